# Optimizing an MI355X kernel written in HIP

```python
import jax, jax.numpy as jnp
from jax import lax
import numpy as np

D_MODEL = 1024
BATCH = 4
SEQ = 4096
DEPTH = 1

MEM_LEN = 256
EPS = 1e-6
M_HEADS = 4
M_DH = 128
M_W = M_HEADS * M_DH
CONV_K = 4
M_CHUNK = 128
DIL_GROUPS = ((128, 1), (512, 4), (2048, 16))
N_DIL = len(DIL_GROUPS)
DIL_HEADS = 4
DIL_DH = 64
DIL_W = DIL_HEADS * DIL_DH
DIL_BLOCK = 128
X_HEADS = 4
X_DH = 128
X_W = X_HEADS * X_DH
N_BRANCH = 3
IN_SIZES = (M_W, M_W, M_W, M_W, M_HEADS, M_HEADS, N_DIL * DIL_W, N_DIL * DIL_W, N_DIL * DIL_W, X_W)
IN_TOTAL = sum(IN_SIZES)
N_GROUPS = 4
EXP_PER_GROUP = 8
TOP_K = 2
D_FF_EXP = 256

kernel_name = 'hybrid_mlstm_dilated_memory_hmoe_block'


def rms_norm(x, g):
    x32 = x.astype(jnp.float32)
    y = x32 * lax.rsqrt(jnp.mean(x32 * x32, axis=-1, keepdims=True) + EPS)
    return (y * g.astype(jnp.float32)).astype(x.dtype)


def causal_depthwise_conv(x, w):
    K = w.shape[0]
    S = x.shape[1]
    xp = jnp.pad(x, ((0, 0), (K - 1, 0), (0, 0)))
    y = xp[:, 0:S] * w[0]
    for j in range(1, K):
        y = y + xp[:, j:j + S] * w[j]
    return y


def mlstm_chunkwise(q, k, v, i_pre, f_pre):
    B, S, H, Dh = q.shape
    f32 = jnp.float32
    L = M_CHUNK
    nc = S // L
    q = q.astype(f32)
    k = k.astype(f32) * (Dh ** -0.5)
    v = v.astype(f32)
    log_f = jax.nn.log_sigmoid(f_pre.astype(f32))
    log_i = i_pre.astype(f32)

    def chunks(a):
        return jnp.moveaxis(a.reshape((B, nc, L) + a.shape[2:]), 1, 0)

    causal = jnp.tril(jnp.ones((L, L), dtype=bool))

    def step(carry, inp):
        C, n, m = carry
        qb, kb, vb, lf, li = inp
        b = jnp.swapaxes(jnp.cumsum(lf, axis=1), 1, 2)
        li = jnp.swapaxes(li, 1, 2)
        log_w = jnp.where(causal, b[..., :, None] - b[..., None, :] + li[..., None, :], -jnp.inf)
        log_inter = b + m[..., None]
        m_t = jnp.maximum(log_inter, jnp.max(log_w, axis=-1))
        w_intra = jnp.exp(log_w - m_t[..., None])
        w_inter = jnp.swapaxes(jnp.exp(log_inter - m_t), 1, 2)[..., None]
        s = jnp.einsum('bthd,bshd->bhts', qb, kb) * w_intra
        num = jnp.einsum('bhts,bshe->bthe', s, vb) + w_inter * jnp.einsum('bthd,bhde->bthe', qb, C)
        den = jnp.swapaxes(jnp.sum(s, axis=-1), 1, 2) + w_inter[..., 0] * jnp.einsum('bthd,bhd->bth', qb, n)
        floor = jnp.swapaxes(jnp.exp(-m_t), 1, 2)
        h = num / jnp.maximum(jnp.abs(den), floor)[..., None]
        b_last = b[..., -1]
        log_end = b_last[..., None] - b + li
        m_new = jnp.maximum(b_last + m, jnp.max(log_end, axis=-1))
        w_end = jnp.exp(log_end - m_new[..., None])
        decay = jnp.exp(b_last + m - m_new)
        C = decay[..., None, None] * C + jnp.einsum('bhs,bshd,bshe->bhde', w_end, kb, vb)
        n = decay[..., None] * n + jnp.einsum('bhs,bshd->bhd', w_end, kb)
        return (C, n, m_new), h

    init = (jnp.zeros((B, H, Dh, Dh), f32), jnp.zeros((B, H, Dh), f32), jnp.zeros((B, H), f32))
    _, h = lax.scan(step, init, (chunks(q), chunks(k), chunks(v), chunks(log_f), chunks(log_i)))
    return jnp.moveaxis(h, 0, 1).reshape(B, S, H, Dh)


def dilated_window_attention(q, k, v, dilation, steps):
    B, S, H, Dh = q.shape
    f32 = jnp.float32
    r = dilation
    N = S // r
    Qb = DIL_BLOCK
    nb = -(-N // Qb)
    pad = nb * Qb - N

    def subseq(a):
        a = a.reshape(B, N, r, H, Dh).transpose(0, 2, 1, 3, 4)
        a = jnp.pad(a, ((0, 0), (0, 0), (0, pad), (0, 0), (0, 0)))
        return a.reshape(B, r, nb, Qb, H, Dh)

    def with_prev(a):
        prev = jnp.pad(a, ((0, 0), (0, 0), (1, 0), (0, 0), (0, 0), (0, 0)))[:, :, :-1]
        return jnp.concatenate([prev, a], axis=3)

    qb = subseq(q)
    kk = with_prev(subseq(k))
    vv = with_prev(subseq(v)).astype(f32)
    scores = jnp.einsum('brnqhd,brnkhd->brnhqk', qb, kk).astype(f32) * (Dh ** -0.5)
    blk = jnp.arange(nb)[:, None] * Qb
    qpos = blk + jnp.arange(Qb)[None]
    kpos = blk - Qb + jnp.arange(2 * Qb)[None]
    dist = qpos[:, :, None] - kpos[:, None, :]
    valid = (dist >= 0) & (dist <= steps) & (kpos[:, None, :] >= 0)
    scores = jnp.where(valid[:, None], scores, -jnp.inf)
    mx = jnp.max(scores, axis=-1, keepdims=True)
    p = jnp.exp(scores - mx)
    den = jnp.sum(p, axis=-1)
    out = jnp.einsum('brnhqk,brnkhd->brnqhd', p, vv) / jnp.swapaxes(den, -1, -2)[..., None]
    lse = jnp.swapaxes(mx[..., 0] + jnp.log(den), -1, -2)

    def unsub(a):
        a = a.reshape((B, r, nb * Qb) + a.shape[4:])[:, :, :N]
        a = jnp.swapaxes(a, 1, 2)
        return a.reshape((B, S) + a.shape[3:])

    return unsub(out), unsub(lse)


def memory_cross_attention(xq, mem, mem_norm_g, w_mem_kv, q_g, k_g):
    B, S, _ = xq.shape
    M = mem.shape[1]
    q = rms_norm(xq.reshape(B, S, X_HEADS, X_DH), q_g)
    kv = rms_norm(mem, mem_norm_g) @ w_mem_kv
    km, vm = jnp.split(kv, 2, axis=-1)
    km = rms_norm(km.reshape(B, M, X_HEADS, X_DH), k_g)
    vm = vm.reshape(B, M, X_HEADS, X_DH).astype(jnp.float32)
    s = jnp.einsum('bshd,bmhd->bhsm', q, km).astype(jnp.float32) * (X_DH ** -0.5)
    p = jax.nn.softmax(s, axis=-1)
    return jnp.einsum('bhsm,bmhd->bshd', p, vm)


def hier_moe(x, w_grp, b_grp, w_er, b_er, w_eg, w_eu, w_ed):
    B, S, D = x.shape
    T = B * S
    f32 = jnp.float32
    xt = x.reshape(T, D)
    grp_prob = jax.nn.softmax((xt @ w_grp + b_grp).astype(f32), axis=-1)
    g_w, g_idx = lax.top_k(grp_prob, 1)
    exp_logits = (jnp.einsum('td,gde->tge', xt, w_er) + b_er).astype(f32)
    exp_logits = jnp.take_along_axis(exp_logits, g_idx[:, :, None], axis=1)[:, 0]
    top_v, top_i = lax.top_k(exp_logits, TOP_K)
    top_w = jax.nn.softmax(top_v, axis=-1) * g_w
    within = jnp.sum(jax.nn.one_hot(top_i, EXP_PER_GROUP, dtype=f32) * top_w[..., None], axis=1)
    y = jnp.zeros((T, D), f32)
    for g in range(N_GROUPS):
        comb = within * (g_idx == g)
        hid = jax.nn.silu(jnp.einsum('td,edf->tef', xt, w_eg[g])) * jnp.einsum('td,edf->tef', xt, w_eu[g])
        y = y + jnp.einsum('tef,efd->td', hid * comb[..., None].astype(hid.dtype), w_ed[g]).astype(f32)
    return y.reshape(B, S, D)


def setup_inputs(seed: int = 0) -> dict:
    key = jax.random.key(seed)
    ks = jax.random.split(key, 32)
    f32 = jnp.float32

    def nrm(k, shape, scale):
        return jax.random.normal(k, shape, f32) * scale

    L = DEPTH
    G, E, F = N_GROUPS, EXP_PER_GROUP, D_FF_EXP
    return {
        'x': nrm(ks[0], (BATCH, SEQ, D_MODEL), 1.0),
        'mem': nrm(ks[1], (BATCH, MEM_LEN, D_MODEL), 1.0),
        'ln1_g': 1.0 + nrm(ks[2], (L, D_MODEL), 0.02),
        'w_in': nrm(ks[3], (L, D_MODEL, IN_TOTAL), D_MODEL ** -0.5),
        'm_conv': nrm(ks[4], (L, CONV_K, 2 * M_W), CONV_K ** -0.5),
        'm_i_b': nrm(ks[5], (L, M_HEADS), 0.1),
        'm_f_b': jnp.linspace(3.0, 6.0, M_HEADS, dtype=f32)[None] + nrm(ks[6], (L, M_HEADS), 0.1),
        'm_norm_g': 1.0 + nrm(ks[7], (L, M_HEADS, M_DH), 0.02),
        'dil_q_g': 1.0 + nrm(ks[8], (L, N_DIL, DIL_DH), 0.02),
        'dil_k_g': 1.0 + nrm(ks[9], (L, N_DIL, DIL_DH), 0.02),
        'mem_norm_g': 1.0 + nrm(ks[10], (L, D_MODEL), 0.02),
        'w_mem_kv': nrm(ks[11], (L, D_MODEL, 2 * X_W), D_MODEL ** -0.5),
        'x_q_g': 1.0 + nrm(ks[12], (L, X_DH), 0.02),
        'x_k_g': 1.0 + nrm(ks[13], (L, X_DH), 0.02),
        'w_a': nrm(ks[14], (L, M_W, D_MODEL), M_W ** -0.5),
        'w_b': nrm(ks[15], (L, DIL_W, D_MODEL), DIL_W ** -0.5),
        'w_c': nrm(ks[16], (L, X_W, D_MODEL), X_W ** -0.5),
        'w_gate': nrm(ks[17], (L, D_MODEL, N_BRANCH * D_MODEL), D_MODEL ** -0.5),
        'b_gate': nrm(ks[18], (L, N_BRANCH * D_MODEL), 0.01),
        'w_out': nrm(ks[19], (L, D_MODEL, D_MODEL), D_MODEL ** -0.5),
        'ln2_g': 1.0 + nrm(ks[20], (L, D_MODEL), 0.02),
        'w_grp': nrm(ks[21], (L, D_MODEL, G), D_MODEL ** -0.5),
        'b_grp': nrm(ks[22], (L, G), 0.01),
        'w_er': nrm(ks[23], (L, G, D_MODEL, E), D_MODEL ** -0.5),
        'b_er': nrm(ks[24], (L, G, E), 0.01),
        'w_eg': nrm(ks[25], (L, G, E, D_MODEL, F), D_MODEL ** -0.5),
        'w_eu': nrm(ks[26], (L, G, E, D_MODEL, F), D_MODEL ** -0.5),
        'w_ed': nrm(ks[27], (L, G, E, F, D_MODEL), F ** -0.5),
    }


def reference(x, mem, ln1_g, w_in, m_conv, m_i_b, m_f_b, m_norm_g, dil_q_g, dil_k_g,
              mem_norm_g, w_mem_kv, x_q_g, x_k_g, w_a, w_b, w_c, w_gate, b_gate, w_out,
              ln2_g, w_grp, b_grp, w_er, b_er, w_eg, w_eu, w_ed):
    B, S, D = x.shape
    splits = np.cumsum(IN_SIZES)[:-1].tolist()
    h = x
    for l in range(DEPTH):
        xn = rms_norm(h, ln1_g[l])
        z = xn @ w_in[l]
        mq, mk, mv, mo, mi, mf, dq, dk, dv, xq = jnp.split(z, splits, axis=-1)

        qk = jax.nn.silu(causal_depthwise_conv(jnp.concatenate([mq, mk], axis=-1), m_conv[l]))
        mq, mk = jnp.split(qk, 2, axis=-1)
        hA = mlstm_chunkwise(mq.reshape(B, S, M_HEADS, M_DH), mk.reshape(B, S, M_HEADS, M_DH),
                             mv.reshape(B, S, M_HEADS, M_DH), mi + m_i_b[l], mf + m_f_b[l])
        hA = rms_norm(hA, m_norm_g[l]).reshape(B, S, M_W) * jax.nn.sigmoid(mo)
        branch_a = hA @ w_a[l]

        dq = rms_norm(dq.reshape(B, S, N_DIL, DIL_HEADS, DIL_DH), dil_q_g[l][:, None, :])
        dk = rms_norm(dk.reshape(B, S, N_DIL, DIL_HEADS, DIL_DH), dil_k_g[l][:, None, :])
        dv = dv.reshape(B, S, N_DIL, DIL_HEADS, DIL_DH)
        outs, lses = [], []
        for g, (window, dilation) in enumerate(DIL_GROUPS):
            o_g, lse_g = dilated_window_attention(dq[:, :, g], dk[:, :, g], dv[:, :, g],
                                                  dilation, window // dilation)
            outs.append(o_g)
            lses.append(lse_g)
        alpha = jax.nn.softmax(jnp.stack(lses, axis=0), axis=0)[..., None]
        hB = jnp.sum(alpha * jnp.stack(outs, axis=0), axis=0).reshape(B, S, DIL_W)
        branch_b = hB @ w_b[l]

        hC = memory_cross_attention(xq, mem, mem_norm_g[l], w_mem_kv[l], x_q_g[l], x_k_g[l])
        branch_c = hC.reshape(B, S, X_W) @ w_c[l]

        gates = jax.nn.sigmoid(xn @ w_gate[l] + b_gate[l]).reshape(B, S, N_BRANCH, D)
        mixed = gates[:, :, 0] * branch_a + gates[:, :, 1] * branch_b + gates[:, :, 2] * branch_c
        h = h + (mixed @ w_out[l]).astype(h.dtype)

        hn = rms_norm(h, ln2_g[l])
        h = h + hier_moe(hn, w_grp[l], b_grp[l], w_er[l], b_er[l], w_eg[l], w_eu[l], w_ed[l]).astype(h.dtype)
    return h.astype(x.dtype)
```

```cpp
#include <hip/hip_runtime.h>
#include <cstdio>
#include <cstdint>
#include <cmath>

constexpr int D = 1024, BATCH = 4, SEQ = 4096, M = BATCH * SEQ;
constexpr int MEM_LEN = 256, MROWS = BATCH * MEM_LEN;
constexpr float EPS = 1e-6f;
constexpr int IN_TOTAL = 4872;
constexpr int ZW = 4864;
constexpr int Z_MQ = 0, Z_MK = 512, Z_MV = 1024, Z_MO = 1536, Z_DQ = 2048, Z_DK = 2816, Z_DV = 3584, Z_XQ = 4352;
constexpr int NCHUNK = SEQ / 128;
typedef unsigned short bf16;

constexpr size_t MiB = 1u << 20;
constexpr size_t WS_CTL = 0;
constexpr size_t WS_IFG = 1 * MiB;
constexpr size_t WS_LSE = 2 * MiB;
constexpr size_t WS_MSC = 3 * MiB;
constexpr size_t WS_NL = 3 * MiB + 64 * 1024;
constexpr size_t WS_WGATE = 8 * MiB;
constexpr size_t WS_WA = 14 * MiB;
constexpr size_t WS_WB = 15 * MiB;
constexpr size_t WS_WC = 16 * MiB;
constexpr size_t WS_WOUT = 17 * MiB;
constexpr size_t WS_HA = 19 * MiB;
constexpr size_t WS_Z = 35 * MiB;
constexpr size_t WS_CL = 187 * MiB;
constexpr size_t WS_W1Z = 219 * MiB;
constexpr size_t WS_WKV = 229 * MiB;
constexpr size_t WS_MEMN = 231 * MiB;
constexpr size_t WS_KVM = 251 * MiB;
constexpr size_t WS_MIXED = 187 * MiB;
constexpr size_t WS_END = 253 * MiB;

__device__ __forceinline__ unsigned f2bf(float f) { unsigned u = __float_as_uint(f); return (u + 0x7fffu + ((u >> 16) & 1u)) >> 16; }
__device__ __forceinline__ float bf2f(bf16 h) { return __uint_as_float(((unsigned)h) << 16); }
#define DPP_F(v, ctrl, rmask) __builtin_bit_cast(float, __builtin_amdgcn_update_dpp(0, __builtin_bit_cast(int, (v)), (ctrl), (rmask), 0xf, false))
__device__ __forceinline__ float wave_sum(float v) {
    v += DPP_F(v, 0xB1, 0xf); v += DPP_F(v, 0x4E, 0xf); v += DPP_F(v, 0x141, 0xf); v += DPP_F(v, 0x140, 0xf);
    v += DPP_F(v, 0x142, 0xa); v += DPP_F(v, 0x143, 0xc);
    return __builtin_bit_cast(float, __builtin_amdgcn_readlane(__builtin_bit_cast(int, v), 63));
}
#define DPP_FM(v, ctrl, rmask) __builtin_bit_cast(float, __builtin_amdgcn_update_dpp(__builtin_bit_cast(int, (v)), __builtin_bit_cast(int, (v)), (ctrl), (rmask), 0xf, false))
__device__ __forceinline__ float wave_max(float v) {
    v = fmaxf(v, DPP_FM(v, 0xB1, 0xf)); v = fmaxf(v, DPP_FM(v, 0x4E, 0xf)); v = fmaxf(v, DPP_FM(v, 0x141, 0xf)); v = fmaxf(v, DPP_FM(v, 0x140, 0xf));
    v = fmaxf(v, DPP_FM(v, 0x142, 0xa)); v = fmaxf(v, DPP_FM(v, 0x143, 0xc));
    return __builtin_bit_cast(float, __builtin_amdgcn_readlane(__builtin_bit_cast(int, v), 63));
}
__device__ __forceinline__ float sigmoidf_(float x) { return 1.f / (1.f + __expf(-x)); }
__device__ __forceinline__ float siluf_(float x) { return x / (1.f + __expf(-x)); }
__device__ __forceinline__ float log_sigmoid_(float x) { return fminf(x, 0.f) - log1pf(__expf(-fabsf(x))); }

namespace pg8 {
#define PG8_LAS __attribute__((address_space(3)))
typedef unsigned short bf16_t;
typedef short bf16x8 __attribute__((ext_vector_type(8)));
typedef float f32x4 __attribute__((ext_vector_type(4)));
typedef unsigned u32x4 __attribute__((ext_vector_type(4)));
constexpr int BM = 256, BK = 64, HALF = 128, HTB = HALF * BK * 2  , STAGE_BYTES = 8 * HTB, NXCD = 8, WGM = 8;

__host__ __device__ __forceinline__ int lds_byte(int r, int c) { const int st = (r >> 4) * 2 + (c >> 5), rr = r & 15, cc = c & 31, ob = rr * 64 + cc * 2; return st * 1024 + (ob ^ (((ob >> 9) & 1) << 5)); }
__host__ __device__ __forceinline__ void stage_rc(int b, int& R, int& C) { const int st = b / 1024, sb = b % 1024, swz = sb ^ (((sb >> 9) & 1) << 5); R = (st >> 1) * 16 + swz / 64; C = (st & 1) * 32 + (swz % 64) / 2; }
__host__ __device__ __forceinline__ int perm32(int rho) { const int n = rho >> 4, i = rho & 15; return 8 * (i >> 2) + 4 * n + (i & 3); }

struct Unit { int pm, pn, bt, aux; };
struct Gemm { const bf16_t* A; const bf16_t* Bt; int lda, K; const int* rowidx; };

struct StaticOrder {
    int nM, nN, nwg, G, c, btoff;
    __host__ __device__ __forceinline__ void init(int M, int N, int G_, int c_, int btoff_ = 0) { nM = M / BM; nN = N / BM; nwg = nM * nN; G = G_; c = c_; btoff = btoff_; }
    __host__ __device__ __forceinline__ bool next(int i, Unit& u) const {
        const long L = (long)i * G + c; if (L >= nwg) return false;
        int wgid = (int)L; { const int q = nwg / NXCD, r = nwg % NXCD, xcd = wgid % NXCD, off = wgid / NXCD; wgid = (xcd < r ? xcd * (q + 1) : r * (q + 1) + (xcd - r) * q) + off; }
        const int nig = WGM * nN, gid = wgid / nig, fm = gid * WGM, gsz = (nM - fm) < WGM ? (nM - fm) : WGM;
        u.pm = fm + ((wgid % nig) % gsz); u.pn = (wgid % nig) / gsz; u.bt = u.pn + btoff; u.aux = 0; return true;
    }
};

typedef __bf16 bf16x2_t __attribute__((ext_vector_type(2)));
typedef float f32x2_t __attribute__((ext_vector_type(2)));
__device__ __forceinline__ unsigned cvt_pk_bf16(float lo, float hi) { const f32x2_t v = {lo, hi}; const bf16x2_t r = __builtin_convertvector(v, bf16x2_t); return __builtin_bit_cast(unsigned, r); }


struct Chain { const bf16_t* A; const bf16_t* Bt; int lda, K; };
template <class Epi, class Sched, bool ALIGN_EPI, bool GATHER, int CH = 0>
__device__ __forceinline__ void gemm_phase(PG8_LAS unsigned char* lds, const Gemm g, const Sched& S, const Epi& E, int wave_id, const Chain nx = Chain{nullptr, nullptr, 0, 0}) {
    int tid_; { int l; asm volatile("v_mbcnt_lo_u32_b32 %0, -1, 0\n\tv_mbcnt_hi_u32_b32 %0, -1, %0" : "=v"(l)); tid_ = wave_id * 64 + l; }
    const int tid = tid_, wid = wave_id, lane = tid & 63, wr = wid >> 2, wc = wid & 3, fr = lane & 15, fq = lane >> 4;
    const int K = g.K, nt = K / BK, lda = g.lda;
    unsigned voffA[2], voffB[2]; int RA[2], CA[2];
#pragma unroll
    for (int i = 0; i < 2; ++i) { int R, C; stage_rc(tid * 16 + i * 8192, R, C); const int Rb = Epi::PERM ? ((R & ~31) + perm32(R & 31)) : R;
        RA[i] = R; CA[i] = C; voffA[i] = (unsigned)(R * lda + C) * 2u; voffB[i] = (unsigned)(Rb * K + C) * 2u; }
    unsigned voffA_n[2], voffB_n[2]; size_t hstepA_n = 0, hstepB_n = 0;
    if constexpr ((CH & 2) != 0) {
#pragma unroll
        for (int i = 0; i < 2; ++i) { const int Rb = (RA[i] & ~31) + perm32(RA[i] & 31); voffA_n[i] = (unsigned)(RA[i] * nx.lda + CA[i]) * 2u; voffB_n[i] = (unsigned)(Rb * nx.K + CA[i]) * 2u; }
        hstepA_n = (size_t)HALF * nx.lda * 2; hstepB_n = (size_t)HALF * nx.K * 2;
    }
    const size_t kstep = (size_t)(BK * 2);
    const size_t hstepA = (size_t)HALF * lda * 2, tstepA = 2 * hstepA;
    const size_t hstepB = (size_t)HALF * K * 2, tstepB = 2 * hstepB;
    const unsigned ldsw = (unsigned)wid * 1024u;
    const int aoff = lds_byte(wr * 64 + fr, fq * 8), boff = lds_byte(wc * 32 + fr, fq * 8);
#define PG8_SA(b, h) (((b) * 2 + (h)) * HTB)
#define PG8_SB(b, h) ((4 + (b) * 2 + (h)) * HTB)
#define PG8_STAGE(bufoff, gbase, voff) do { _Pragma("unroll") for (int _i = 0; _i < 2; ++_i) \
        __builtin_amdgcn_global_load_lds((const unsigned*)((const char*)(gbase) + (voff)[_i]), (PG8_LAS unsigned*)(lds + (bufoff) + ldsw + _i * 8192), 16, 0, 0); } while (0)
#define PG8_LDA(dst, b, h) do { _Pragma("unroll") for (int m = 0; m < 4; ++m) _Pragma("unroll") for (int k = 0; k < 2; ++k) dst[m][k] = *(const PG8_LAS bf16x8*)(lds + PG8_SA(b, h) + aoff + m * 2048 + k * 1024); } while (0)
#define PG8_LDB(dst, b, h) do { _Pragma("unroll") for (int n = 0; n < 2; ++n) _Pragma("unroll") for (int k = 0; k < 2; ++k) dst[n][k] = *(const PG8_LAS bf16x8*)(lds + PG8_SB(b, h) + boff + n * 2048 + k * 1024); } while (0)
#define PG8_MMA(ai, bj, At, Bt) do { __builtin_amdgcn_s_setprio(1); _Pragma("unroll") for (int m = 0; m < 4; ++m) _Pragma("unroll") for (int n = 0; n < 2; ++n) _Pragma("unroll") for (int k = 0; k < 2; ++k) \
        acc[ai][bj][m][n] = __builtin_amdgcn_mfma_f32_16x16x32_bf16(Bt[n][k], At[m][k], acc[ai][bj][m][n], 0, 0, 0); __builtin_amdgcn_s_setprio(0); } while (0)
#define PG8_WAIT_V(n) asm volatile("s_waitcnt vmcnt(" #n ")" ::: "memory")
#define PG8_WAIT_L(n) asm volatile("s_waitcnt lgkmcnt(" #n ")" ::: "memory")
#define PG8_BAR __builtin_amdgcn_s_barrier()
#define PG8_SCHED __builtin_amdgcn_sched_barrier(0)
    Unit cur, nxt; int ui = 0;
    if (!S.next(0, cur)) return;
    f32x4 acc[2][2][4][2];
#pragma unroll
    for (int a = 0; a < 2; ++a)
#pragma unroll
        for (int b = 0; b < 2; ++b)
#pragma unroll
            for (int m = 0; m < 4; ++m)
#pragma unroll
                for (int n = 0; n < 2; ++n) acc[a][b][m][n] = (f32x4){0.f, 0.f, 0.f, 0.f};
    bf16x8 At[4][2], B0[2][2], B1[2][2];
    unsigned gAc[2][2], gAn[2][2];
    if constexpr (GATHER) {
#pragma unroll
        for (int h = 0; h < 2; ++h)
#pragma unroll
            for (int i = 0; i < 2; ++i) { unsigned _r = (unsigned)g.rowidx[cur.pm * BM + h * HALF + RA[i]]; _r = _r < 16384u ? _r : 0u; gAc[h][i] = (_r * (unsigned)lda + (unsigned)CA[i]) * 2u; }
    }
    const char* cA = GATHER ? (const char*)g.A : (const char*)g.A + (size_t)cur.pm * tstepA; const char* cB = (const char*)g.Bt + (size_t)cur.bt * tstepB;
#define PG8_STAGE_A(bufoff, p, h, useN) do { if constexpr (GATHER) { unsigned _v[2]; _v[0] = (useN) ? gAn[h][0] : gAc[h][0]; _v[1] = (useN) ? gAn[h][1] : gAc[h][1]; PG8_STAGE(bufoff, p, _v); } \
        else if constexpr ((CH & 2) != 0) { unsigned _v[2]; _v[0] = ((useN) && chain_now) ? voffA_n[0] : voffA[0]; _v[1] = ((useN) && chain_now) ? voffA_n[1] : voffA[1]; \
            PG8_STAGE(bufoff, (p) + (h) * (((useN) && chain_now) ? hstepA_n : hstepA), _v); } \
        else { PG8_STAGE(bufoff, (p) + (h) * hstepA, voffA); } } while (0)
#define PG8_STAGE_B(bufoff, p, h, useN) do { if constexpr ((CH & 2) != 0) { unsigned _v[2]; _v[0] = ((useN) && chain_now) ? voffB_n[0] : voffB[0]; _v[1] = ((useN) && chain_now) ? voffB_n[1] : voffB[1]; \
            PG8_STAGE(bufoff, (p) + (h) * (((useN) && chain_now) ? hstepB_n : hstepB), _v); } \
        else { PG8_STAGE(bufoff, (p) + (h) * hstepB, voffB); } } while (0)
    bool chain_now = false;
    if constexpr ((CH & 1) == 0) {
    PG8_STAGE(PG8_SB(0, 0), cB, voffB); PG8_STAGE(PG8_SB(0, 1), cB + hstepB, voffB); PG8_STAGE_A(PG8_SA(0, 0), cA, 0, false); PG8_STAGE_A(PG8_SA(0, 1), cA, 1, false);
    if (wr == 1) PG8_BAR;
    PG8_WAIT_V(2); PG8_BAR;
    PG8_STAGE(PG8_SB(1, 0), cB + kstep, voffB); PG8_STAGE_A(PG8_SA(1, 0), cA + kstep, 0, false); PG8_STAGE(PG8_SB(1, 1), cB + hstepB + kstep, voffB);
    PG8_WAIT_V(6); PG8_BAR;
    }
    for (;;) {
        const bool has_next = S.next(ui + 1, nxt);
        const char* nA = GATHER ? (const char*)g.A : (has_next ? (const char*)g.A + (size_t)nxt.pm * tstepA : (((CH & 2) != 0) ? (const char*)nx.A : cA)); const char* nB = has_next ? (const char*)g.Bt + (size_t)nxt.bt * tstepB : (((CH & 2) != 0) ? (const char*)nx.Bt : cB);
        if constexpr ((CH & 2) != 0) chain_now = !has_next;
        if constexpr (GATHER) {
#pragma unroll
            for (int h = 0; h < 2; ++h)
#pragma unroll
                for (int i = 0; i < 2; ++i) { unsigned _r = has_next ? (unsigned)g.rowidx[nxt.pm * BM + h * HALF + RA[i]] : 0u; _r = _r < 16384u ? _r : 0u; gAn[h][i] = has_next ? (_r * (unsigned)lda + (unsigned)CA[i]) * 2u : gAc[h][i]; }
        }
        for (int t = 0; t < nt; t += 2) {
            const bool last = (t == nt - 2);
            const char* a1 = cA + (size_t)(t + 1) * kstep;
            const char* a2 = last ? nA : cA + (size_t)(t + 2) * kstep; const char* b2 = last ? nB : cB + (size_t)(t + 2) * kstep;
            const char* a3 = a2 + kstep; const char* b3 = b2 + kstep;
            PG8_LDB(B0, 0, 0); PG8_LDB(B1, 0, 1); PG8_SCHED; PG8_LDA(At, 0, 0); PG8_STAGE_A(PG8_SA(1, 1), a1, 1, false);
            PG8_WAIT_V(8); PG8_WAIT_L(0); PG8_BAR; PG8_MMA(0, 0, At, B0); PG8_MMA(0, 1, At, B1); PG8_BAR; PG8_SCHED;
            PG8_LDA(At, 0, 1); PG8_STAGE_B(PG8_SB(0, 0), b2, 0, last); PG8_STAGE_B(PG8_SB(0, 1), b2, 1, last); PG8_STAGE_A(PG8_SA(0, 0), a2, 0, last);
            PG8_WAIT_V(8); PG8_WAIT_L(0); PG8_BAR; PG8_MMA(1, 0, At, B0); PG8_MMA(1, 1, At, B1); PG8_BAR; PG8_SCHED;
            PG8_LDB(B0, 1, 0); PG8_LDB(B1, 1, 1); PG8_SCHED; PG8_LDA(At, 1, 0); PG8_STAGE_A(PG8_SA(0, 1), a2, 1, last);
            PG8_WAIT_V(8); PG8_WAIT_L(0); PG8_BAR; PG8_MMA(0, 0, At, B0); PG8_MMA(0, 1, At, B1); PG8_BAR; PG8_SCHED;
            PG8_LDA(At, 1, 1); PG8_STAGE_B(PG8_SB(1, 0), b3, 0, last); PG8_STAGE_B(PG8_SB(1, 1), b3, 1, last); PG8_STAGE_A(PG8_SA(1, 0), a3, 0, last);
            PG8_WAIT_V(8); PG8_WAIT_L(0); PG8_BAR; PG8_MMA(1, 0, At, B0); PG8_MMA(1, 1, At, B1); PG8_BAR; PG8_SCHED;
        }
        if constexpr (ALIGN_EPI) { if (wr == 0) PG8_BAR; }
        E(acc, cur, wr, wc, fr, fq);
        if (!has_next) { if constexpr ((CH & 2) != 0) { if constexpr (ALIGN_EPI) { if (wr == 1) PG8_BAR; } return; } break; }
#pragma unroll
        for (int a = 0; a < 2; ++a)
#pragma unroll
            for (int b = 0; b < 2; ++b)
#pragma unroll
                for (int m = 0; m < 4; ++m)
#pragma unroll
                    for (int n = 0; n < 2; ++n) acc[a][b][m][n] = (f32x4){0.f, 0.f, 0.f, 0.f};
        cur = nxt; cA = nA; cB = nB; ++ui;
        if constexpr (GATHER) {
#pragma unroll
            for (int h = 0; h < 2; ++h)
#pragma unroll
                for (int i = 0; i < 2; ++i) gAc[h][i] = gAn[h][i];
        }
        if constexpr (ALIGN_EPI) { if (wr == 1) PG8_BAR; }
    }
    PG8_WAIT_V(0);
    if constexpr (!ALIGN_EPI) { if (wr == 0) PG8_BAR; }
    PG8_BAR;
#undef PG8_SA
#undef PG8_SB
#undef PG8_STAGE
#undef PG8_STAGE_A
#undef PG8_STAGE_B
#undef PG8_LDA
#undef PG8_LDB
#undef PG8_MMA
#undef PG8_WAIT_V
#undef PG8_WAIT_L
#undef PG8_BAR
#undef PG8_SCHED
}
}
namespace pg8 {
struct EpiStoreBf16 {
    static constexpr bool PERM = true;
    bf16_t* O; int ldc;
    __device__ __forceinline__ void operator()(const f32x4 (&acc)[2][2][4][2], const Unit& u, int wr, int wc, int fr, int fq) const {
        const int row0 = u.pm * BM + wr * 64 + fr, col0 = u.pn * BM + wc * 32 + 8 * fq;
#pragma unroll
        for (int ai = 0; ai < 2; ++ai)
#pragma unroll
            for (int m = 0; m < 4; ++m) { bf16_t* rowp = O + (size_t)(row0 + ai * HALF + m * 16) * ldc + col0;
#pragma unroll
                for (int bj = 0; bj < 2; ++bj) { const f32x4 v0 = acc[ai][bj][m][0], v1 = acc[ai][bj][m][1];
                    u32x4 w; w.x = cvt_pk_bf16(v0[0], v0[1]); w.y = cvt_pk_bf16(v0[2], v0[3]); w.z = cvt_pk_bf16(v1[0], v1[1]); w.w = cvt_pk_bf16(v1[2], v1[3]);
                    *(u32x4*)(rowp + bj * HALF) = w; } }
    }
};
__device__ __forceinline__ float fast_sigmoid(float x) { return __builtin_amdgcn_rcpf(1.f + __builtin_amdgcn_exp2f(-1.4426950408889634f * x)); }
struct EpiGate {
    static constexpr bool PERM = true;
    bf16_t* O; const float* bias;
    __device__ __forceinline__ void operator()(const f32x4 (&acc)[2][2][4][2], const Unit& u, int wr, int wc, int fr, int fq) const {
        const int row0 = u.pm * BM + wr * 64 + fr, col0 = u.pn * BM + wc * 32 + 8 * fq;
        f32x4 bv[2][2];
#pragma unroll
        for (int bj = 0; bj < 2; ++bj)
#pragma unroll
            for (int n = 0; n < 2; ++n) bv[bj][n] = *(const f32x4*)(bias + col0 + bj * HALF + 4 * n);
#pragma unroll
        for (int ai = 0; ai < 2; ++ai)
#pragma unroll
            for (int m = 0; m < 4; ++m) { bf16_t* rowp = O + (size_t)(row0 + ai * HALF + m * 16) * 1024 + col0;
#pragma unroll
                for (int bj = 0; bj < 2; ++bj) { f32x4 v0 = acc[ai][bj][m][0] + bv[bj][0], v1 = acc[ai][bj][m][1] + bv[bj][1];
#pragma unroll
                    for (int j = 0; j < 4; ++j) { v0[j] = fast_sigmoid(v0[j]); v1[j] = fast_sigmoid(v1[j]); }
                    u32x4 w; w.x = cvt_pk_bf16(v0[0], v0[1]); w.y = cvt_pk_bf16(v0[2], v0[3]); w.z = cvt_pk_bf16(v1[0], v1[1]); w.w = cvt_pk_bf16(v1[2], v1[3]);
                    *(u32x4*)(rowp + bj * HALF) = w; } }
    }
};
__device__ __forceinline__ float bflo(unsigned w) { return __uint_as_float(w << 16); }
__device__ __forceinline__ float bfhi(unsigned w) { return __uint_as_float(w & 0xffff0000u); }
template <int MODE>
struct EpiMix {
    static constexpr bool PERM = true;
    bf16_t* GS; bf16_t* MIXED;
    __device__ __forceinline__ void operator()(const f32x4 (&acc)[2][2][4][2], const Unit& u, int wr, int wc, int fr, int fq) const {
        const int row0 = u.pm * BM + wr * 64 + fr, col0 = u.pn * BM + wc * 32 + 8 * fq;
#pragma unroll
        for (int ai = 0; ai < 2; ++ai) {
            u32x4 gw[4][2], pw[4][2];
#pragma unroll
            for (int m = 0; m < 4; ++m)
#pragma unroll
                for (int bj = 0; bj < 2; ++bj) { const size_t o = (size_t)(row0 + ai * HALF + m * 16) * 1024 + col0 + bj * HALF;
                    gw[m][bj] = *(const u32x4*)(GS + o); if (MODE != 0) pw[m][bj] = *(const u32x4*)(MIXED + o); }
#pragma unroll
            for (int m = 0; m < 4; ++m)
#pragma unroll
                for (int bj = 0; bj < 2; ++bj) { const size_t o = (size_t)(row0 + ai * HALF + m * 16) * 1024 + col0 + bj * HALF; const u32x4 g = gw[m][bj];
                    f32x4 t0, t1;
                    t0[0] = bflo(g.x) * acc[ai][bj][m][0][0]; t0[1] = bfhi(g.x) * acc[ai][bj][m][0][1]; t0[2] = bflo(g.y) * acc[ai][bj][m][0][2]; t0[3] = bfhi(g.y) * acc[ai][bj][m][0][3];
                    t1[0] = bflo(g.z) * acc[ai][bj][m][1][0]; t1[1] = bfhi(g.z) * acc[ai][bj][m][1][1]; t1[2] = bflo(g.w) * acc[ai][bj][m][1][2]; t1[3] = bfhi(g.w) * acc[ai][bj][m][1][3];
                    if (MODE != 0) { const u32x4 p = pw[m][bj];
                        t0[0] += bflo(p.x); t0[1] += bfhi(p.x); t0[2] += bflo(p.y); t0[3] += bfhi(p.y); t1[0] += bflo(p.z); t1[1] += bfhi(p.z); t1[2] += bflo(p.w); t1[3] += bfhi(p.w); }
                    u32x4 w; w.x = cvt_pk_bf16(t0[0], t0[1]); w.y = cvt_pk_bf16(t0[2], t0[3]); w.z = cvt_pk_bf16(t1[0], t1[1]); w.w = cvt_pk_bf16(t1[2], t1[3]);
                    if (MODE != 2) *(u32x4*)(MIXED + o) = w; else *(u32x4*)(GS + o) = w; }
            asm volatile("" ::: "memory");
        }
    }
};
struct EpiRes {
    static constexpr bool PERM = false;
    const float* x; float* out;
    __device__ __forceinline__ void operator()(const f32x4 (&acc)[2][2][4][2], const Unit& u, int wr, int wc, int fr, int fq) const {
        const int row0 = u.pm * BM + wr * 64 + fr, col0 = u.pn * BM + wc * 32 + 4 * fq;
#pragma unroll
        for (int ai = 0; ai < 2; ++ai)
#pragma unroll
            for (int mp = 0; mp < 2; ++mp) {
                f32x4 xv[2][2][2];
#pragma unroll
                for (int mm = 0; mm < 2; ++mm)
#pragma unroll
                    for (int bj = 0; bj < 2; ++bj)
#pragma unroll
                        for (int n = 0; n < 2; ++n) xv[mm][bj][n] = *(const f32x4*)(x + (size_t)(row0 + ai * HALF + (2 * mp + mm) * 16) * 1024 + col0 + bj * HALF + n * 16);
#pragma unroll
                for (int mm = 0; mm < 2; ++mm)
#pragma unroll
                    for (int bj = 0; bj < 2; ++bj)
#pragma unroll
                        for (int n = 0; n < 2; ++n) *(f32x4*)(out + (size_t)(row0 + ai * HALF + (2 * mp + mm) * 16) * 1024 + col0 + bj * HALF + n * 16) = xv[mm][bj][n] + acc[ai][bj][2 * mp + mm][n];
                asm volatile("" ::: "memory");
            }
    }
};
}
constexpr int NWAVES = 8;
constexpr int SCR_BYTES = 146432;
constexpr int LDSCTL_OFF = SCR_BYTES, MISC_OFF = LDSCTL_OFF + 320;
constexpr int LDS_BYTES = 147456;
#define GAS __attribute__((address_space(1)))
#define LAS __attribute__((address_space(3)))
typedef unsigned v4u __attribute__((ext_vector_type(4)));
typedef float f32x4 __attribute__((ext_vector_type(4)));
typedef short bf16x8 __attribute__((ext_vector_type(8)));
typedef short s16x4 __attribute__((ext_vector_type(4)));
typedef GAS unsigned gu32;
#define RLX_AGENT __ATOMIC_RELAXED, __HIP_MEMORY_SCOPE_AGENT
#define LDS_WAIT() asm volatile("s_waitcnt lgkmcnt(0)" ::: "memory")
#define VM_WAIT() asm volatile("s_waitcnt vmcnt(0)" ::: "memory")
__device__ __forceinline__ int lane_id() { int l; asm volatile("v_mbcnt_lo_u32_b32 %0, -1, 0\n\tv_mbcnt_hi_u32_b32 %0, -1, %0" : "=v"(l)); return l; }
__device__ __forceinline__ unsigned pk2(float lo, float hi) { return pg8::cvt_pk_bf16(lo, hi); }

constexpr int CW_BAR = 4096;
constexpr int CW_ECNT = 32768;

#define XB_TMO      128
#define XB_XCNT(j)  (256  + 64 * (j))
#define XB_XSUB(j)  (1280 + 64 * (j))
#define XB_XGEN(j)  (2304 + 64 * (j))
#define XB_TOP      3328
#define XB_TOPGEN   3392
#define XCD_BAR_WORDS 3456
#define XB_SPIN_CAP (1u << 18)
__device__ __forceinline__ unsigned xb_ld(unsigned* p)              { return __hip_atomic_load(p, __ATOMIC_RELAXED, __HIP_MEMORY_SCOPE_AGENT); }
__device__ __forceinline__ unsigned xb_add(unsigned* p, unsigned v) { return __hip_atomic_fetch_add(p, v, __ATOMIC_RELAXED, __HIP_MEMORY_SCOPE_AGENT); }
__device__ __forceinline__ unsigned xb_xcc_id() { return (unsigned)__builtin_amdgcn_s_getreg((3 << 11) | 20) & 0xFu; }
#define XB_SPIN(cond, bar) do { unsigned _sp = 0; while (cond) { __builtin_amdgcn_s_sleep(1); \
    if ((++_sp & 255u) == 0u) { if (xb_ld(&(bar)[XB_TMO])) break; if (_sp > XB_SPIN_CAP) { atomicAdd(&(bar)[XB_TMO], 1u); break; } } } } while (0)
struct XcdBarrier { unsigned* bar; unsigned x; volatile LAS unsigned* st; };
__device__ __forceinline__ XcdBarrier xcd_barrier_post(unsigned* bar, volatile LAS unsigned* st, int tid) {
    XcdBarrier b; b.bar = bar; b.x = xb_xcc_id(); b.st = st;
    if (tid == 0) (void)xb_add(&bar[XB_XCNT(b.x)], 1u);
    return b;
}
__device__ __forceinline__ void xcd_barrier_complete(unsigned* bar, unsigned x, unsigned& nloc, unsigned& nx) {
    const unsigned G = gridDim.x * gridDim.y * gridDim.z;
    unsigned sum, cnt, mine, sp = 0u;
    for (;;) {
        sum = 0u; cnt = 0u; mine = 0u;
#pragma unroll
        for (unsigned j = 0; j < 16; ++j) { const unsigned c = xb_ld(&bar[XB_XCNT(j)]); sum += c; cnt += (c > 0u) ? 1u : 0u; mine = (j == x) ? c : mine; }
        if (sum == G) break;
        __builtin_amdgcn_s_sleep(1);
        if ((++sp & 255u) == 0u) { if (xb_ld(&bar[XB_TMO])) break; if (sp > XB_SPIN_CAP) { atomicAdd(&bar[XB_TMO], 1u); break; } }
    }
    nloc = mine > 0u ? mine : 1u; nx = cnt > 0u ? cnt : 1u;
}
__device__ __forceinline__ void xcd_barrier(const XcdBarrier& b, int tid) {
    asm volatile("s_waitcnt vmcnt(0)" ::: "memory");
    __syncthreads();
    if (tid == 0) {
        unsigned* bar = b.bar;
        __builtin_amdgcn_s_waitcnt(0);
        unsigned nloc = b.st[0], nx = b.st[1];
        if (nloc == 0u) { xcd_barrier_complete(bar, b.x, nloc, nx); b.st[0] = nloc; b.st[1] = nx; }
        const unsigned old = xb_add(&bar[XB_XSUB(b.x)], 1u);
        const unsigned gen = old / nloc;
        if (old + 1u == (gen + 1u) * nloc) {
            __builtin_amdgcn_fence(__ATOMIC_RELEASE, "agent");
            asm volatile("s_waitcnt vmcnt(0)" ::: "memory");
            const unsigned og = xb_add(&bar[XB_TOP], 1u);
            const unsigned tg = og / nx;
            if (og + 1u == (tg + 1u) * nx) xb_add(&bar[XB_TOPGEN], 1u);
            else XB_SPIN(xb_ld(&bar[XB_TOPGEN]) == tg, bar);
            __builtin_amdgcn_fence(__ATOMIC_ACQUIRE, "agent");
            xb_add(&bar[XB_XGEN(b.x)], 1u);
            asm volatile("s_waitcnt vmcnt(0)" ::: "memory");
        } else {
            XB_SPIN(xb_ld(&bar[XB_XGEN(b.x)]) == gen, bar);
            __builtin_amdgcn_fence(__ATOMIC_ACQUIRE, "agent");
            asm volatile("s_waitcnt vmcnt(0)" ::: "memory");
        }
    }
    __syncthreads();
}

constexpr int CW_SPLIT_REL = 65536 - CW_BAR;
__device__ __forceinline__ void split_arrive(const XcdBarrier& b, int inst, int tid) {
    asm volatile("s_waitcnt vmcnt(0)" ::: "memory");
    __syncthreads();
    if (tid == 0) {
        unsigned* w = b.bar + CW_SPLIT_REL + inst * 2048;
        const unsigned nloc = b.st[0];
        const unsigned old = xb_add(&w[64 * b.x], 1u);
        if (old + 1u == nloc) { __builtin_amdgcn_fence(__ATOMIC_RELEASE, "agent"); asm volatile("s_waitcnt vmcnt(0)" ::: "memory"); (void)xb_add(&w[1024], 1u); }
    }
}
__device__ __forceinline__ void split_wait(const XcdBarrier& b, int inst, int tid) {
    if (tid == 0) {
        unsigned* w = b.bar + CW_SPLIT_REL + inst * 2048;
        const unsigned nx = b.st[1];
        XB_SPIN(xb_ld(&w[1024]) < nx, b.bar);
        __builtin_amdgcn_fence(__ATOMIC_ACQUIRE, "agent");
        asm volatile("s_waitcnt vmcnt(0)" ::: "memory");
    }
    __syncthreads();
}

struct Args { const float* in[28]; float* out; unsigned char* ws; int ph_lo, ph_hi, li, pad; };

struct Frame {
    LAS unsigned char* lds;
    int wave, G, gw, NGW;
#define F_LANE (lane_id())
#define F_TID (F.wave * 64 + lane_id())
};

__device__ __forceinline__ void tr_load(const float* W, int ldw, int kb, int nb, int lane, f32x4 (&v)[8]) {
    const float* src = W + (size_t)(64 * kb + 8 * (lane >> 3)) * ldw + 32 * nb + 4 * (lane & 7);
#pragma unroll
    for (int j = 0; j < 8; ++j) v[j] = *(const f32x4*)(src + (size_t)j * ldw);
}
__device__ __forceinline__ void tr_store(bf16* WT, int K, int kb, int nb, int lane, const f32x4 (&v)[8]) {
    bf16* dst = WT + (size_t)(32 * nb + 4 * (lane & 7)) * K + 64 * kb + 8 * (lane >> 3);
#pragma unroll
    for (int i = 0; i < 4; ++i) { v4u o; o.x = pk2(v[0][i], v[1][i]); o.y = pk2(v[2][i], v[3][i]); o.z = pk2(v[4][i], v[5][i]); o.w = pk2(v[6][i], v[7][i]);
        *(GAS v4u*)(dst + (size_t)i * K) = o; }
}
__device__ __forceinline__ void p0_transpose_item(const float* W, int ldw, int K, bf16* WT, int kb, int nb, int lane) { f32x4 v[8]; tr_load(W, ldw, kb, nb, lane, v); tr_store(WT, K, kb, nb, lane, v); }
__device__ __forceinline__ void row_load(const float* xrow, int lane, f32x4 (&v)[4]) {
    const GAS f32x4* xr = (const GAS f32x4*)xrow + lane;
#pragma unroll
    for (int j = 0; j < 4; ++j) v[j] = xr[64 * j];
}
__device__ __forceinline__ void rms_row_finish(const float* g, bf16* orow, int lane, f32x4 (&v)[4]) {
    float s = 0.f;
#pragma unroll
    for (int j = 0; j < 4; ++j) s += (v[j].x * v[j].x + v[j].y * v[j].y) + (v[j].z * v[j].z + v[j].w * v[j].w);
    const float rstd = rsqrtf(wave_sum(s) * (1.f / D) + EPS);
    const GAS f32x4* gr = (const GAS f32x4*)g + lane;
    GAS unsigned long long* o8 = (GAS unsigned long long*)orow + lane;
#pragma unroll
    for (int j = 0; j < 4; ++j) { const f32x4 gg = gr[64 * j]; v[j] = v[j] * rstd * gg;
        o8[64 * j] = (unsigned long long)pk2(v[j].x, v[j].y) | ((unsigned long long)pk2(v[j].z, v[j].w) << 32); }
}
__device__ __forceinline__ void rms_row_to_bf16(const float* xrow, const float* g, bf16* orow, int lane, f32x4 (&v)[4]) { row_load(xrow, lane, v); rms_row_finish(g, orow, lane, v); }

constexpr int PH_P0 = 0, PH_P1 = 1, PH_P2 = 2, PH_SCAN = 3, PH_MLOUT = 4, PH_MIX = 5, PH_WOUT = 6, PH_ROUTE = 7, PH_G1 = 8, PH_G2S = 9, PH_G2P = 10, PH_END = 11;
constexpr size_t WS_G8 = 219 * MiB;
constexpr size_t WS_H1 = 35 * MiB;
constexpr size_t WS_HN = 99 * MiB;
constexpr size_t WS_WGU = 219 * MiB;
constexpr size_t WS_WD = 19 * MiB;
constexpr size_t WS_HH = 187 * MiB;
constexpr size_t WS_Y1 = 139 * MiB;


constexpr int CV_WGU = 32 * 256, CV_LATE = 1536 + 256 + 128 + 256 + 512, CV_ITEMS = CV_WGU + CV_LATE + 32 * 128;
__device__ __forceinline__ void cv_item(const Args& a, int it, const float*& W, int& ldw, int& K, bf16*& WT, int& kb, int& nb) {
    unsigned char* ws = a.ws;
    if (it < CV_WGU) { const int e = it >> 8, q = it & 255, sub = q >> 6, r = q & 63;
        W = ((sub & 1) ? a.in[26] : a.in[25]) + (size_t)e * 1024 * 256 + (sub >> 1) * 128; ldw = 256; K = 1024; WT = (bf16*)(ws + WS_WGU) + ((size_t)e * 512 + sub * 128) * 1024; kb = r >> 2; nb = r & 3; return; }
    int r = it - CV_WGU;
    if (r < 1536) { W = a.in[17]; ldw = 3072; K = 1024; WT = (bf16*)(ws + WS_WGATE); kb = r / 96; nb = r % 96; return; } r -= 1536;
    if (r < 256) { W = a.in[14]; ldw = 1024; K = 512; WT = (bf16*)(ws + WS_WA); kb = r >> 5; nb = r & 31; return; } r -= 256;
    if (r < 128) { W = a.in[15]; ldw = 1024; K = 256; WT = (bf16*)(ws + WS_WB); kb = r >> 5; nb = r & 31; return; } r -= 128;
    if (r < 256) { W = a.in[16]; ldw = 1024; K = 512; WT = (bf16*)(ws + WS_WC); kb = r >> 5; nb = r & 31; return; } r -= 256;
    if (r < 512) { W = a.in[19]; ldw = 1024; K = 1024; WT = (bf16*)(ws + WS_WOUT); kb = r >> 5; nb = r & 31; return; } r -= 512;
    { const int e = r >> 7, q = r & 127; W = a.in[27] + (size_t)e * 256 * 1024; ldw = 1024; K = 256; WT = (bf16*)(ws + WS_WD) + (size_t)e * 1024 * 256; kb = q >> 5; nb = q & 31; }
}
__device__ __forceinline__ void bg_load(const Args& a, int it, int lane, f32x4 (&v)[8]) { const float* W; int ldw, K, kb, nb; bf16* WT; cv_item(a, it, W, ldw, K, WT, kb, nb); tr_load(W, ldw, kb, nb, lane, v); }
__device__ __forceinline__ void bg_store(const Args& a, int it, int lane, const f32x4 (&v)[8]) { const float* W; int ldw, K, kb, nb; bf16* WT; cv_item(a, it, W, ldw, K, WT, kb, nb); tr_store(WT, K, kb, nb, lane, v); }
__device__ __forceinline__ void cv_range(const Args& a, int lo, int hi, int wi, int nw, int lane) {
    for (int it = lo + wi; it < hi; it += 3 * nw) { f32x4 v0[8], v1[8], v2[8]; const int it1 = it + nw, it2 = it + 2 * nw; const bool h1 = it1 < hi, h2 = it2 < hi;
        bg_load(a, it, lane, v0); bg_load(a, h1 ? it1 : it, lane, v1); bg_load(a, h2 ? it2 : it, lane, v2);
        bg_store(a, it, lane, v0); if (h1) bg_store(a, it1, lane, v1); if (h2) bg_store(a, it2, lane, v2); }
}
constexpr size_t WS_ENT = 131 * MiB;
constexpr size_t WS_ENTW = 135 * MiB;
constexpr int TOFF_LDS = 136192;

namespace pg8 {
template <int i0, int i1, int npn_shift, int gather>
struct MoeOrder {
    const PG8_LAS int* toff; int G, c, tbeg, tend, c2;
    __device__ __forceinline__ bool next(int i, Unit& u) const {
        if (c < 0) return false;
        const int L = (i == 0) ? c : i * G + c2; const int tau = tbeg + (L >> npn_shift), pn = L & ((1 << npn_shift) - 1);
        if (tau >= tend) return false;
        int li = i0;
        while (toff[li + 1] <= tau) ++li;
        const int t = tau - toff[li], v = (li + 32) & 63, e = v & 31;
        u.pm = gather ? (v * 64 + t) : tau; u.pn = pn; u.bt = (e << npn_shift) + pn; u.aux = (tau << 16) | (v << 8) | t;
        return true;
    }
};
struct EpiGLU {
    static constexpr bool PERM = true;
    bf16_t* H; const float* entw;
    __device__ __forceinline__ void operator()(const f32x4 (&acc)[2][2][4][2], const Unit& u, int wr, int wc, int fr, int fq) const {
        const int tau = u.aux >> 16, v = (u.aux >> 8) & 255, t = u.aux & 255;
        const int col0 = u.pn * 128 + wc * 32 + 8 * fq;
        int rb = wr * 64 + fr; asm volatile("" : "+v"(rb));
        const float* wrow = entw + (size_t)v * 16384 + t * 256 + rb; bf16_t* hrow = H + ((size_t)tau * 256 + rb) * 256 + col0;
        float wv8[2][4];
#pragma unroll
        for (int ai = 0; ai < 2; ++ai)
#pragma unroll
            for (int m = 0; m < 4; ++m) wv8[ai][m] = wrow[ai * HALF + m * 16];
#pragma unroll
        for (int ai = 0; ai < 2; ++ai)
#pragma unroll
            for (int m = 0; m < 4; ++m) { const float w = wv8[ai][m];
                f32x4 h0, h1;
#pragma unroll
                for (int j = 0; j < 4; ++j) { const float g0 = acc[ai][0][m][0][j], g1 = acc[ai][0][m][1][j];
                    h0[j] = g0 * fast_sigmoid(g0) * acc[ai][1][m][0][j] * w; h1[j] = g1 * fast_sigmoid(g1) * acc[ai][1][m][1][j] * w; }
                u32x4 o; o.x = cvt_pk_bf16(h0[0], h0[1]); o.y = cvt_pk_bf16(h0[2], h0[3]); o.z = cvt_pk_bf16(h1[0], h1[1]); o.w = cvt_pk_bf16(h1[2], h1[3]);
                { unsigned long long* hp = (unsigned long long*)(hrow + (size_t)(ai * HALF + m * 16) * 256);
                  __hip_atomic_store(hp, (unsigned long long)o.x | ((unsigned long long)o.y << 32), __ATOMIC_RELAXED, __HIP_MEMORY_SCOPE_AGENT);
                  __hip_atomic_store(hp + 1, (unsigned long long)o.z | ((unsigned long long)o.w << 32), __ATOMIC_RELAXED, __HIP_MEMORY_SCOPE_AGENT); } }
    }
};
template <bool PRIMARY>
struct EpiScatter {
    static constexpr bool PERM = true;
    const int* ent; const PG8_LAS int* cnt; bf16_t* Y1; const float* H1; float* OUT;
    __device__ __forceinline__ void operator()(const f32x4 (&acc)[2][2][4][2], const Unit& u, int wr, int wc, int fr, int fq) const {
        const int v = (u.aux >> 8) & 255, t = u.aux & 255;
        int tq; asm volatile("v_mbcnt_lo_u32_b32 %0, -1, 0\n\tv_mbcnt_hi_u32_b32 %0, -1, %0" : "=v"(tq));
        const unsigned col0 = (unsigned)(u.pn * BM + wc * 32 + 8 * (tq >> 4));
        const int rb = wr * 64 + (tq & 15);
        const char* eb = (const char*)(ent + (size_t)v * 16384 + t * 256); const unsigned rb4 = (unsigned)rb * 4u; const int nv = cnt[v] - t * 256 - rb;
        unsigned tok[2][4];
#pragma unroll
        for (int ai = 0; ai < 2; ++ai)
#pragma unroll
            for (int m = 0; m < 4; ++m) tok[ai][m] = (ai * HALF + m * 16 < nv) ? *(const unsigned*)(eb + rb4 + (unsigned)(ai * HALF + m * 16) * 4u) : 0u;
#pragma unroll
        for (int ai = 0; ai < 2; ++ai)
#pragma unroll
            for (int mp = 0; mp < 2; ++mp) {
                u32x4 yv[2][2]; f32x4 hv[2][2][2];
                if (PRIMARY) {
#pragma unroll
                    for (int mm = 0; mm < 2; ++mm)
#pragma unroll
                        for (int bj = 0; bj < 2; ++bj) { const unsigned o = tok[ai][2 * mp + mm] * 1024u + col0 + bj * HALF;
                            yv[mm][bj] = *(const u32x4*)((const char*)Y1 + o * 2u); hv[mm][bj][0] = *(const f32x4*)((const char*)H1 + o * 4u); hv[mm][bj][1] = *(const f32x4*)((const char*)H1 + o * 4u + 16u); }
                }
#pragma unroll
                for (int mm = 0; mm < 2; ++mm) { const int m = 2 * mp + mm;
                    if (ai * HALF + m * 16 < nv) {
#pragma unroll
                        for (int bj = 0; bj < 2; ++bj) { const unsigned o = tok[ai][m] * 1024u + col0 + bj * HALF; const f32x4 a0 = acc[ai][bj][m][0], a1 = acc[ai][bj][m][1];
                            if (PRIMARY) { const u32x4 y = yv[mm][bj]; f32x4 t0 = hv[mm][bj][0], t1 = hv[mm][bj][1];
                                t0[0] += a0[0] + bflo(y.x); t0[1] += a0[1] + bfhi(y.x); t0[2] += a0[2] + bflo(y.y); t0[3] += a0[3] + bfhi(y.y);
                                t1[0] += a1[0] + bflo(y.z); t1[1] += a1[1] + bfhi(y.z); t1[2] += a1[2] + bflo(y.w); t1[3] += a1[3] + bfhi(y.w);
                                *(f32x4*)((char*)OUT + o * 4u) = t0; *(f32x4*)((char*)OUT + o * 4u + 16u) = t1; }
                            else { u32x4 w; w.x = cvt_pk_bf16(a0[0], a0[1]); w.y = cvt_pk_bf16(a0[2], a0[3]); w.z = cvt_pk_bf16(a1[0], a1[1]); w.w = cvt_pk_bf16(a1[2], a1[3]); *(u32x4*)((char*)Y1 + o * 2u) = w; } } } }
                asm volatile("" ::: "memory"); }
    }
};
}

__device__ __forceinline__ void route_phase(const Frame& F, const Args& a, gu32* ctl, const XcdBarrier& bar) {
    const float* ln2_g = a.in[20]; const float* w_grp = a.in[21]; const float* b_grp = a.in[22]; const float* w_er = a.in[23]; const float* b_er = a.in[24];
    const float* w_eg = a.in[25]; const float* w_eu = a.in[26]; const float* w_ed = a.in[27];
    unsigned char* ws = a.ws;
    const float* H1 = (const float*)(ws + WS_H1); bf16* HN = (bf16*)(ws + WS_HN);
    int* ENT = (int*)(ws + WS_ENT); float* ENTW = (float*)(ws + WS_ENTW);
    __syncthreads();
    cv_range(a, CV_WGU / 2, CV_WGU, F.gw, F.NGW, F_LANE);
    split_wait(bar, 3, F_TID);
    LAS float* wer = (LAS float*)F.lds;
    for (int r = F_TID; r < 4096; r += NWAVES * 64) { const f32x4 wa = *(const f32x4*)(w_er + (size_t)r * 8), wb = *(const f32x4*)(w_er + (size_t)r * 8 + 4);
        const int g = r >> 10, k = r & 1023; LAS float* d = wer + (size_t)(g * 8) * 1024 + k;
        d[0] = wa.x; d[1024] = wa.y; d[2048] = wa.z; d[3072] = wa.w; d[4096] = wb.x; d[5120] = wb.y; d[6144] = wb.z; d[7168] = wb.w; }
    __syncthreads();
    const int lane = F_LANE;
    f32x4 wgq[4][4];
#pragma unroll
    for (int jj = 0; jj < 4; ++jj)
#pragma unroll
        for (int cc = 0; cc < 4; ++cc) wgq[jj][cc] = *(const f32x4*)(w_grp + (size_t)(4 * lane + 256 * jj + cc) * 4);
    for (int mb = F.gw; mb < M; mb += 2 * F.NGW) {
        f32x4 vv[2][4];
#pragma unroll
        for (int q = 0; q < 2; ++q) { const int m = mb + q * F.NGW; if (m < M) row_load(H1 + (size_t)m * D, lane, vv[q]); }
#pragma unroll
        for (int q = 0; q < 2; ++q) { const int m = mb + q * F.NGW; if (m >= M) break;
            f32x4 (&v)[4] = vv[q];
            rms_row_finish(ln2_g, HN + (size_t)m * D, lane, v);
            float gl[4] = {0.f, 0.f, 0.f, 0.f};
#pragma unroll
            for (int jj = 0; jj < 4; ++jj)
#pragma unroll
                for (int cc = 0; cc < 4; ++cc) { const float y = v[jj][cc]; const f32x4 w4 = wgq[jj][cc]; gl[0] += y * w4.x; gl[1] += y * w4.y; gl[2] += y * w4.z; gl[3] += y * w4.w; }
#pragma unroll
            for (int j = 0; j < 4; ++j) gl[j] = wave_sum(gl[j]) + b_grp[j];
            int gi = 0; float gmax = gl[0];
#pragma unroll
            for (int j = 1; j < 4; ++j) if (gl[j] > gmax) { gmax = gl[j]; gi = j; }
            float gden = 0.f;
#pragma unroll
            for (int j = 0; j < 4; ++j) gden += __expf(gl[j] - gmax);
            const float gw = 1.f / gden;
            gi = __builtin_amdgcn_readfirstlane(gi);
            const LAS float* we = wer + (size_t)(gi * 8) * 1024 + 4 * lane;
            float el[8];
#pragma unroll
            for (int j = 0; j < 8; ++j) { float s = 0.f;
#pragma unroll
                for (int jj = 0; jj < 4; ++jj) { const f32x4 w4 = *(const LAS f32x4*)(we + j * 1024 + 256 * jj); s += (v[jj].x * w4.x + v[jj].y * w4.y) + (v[jj].z * w4.z + v[jj].w * w4.w); }
                el[j] = wave_sum(s) + b_er[gi * 8 + j]; }
            int i0 = 0; float m0 = el[0];
#pragma unroll
            for (int j = 1; j < 8; ++j) if (el[j] > m0) { m0 = el[j]; i0 = j; }
            int i1 = -1; float m1 = -INFINITY;
#pragma unroll
            for (int j = 0; j < 8; ++j) if (j != i0 && el[j] > m1) { m1 = el[j]; i1 = j; }
            const float e1 = __expf(m1 - m0), w0 = gw / (1.f + e1), w1 = gw * e1 / (1.f + e1);
            if (lane == 0) {
                const int v0 = gi * 8 + i0, v1 = 32 + gi * 8 + i1;
                const unsigned r0 = __hip_atomic_fetch_add(ctl + CW_ECNT + 64 * v0, 1u, RLX_AGENT), r1 = __hip_atomic_fetch_add(ctl + CW_ECNT + 64 * v1, 1u, RLX_AGENT);
                ENT[(size_t)v0 * 16384 + r0] = m; ENTW[(size_t)v0 * 16384 + r0] = w0;
                ENT[(size_t)v1 * 16384 + r1] = m; ENTW[(size_t)v1 * 16384 + r1] = w1;
            }
        }
    }
    split_arrive(bar, 6, F_TID);
    cv_range(a, CV_WGU + CV_LATE, CV_ITEMS, F.gw, F.NGW, F_LANE);
    split_arrive(bar, 7, F_TID);
}
__device__ __forceinline__ void moe_tile_offsets(const Frame& F, gu32* ctl) {
    LAS int* toff = (LAS int*)(F.lds + TOFF_LDS);
    __syncthreads();
    if (F_TID < 64) toff[80 + F_TID] = (int)__hip_atomic_load(ctl + CW_ECNT + 64 * F_TID, RLX_AGENT);
    __syncthreads();
    if (F_TID == 0) { int acc = 0; for (int i = 0; i < 64; ++i) { toff[i] = acc; acc += (toff[80 + ((i + 32) & 63)] + 255) >> 8; } toff[64] = acc; }
    __syncthreads();
}
constexpr int CW_SDONE = CW_ECNT + 64 * 64;
#define TOFFP ((const LAS int*)(F.lds + TOFF_LDS))
constexpr int G2LS = 528;
template <bool PRIMARY>
__device__ __forceinline__ void g2e_phase(const Frame& F, unsigned char* ws, float* OUT, int c, int G, const XcdBarrier& bar, int wait_inst) {
    LAS unsigned char* Bs = F.lds;
    const LAS int* toff = TOFFP; const LAS int* cnt = TOFFP + 80;
    const bf16* HH = (const bf16*)(ws + WS_HH); const bf16* WD = (const bf16*)(ws + WS_WD); const int* ENT = (const int*)(ws + WS_ENT);
    bf16* Y1 = (bf16*)(ws + WS_Y1); const float* H1 = (const float*)(ws + WS_H1);
    const int tid = F_TID, lane = tid & 63, i16 = lane & 15, quad = lane >> 4, w = F.wave;
    for (int u = (c >= 0 ? c : 256); u < 256; u += G) {
        const int e = u >> 3, pn = (u >> 1) & 3, hh = u & 1, v = (PRIMARY ? 0 : 32) + e, li = (v + 32) & 63;
        const int n = __builtin_amdgcn_readfirstlane(cnt[v]), hbase = __builtin_amdgcn_readfirstlane(toff[li]) * 256;
        const int half = ((((n + 1) >> 1) + 15) & ~15), rbeg = hh ? half : 0, rend = hh ? n : (half < n ? half : n);
        const int nstrip = (rend > rbeg) ? ((rend - rbeg + 15) >> 4) : 0;
        __syncthreads();
        bf16x8 af[8]; unsigned tok = 0u; int row = rbeg + 16 * w + i16;
        if (nstrip > 0) {
            const v4u* gb = (const v4u*)(WD + ((size_t)e * 1024 + pn * 256) * 256);
            v4u rb[16];
#pragma unroll
            for (int i = 0; i < 16; ++i) rb[i] = gb[tid + 512 * i];
            if (wait_inst >= 0) { split_wait(bar, wait_inst, tid); wait_inst = -1; }
            if (w < nstrip) { if (row < rend) tok = (unsigned)ENT[(size_t)v * 16384 + row];
                const bf16* hrow = HH + ((size_t)hbase + row) * 256 + 8 * quad;
#pragma unroll
                for (int ks = 0; ks < 8; ++ks) af[ks] = *(const bf16x8*)(hrow + 32 * ks); }
            const int c0 = tid >> 5, ch = tid & 31, L0 = 16 * ((c0 >> 2) & 1) + 4 * ((c0 >> 3) & 1) + (c0 & 3);
            LAS unsigned char* sb = Bs + L0 * G2LS + ch * 16;
#pragma unroll
            for (int i = 0; i < 16; ++i) *(LAS v4u*)(sb + (32 * (i >> 1) + 8 * (i & 1)) * G2LS) = rb[i];
        }
        __syncthreads();
        for (int s = w; s < nstrip; s += NWAVES) {
            const bool valid = row < rend;
            const unsigned ob = tok * 1024u + (unsigned)(pn * 256 + 8 * quad);
            v4u yv[8]; f32x4 hv[8][2];
            if (PRIMARY) {
#pragma unroll
                for (int p = 0; p < 8; ++p) { const unsigned o = ob + 32u * p; yv[p] = *(const v4u*)((const char*)Y1 + o * 2u); hv[p][0] = *(const f32x4*)((const char*)H1 + o * 4u); hv[p][1] = *(const f32x4*)((const char*)H1 + o * 4u + 16u); }
            }
            bf16x8 afn[8]; unsigned tokn = 0u; const int rown = row + 16 * NWAVES; const bool more = s + NWAVES < nstrip;
            if (!PRIMARY && more) { if (rown < rend) tokn = (unsigned)ENT[(size_t)v * 16384 + rown];
                const bf16* hrow = HH + ((size_t)hbase + rown) * 256 + 8 * quad;
#pragma unroll
                for (int ks = 0; ks < 8; ++ks) afn[ks] = *(const bf16x8*)(hrow + 32 * ks); }
            f32x4 acc[16];
#pragma unroll
            for (int nt = 0; nt < 16; ++nt) { acc[nt] = (f32x4){0.f, 0.f, 0.f, 0.f};
#pragma unroll
                for (int ks = 0; ks < 8; ++ks) acc[nt] = __builtin_amdgcn_mfma_f32_16x16x32_bf16(*(const LAS bf16x8*)(Bs + (16 * nt + i16) * G2LS + (32 * ks + 8 * quad) * 2), af[ks], acc[nt], 0, 0, 0);
                if (nt & 1) asm volatile("" ::: "memory"); }
            if (PRIMARY && more) { if (rown < rend) tokn = (unsigned)ENT[(size_t)v * 16384 + rown];
                const bf16* hrow = HH + ((size_t)hbase + rown) * 256 + 8 * quad;
#pragma unroll
                for (int ks = 0; ks < 8; ++ks) af[ks] = *(const bf16x8*)(hrow + 32 * ks); }
            if (valid) {
#pragma unroll
                for (int p = 0; p < 8; ++p) { const unsigned o = ob + 32u * p; const f32x4 a0 = acc[2 * p], a1 = acc[2 * p + 1];
                    if (PRIMARY) { const v4u y = yv[p]; f32x4 t0 = hv[p][0], t1 = hv[p][1];
                        t0[0] += a0[0] + pg8::bflo(y.x); t0[1] += a0[1] + pg8::bfhi(y.x); t0[2] += a0[2] + pg8::bflo(y.y); t0[3] += a0[3] + pg8::bfhi(y.y);
                        t1[0] += a1[0] + pg8::bflo(y.z); t1[1] += a1[1] + pg8::bfhi(y.z); t1[2] += a1[2] + pg8::bflo(y.w); t1[3] += a1[3] + pg8::bfhi(y.w);
                        *(f32x4*)((char*)OUT + o * 4u) = t0; *(f32x4*)((char*)OUT + o * 4u + 16u) = t1; }
                    else { v4u wv; wv.x = pg8::cvt_pk_bf16(a0[0], a0[1]); wv.y = pg8::cvt_pk_bf16(a0[2], a0[3]); wv.z = pg8::cvt_pk_bf16(a1[0], a1[1]); wv.w = pg8::cvt_pk_bf16(a1[2], a1[3]); *(v4u*)((char*)Y1 + o * 2u) = wv; } }
            }
            if (more) {
                if (!PRIMARY) {
#pragma unroll
                    for (int ks = 0; ks < 8; ++ks) af[ks] = afn[ks]; }
                tok = tokn; row = rown; }
        }
    }
    if (wait_inst >= 0) split_wait(bar, wait_inst, tid);
    __syncthreads();
}
#define MEGA_MOE_PHASES \
    if (IN(PH_ROUTE)) { route_phase(F, args, ctl, bar); } \
    if (IN(PH_G1)) { split_wait(bar, 6, F_TID); moe_tile_offsets(F, ctl); \
        const int tS = __builtin_amdgcn_readfirstlane(TOFFP[32]), tA = __builtin_amdgcn_readfirstlane(TOFFP[64]);     \
        const int c2 = (c - 2 * tS + F.G) % F.G;     \
        {     \
            pg8::MoeOrder<0, 64, 1, 1> S{TOFFP, F.G, c, 0, tA, c2}; \
            pg8::Gemm g{(const bf16*)(ws + WS_HN), (const bf16*)(ws + WS_WGU), 1024, 1024, (const int*)(ws + WS_ENT)}; \
            pg8::EpiGLU E{(bf16*)(ws + WS_HH), (const float*)(ws + WS_ENTW)}; \
            pg8::gemm_phase<pg8::EpiGLU, pg8::MoeOrder<0, 64, 1, 1>, true, true>(F.lds, g, S, E, F.wave); } \
        {     \
            int nsec = 0; for (int i = 0;; ++i) { const int L = (i == 0) ? c : i * F.G + c2; if (L >= 2 * tA) break; if (L < 2 * tS) ++nsec; } \
            VM_WAIT(); __syncthreads(); \
            if (F_TID == 0 && nsec > 0) { __hip_atomic_fetch_add(ctl + CW_SDONE, (unsigned)nsec, RLX_AGENT); }     \
            const int nbusy = (F.G == 256 && 2 * tA > F.G) ? (2 * tA - F.G) : 0;     \
            const int nfree = F.G - nbusy, cf = (c2 >= nbusy) ? (c2 - nbusy) : -1; \
            if (cf >= 0) { \
                if (F_TID == 0) { unsigned sp = 0; while (__hip_atomic_load(ctl + CW_SDONE, RLX_AGENT) < (unsigned)(2 * tS)) { __builtin_amdgcn_s_sleep(2); if (++sp > (1u << 22)) break; } \
                    __builtin_amdgcn_fence(__ATOMIC_ACQUIRE, "agent"); VM_WAIT(); } \
                __syncthreads(); \
            } \
            split_wait(bar, 7, F_TID);     \
            g2e_phase<false>(F, ws, args.out, cf, nfree, bar, -1); } \
        split_arrive(bar, 4, F_TID);     \
    } \
    if (IN(PH_G2P)) { moe_tile_offsets(F, ctl); g2e_phase<true>(F, ws, args.out, c, F.G, bar, 4); }
__device__ __forceinline__ void ml_scan_phase(const Frame& F, float* CL, float* NL, float* SC) {
    const int gt = F.gw * 64 + F_LANE, NT = F.NGW * 64;
    for (int e = gt; e < 16 * 16512; e += NT) {
        const int bh = e / 16512, r = e % 16512; const bool isn = r >= 16384;
        float* p0 = isn ? (NL + (size_t)bh * NCHUNK * 128 + (r - 16384)) : (CL + (size_t)bh * NCHUNK * 16384 + r);
        const size_t stride = isn ? 128 : 16384;
        float loc[NCHUNK];
#pragma unroll
        for (int c = 0; c < NCHUNK; ++c) loc[c] = p0[c * stride];
        float st = 0.f, mcur = 0.f;
#pragma unroll
        for (int c = 0; c < NCHUNK; ++c) {
            const int u = bh * NCHUNK + c;
            const float bl = SC[u * 4 + 0], ml = SC[u * 4 + 1];
            const float mnew = fmaxf(bl + mcur, ml), dec = __expf(bl + mcur - mnew), sl = __expf(ml - mnew);
            p0[c * stride] = st; st = dec * st + sl * loc[c];
            if (r == 0) SC[u * 4 + 2] = mcur;
            mcur = mnew;
        }
    }
}
#define MFMA16(a, b, c) __builtin_amdgcn_mfma_f32_16x16x32_bf16((a), (b), (c), 0, 0, 0)
__device__ __forceinline__ bf16x8 lds_frag(const LAS unsigned char* p) { return *(const LAS bf16x8*)p; }
__device__ __forceinline__ bf16x8 lds_frag_tr2(const LAS unsigned char* p0, const LAS unsigned char* p1) {
    const s16x4 a = __builtin_amdgcn_ds_read_tr16_b64_v4i16((LAS s16x4*)p0), b = __builtin_amdgcn_ds_read_tr16_b64_v4i16((LAS s16x4*)p1);
    bf16x8 r; r[0] = a[0]; r[1] = a[1]; r[2] = a[2]; r[3] = a[3]; r[4] = b[0]; r[5] = b[1]; r[6] = b[2]; r[7] = b[3]; return r;
}
__device__ __forceinline__ bf16x8 pack8(f32x4 a, f32x4 b) {
    v4u w; w.x = pg8::cvt_pk_bf16(a[0], a[1]); w.y = pg8::cvt_pk_bf16(a[2], a[3]); w.z = pg8::cvt_pk_bf16(b[0], b[1]); w.w = pg8::cvt_pk_bf16(b[2], b[3]);
    return __builtin_bit_cast(bf16x8, w);
}
__device__ __forceinline__ float bfs(short s) { return __uint_as_float(((unsigned)(unsigned short)s) << 16); }
__device__ __forceinline__ float quad_sum(float v) { v += __shfl_xor(v, 16); v += __shfl_xor(v, 32); return v; }
__device__ __forceinline__ float quad_max(float v) { v = fmaxf(v, __shfl_xor(v, 16)); v = fmaxf(v, __shfl_xor(v, 32)); return v; }

constexpr int XS = 272;
__device__ __forceinline__ void cross_job(const Frame& F, bf16* Z, const bf16* kvm, const float* qg, const float* kg, int job) {
    const int b = job >> 6, h = (job >> 4) & 3, qblk = job & 15;
    LAS unsigned char* Ks = F.lds; LAS unsigned char* Vs = F.lds + 256 * XS;
    const int tid = F_TID, lane = tid & 63, i16 = lane & 15, quad = lane >> 4;
    __syncthreads();
    for (int c = tid; c < 256 * 16; c += 512) { const int row = c >> 4, ch = c & 15;
        const v4u* src = (const v4u*)(kvm + (size_t)(b * MEM_LEN + row) * 1024 + h * 128 + ch * 8);
        const bf16x8 kr = __builtin_bit_cast(bf16x8, src[0]); float kv[8]; float ss = 0.f;
#pragma unroll
        for (int e = 0; e < 8; ++e) { kv[e] = bfs(kr[e]); ss += kv[e] * kv[e]; }
        ss += DPP_F(ss, 0xB1, 0xf); ss += DPP_F(ss, 0x4E, 0xf); ss += DPP_F(ss, 0x141, 0xf); ss += DPP_F(ss, 0x140, 0xf);
        const float rstd = rsqrtf(ss * (1.f / 128) + EPS);
        const f32x4 g0 = *(const f32x4*)(kg + ch * 8), g1 = *(const f32x4*)(kg + ch * 8 + 4);
        f32x4 a, c2; a[0] = kv[0] * rstd * g0[0]; a[1] = kv[1] * rstd * g0[1]; a[2] = kv[2] * rstd * g0[2]; a[3] = kv[3] * rstd * g0[3];
        c2[0] = kv[4] * rstd * g1[0]; c2[1] = kv[5] * rstd * g1[1]; c2[2] = kv[6] * rstd * g1[2]; c2[3] = kv[7] * rstd * g1[3];
        *(LAS bf16x8*)(Ks + row * XS + ch * 16) = pack8(a, c2); *(LAS v4u*)(Vs + row * XS + ch * 16) = src[64]; }
    __syncthreads();
    for (int pass = 0; pass < 2; ++pass) {
        const int t0 = qblk * 256 + pass * 128 + F.wave * 16;
        bf16* qrow = Z + (size_t)(b * SEQ + t0 + i16) * ZW + Z_XQ + h * 128;
        bf16x8 qf[4]; float ss = 0.f; float qv[4][8];
#pragma unroll
        for (int ks = 0; ks < 4; ++ks) { const bf16x8 raw = *(const bf16x8*)(qrow + 32 * ks + 8 * quad);
#pragma unroll
            for (int e = 0; e < 8; ++e) { qv[ks][e] = bfs(raw[e]); ss += qv[ks][e] * qv[ks][e]; } }
        const float rstd = rsqrtf(quad_sum(ss) * (1.f / 128) + EPS) * 0.08838834764831845f;
#pragma unroll
        for (int ks = 0; ks < 4; ++ks) { const f32x4 g0 = *(const f32x4*)(qg + 32 * ks + 8 * quad), g1 = *(const f32x4*)(qg + 32 * ks + 8 * quad + 4);
            f32x4 a, c2; a[0] = qv[ks][0] * rstd * g0[0]; a[1] = qv[ks][1] * rstd * g0[1]; a[2] = qv[ks][2] * rstd * g0[2]; a[3] = qv[ks][3] * rstd * g0[3];
            c2[0] = qv[ks][4] * rstd * g1[0]; c2[1] = qv[ks][5] * rstd * g1[1]; c2[2] = qv[ks][6] * rstd * g1[2]; c2[3] = qv[ks][7] * rstd * g1[3];
            qf[ks] = pack8(a, c2); }
        f32x4 s[16];
#pragma unroll
        for (int jt = 0; jt < 16; ++jt) { s[jt] = (f32x4){0.f, 0.f, 0.f, 0.f};
#pragma unroll
            for (int ks = 0; ks < 4; ++ks) s[jt] = MFMA16(lds_frag(Ks + (16 * jt + i16) * XS + (32 * ks + 8 * quad) * 2), qf[ks], s[jt]);
            if (jt & 1) asm volatile("" ::: "memory"); }
        float mx = -INFINITY;
#pragma unroll
        for (int jt = 0; jt < 16; ++jt) mx = fmaxf(mx, fmaxf(fmaxf(s[jt][0], s[jt][1]), fmaxf(s[jt][2], s[jt][3])));
        mx = quad_max(mx);
        float l = 0.f;
#pragma unroll
        for (int jt = 0; jt < 16; ++jt) {
#pragma unroll
            for (int r = 0; r < 4; ++r) { s[jt][r] = __expf(s[jt][r] - mx); l += s[jt][r]; } }
        l = quad_sum(l);
        f32x4 o[8];
#pragma unroll
        for (int dt = 0; dt < 8; ++dt) o[dt] = (f32x4){0.f, 0.f, 0.f, 0.f};
#pragma unroll
        for (int kk = 0; kk < 8; ++kk) { const bf16x8 pf = pack8(s[2 * kk], s[2 * kk + 1]);
            const LAS unsigned char* vb = Vs + (32 * kk + 4 * quad + (i16 >> 2)) * XS + (4 * (i16 & 3)) * 2;
#pragma unroll
            for (int dt = 0; dt < 8; ++dt) o[dt] = MFMA16(lds_frag_tr2(vb + dt * 32, vb + 16 * XS + dt * 32), pf, o[dt]);
            asm volatile("" ::: "memory"); }
        const float inv = 1.f / l;
#pragma unroll
        for (int dt = 0; dt < 8; ++dt) { uint2 w; w.x = pg8::cvt_pk_bf16(o[dt][0] * inv, o[dt][1] * inv); w.y = pg8::cvt_pk_bf16(o[dt][2] * inv, o[dt][3] * inv);
            *(uint2*)(qrow + 16 * dt + 4 * quad) = w; }
    }
}

constexpr int DS = 144;
struct DilUnit { int b, g, h, r, res, blk; };
__device__ __forceinline__ DilUnit dil_decode(int u) {
    DilUnit d; const int rb = u & 31; d.h = (u >> 5) & 3; d.g = (u >> 7) % 3; d.b = u / 384;
    const int lr = (d.g == 0) ? 0 : (d.g == 1 ? 2 : 4), nblk = 32 >> lr; d.r = 1 << lr; d.res = rb / nblk; d.blk = rb % nblk; return d;
}
struct DilPre { v4u kw[4], vw[4]; bf16x8 qraw[2]; f32x4 kg0, kg1; };
__device__ __forceinline__ void dil_load(const bf16* Z, const float* kg, const DilUnit& d, int tid, int wave, DilPre& p) {
    const int colk = Z_DK + d.g * 256 + d.h * 64, colv = Z_DV + d.g * 256 + d.h * 64, colq = Z_DQ + d.g * 256 + d.h * 64;
#pragma unroll
    for (int it = 0; it < 4; ++it) { const int c = tid + 512 * it, j = c >> 3, ch = c & 7, ak0 = 128 * (d.blk - 1) + j, ak = ak0 < 0 ? 0 : ak0;
        const bf16* rowp = Z + (size_t)(d.b * SEQ + ak * d.r + d.res) * ZW; p.kw[it] = *(const v4u*)(rowp + colk + ch * 8); p.vw[it] = *(const v4u*)(rowp + colv + ch * 8); }
    const int lane = tid & 63, i16 = lane & 15, quad = lane >> 4, aq = 128 * d.blk + 16 * wave + i16;
    const bf16* qrow = Z + (size_t)(d.b * SEQ + aq * d.r + d.res) * ZW + colq;
#pragma unroll
    for (int ks = 0; ks < 2; ++ks) p.qraw[ks] = *(const bf16x8*)(qrow + 32 * ks + 8 * quad);
    p.kg0 = *(const f32x4*)(kg + d.g * 64 + (tid & 7) * 8); p.kg1 = *(const f32x4*)(kg + d.g * 64 + (tid & 7) * 8 + 4);
}
__device__ __forceinline__ void dil_stage(LAS unsigned char* Ks, LAS unsigned char* Vs, const DilUnit& d, int tid, const DilPre& p) {
    const f32x4 g0 = p.kg0, g1 = p.kg1;
#pragma unroll
    for (int it = 0; it < 4; ++it) { const int c = tid + 512 * it, j = c >> 3, ch = c & 7; const bool ok = d.blk > 0 || j >= 128;
        const v4u kwv = ok ? p.kw[it] : (v4u){0u, 0u, 0u, 0u}, vwv = ok ? p.vw[it] : (v4u){0u, 0u, 0u, 0u};
        const bf16x8 kr = __builtin_bit_cast(bf16x8, kwv); float kv[8]; float ss = 0.f;
#pragma unroll
        for (int e = 0; e < 8; ++e) { kv[e] = bfs(kr[e]); ss += kv[e] * kv[e]; }
        ss += DPP_F(ss, 0xB1, 0xf); ss += DPP_F(ss, 0x4E, 0xf); ss += DPP_F(ss, 0x141, 0xf);
        const float rstd = rsqrtf(ss * (1.f / 64) + EPS);
        f32x4 a, c2; a[0] = kv[0] * rstd * g0[0]; a[1] = kv[1] * rstd * g0[1]; a[2] = kv[2] * rstd * g0[2]; a[3] = kv[3] * rstd * g0[3];
        c2[0] = kv[4] * rstd * g1[0]; c2[1] = kv[5] * rstd * g1[1]; c2[2] = kv[6] * rstd * g1[2]; c2[3] = kv[7] * rstd * g1[3];
        *(LAS bf16x8*)(Ks + j * DS + ch * 16) = pack8(a, c2); *(LAS v4u*)(Vs + j * DS + ch * 16) = vwv; }
}
__device__ __forceinline__ void dil_compute(const LAS unsigned char* Ks, const LAS unsigned char* Vs, bf16* Z, const f32x4 (&qgv)[2][2], float* LSE, const DilUnit& d, int tid, int w, const bf16x8 (&qraw)[2]) {
    const int lane = tid & 63, i16 = lane & 15, quad = lane >> 4, g = d.g, blk = d.blk;
    const int aq = 128 * blk + 16 * w + i16;
    const int mrow = d.b * SEQ + aq * d.r + d.res;
    bf16* qrow = Z + (size_t)mrow * ZW + Z_DQ + g * 256 + d.h * 64;
    bf16x8 qf[2]; { float qv[2][8]; float ss = 0.f;
#pragma unroll
        for (int ks = 0; ks < 2; ++ks) {
#pragma unroll
            for (int e = 0; e < 8; ++e) { qv[ks][e] = bfs(qraw[ks][e]); ss += qv[ks][e] * qv[ks][e]; } }
        const float rstd = rsqrtf(quad_sum(ss) * (1.f / 64) + EPS) * 0.125f;
#pragma unroll
        for (int ks = 0; ks < 2; ++ks) { const f32x4 g0 = qgv[ks][0], g1 = qgv[ks][1];
            f32x4 a, c2; a[0] = qv[ks][0] * rstd * g0[0]; a[1] = qv[ks][1] * rstd * g0[1]; a[2] = qv[ks][2] * rstd * g0[2]; a[3] = qv[ks][3] * rstd * g0[3];
            c2[0] = qv[ks][4] * rstd * g1[0]; c2[1] = qv[ks][5] * rstd * g1[1]; c2[2] = qv[ks][6] * rstd * g1[2]; c2[3] = qv[ks][7] * rstd * g1[3];
            qf[ks] = pack8(a, c2); } }
    f32x4 s[10]; float mx = -INFINITY;
#pragma unroll
    for (int dj = 0; dj < 9; ++dj) { s[dj] = (f32x4){0.f, 0.f, 0.f, 0.f};
#pragma unroll
        for (int ks = 0; ks < 2; ++ks) s[dj] = MFMA16(lds_frag(Ks + (16 * (w + dj) + i16) * DS + (32 * ks + 8 * quad) * 2), qf[ks], s[dj]);
#pragma unroll
        for (int rg = 0; rg < 4; ++rg) { const int jj = 16 * dj + 4 * quad + rg; const bool ok = (jj >= i16) && (jj <= i16 + 128) && (blk > 0 || 16 * w + jj >= 128);
            s[dj][rg] = ok ? s[dj][rg] : -INFINITY; mx = fmaxf(mx, s[dj][rg]); } }
    mx = quad_max(mx);
    float l = 0.f;
#pragma unroll
    for (int dj = 0; dj < 9; ++dj)
#pragma unroll
        for (int rg = 0; rg < 4; ++rg) { s[dj][rg] = __expf(s[dj][rg] - mx); l += s[dj][rg]; }
    l = quad_sum(l);
    s[9] = (f32x4){0.f, 0.f, 0.f, 0.f};
    f32x4 o[4];
#pragma unroll
    for (int dt = 0; dt < 4; ++dt) o[dt] = (f32x4){0.f, 0.f, 0.f, 0.f};
#pragma unroll
    for (int kk = 0; kk < 5; ++kk) { const bf16x8 pf = pack8(s[2 * kk], s[2 * kk + 1]);
        const LAS unsigned char* vb = Vs + (16 * w + 32 * kk + 4 * quad + (i16 >> 2)) * DS + (4 * (i16 & 3)) * 2;
#pragma unroll
        for (int dt = 0; dt < 4; ++dt) o[dt] = MFMA16(lds_frag_tr2(vb + dt * 32, vb + 16 * DS + dt * 32), pf, o[dt]); }
    const float inv = 1.f / l;
#pragma unroll
    for (int dt = 0; dt < 4; ++dt) { uint2 wv; wv.x = pg8::cvt_pk_bf16(o[dt][0] * inv, o[dt][1] * inv); wv.y = pg8::cvt_pk_bf16(o[dt][2] * inv, o[dt][3] * inv);
        *(uint2*)(qrow + 16 * dt + 4 * quad) = wv; }
    LSE[((size_t)g * M + mrow) * 4 + d.h] = mx + __logf(l);
}
__device__ __forceinline__ void dil_phase(const Frame& F, bf16* Z, const float* qg, const float* kg, float* LSE, int c) {
    LAS unsigned char* Ks = F.lds; LAS unsigned char* Vs = F.lds + 256 * DS;
    const int tid = F_TID;
    __syncthreads();
    if (tid < 128) *(LAS v4u*)(Vs + (256 + (tid >> 3)) * DS + (tid & 7) * 16) = (v4u){0u, 0u, 0u, 0u};
    DilUnit cur = dil_decode(c < 1536 ? c : 0); DilPre pre; dil_load(Z, kg, cur, tid, F.wave, pre);
    for (int u = c; u < 1536; u += F.G) {
        __syncthreads();
        dil_stage(Ks, Vs, cur, tid, pre);
        bf16x8 qr[2] = {pre.qraw[0], pre.qraw[1]};
        __syncthreads();
        const DilUnit now = cur; const int un = u + F.G;
        f32x4 qgv[2][2];
#pragma unroll
        for (int ks = 0; ks < 2; ++ks) { qgv[ks][0] = *(const f32x4*)(qg + now.g * 64 + 32 * ks + 8 * ((tid & 63) >> 4)); qgv[ks][1] = *(const f32x4*)(qg + now.g * 64 + 32 * ks + 8 * ((tid & 63) >> 4) + 4); }
        cur = dil_decode(un < 1536 ? un : u); dil_load(Z, kg, cur, tid, F.wave, pre);
        asm volatile("" ::: "memory");
        dil_compute(Ks, Vs, Z, qgv, LSE, now, tid, F.wave, qr);
    }
}
__device__ __forceinline__ void dil_merge_phase(const Frame& F, bf16* Z, const float* LSE) {
    const int gt = F.gw * 64 + F_LANE, NT = F.NGW * 64;
    for (int it0 = gt; it0 < M * 32; it0 += 2 * NT) {
        float l[2][3]; bf16x8 av[2][3]; bf16* pp[2];
#pragma unroll
        for (int q = 0; q < 2; ++q) { const int it = it0 + q * NT; const int m = (it < M * 32) ? (it >> 5) : 0, h = (it >> 3) & 3, ch = it & 7;
            l[q][0] = LSE[((size_t)0 * M + m) * 4 + h]; l[q][1] = LSE[((size_t)1 * M + m) * 4 + h]; l[q][2] = LSE[((size_t)2 * M + m) * 4 + h];
            pp[q] = Z + (size_t)m * ZW + Z_DQ + h * 64 + ch * 8;
            av[q][0] = *(const bf16x8*)pp[q]; av[q][1] = *(const bf16x8*)(pp[q] + 256); av[q][2] = *(const bf16x8*)(pp[q] + 512); }
#pragma unroll
        for (int q = 0; q < 2; ++q) { if (it0 + q * NT >= M * 32) break;
            const float mxl = fmaxf(l[q][0], fmaxf(l[q][1], l[q][2])), e0 = __expf(l[q][0] - mxl), e1 = __expf(l[q][1] - mxl), e2 = __expf(l[q][2] - mxl), inv = 1.f / (e0 + e1 + e2);
            f32x4 x, y;
#pragma unroll
            for (int e = 0; e < 4; ++e) { x[e] = (e0 * bfs(av[q][0][e]) + e1 * bfs(av[q][1][e]) + e2 * bfs(av[q][2][e])) * inv; y[e] = (e0 * bfs(av[q][0][e + 4]) + e1 * bfs(av[q][1][e + 4]) + e2 * bfs(av[q][2][e + 4])) * inv; }
            *(bf16x8*)pp[q] = pack8(x, y); }
    }
}

constexpr int MS = 272;
__device__ __forceinline__ void conv_silu8(const bf16* Z, const float* cw, int m, int c0, float (&y)[8]) {
    const int t = m % SEQ;
#pragma unroll
    for (int e = 0; e < 8; ++e) y[e] = 0.f;
#pragma unroll
    for (int j = 0; j < 4; ++j) { if (t - 3 + j >= 0) { const bf16x8 z = *(const bf16x8*)(Z + (size_t)(m - 3 + j) * ZW + c0);
            const f32x4 w0 = *(const f32x4*)(cw + j * 1024 + c0), w1 = *(const f32x4*)(cw + j * 1024 + c0 + 4);
            y[0] += w0[0] * bfs(z[0]); y[1] += w0[1] * bfs(z[1]); y[2] += w0[2] * bfs(z[2]); y[3] += w0[3] * bfs(z[3]);
            y[4] += w1[0] * bfs(z[4]); y[5] += w1[1] * bfs(z[5]); y[6] += w1[2] * bfs(z[6]); y[7] += w1[3] * bfs(z[7]); } }
#pragma unroll
    for (int e = 0; e < 8; ++e) y[e] = y[e] * pg8::fast_sigmoid(y[e]);
}
__device__ __forceinline__ void conv_silu8x4(const bf16* Z, const float* cw, int m, int c0, float (&y)[4][8]) {
    const int t = m % SEQ;
    f32x4 w[4][2];
#pragma unroll
    for (int j = 0; j < 4; ++j) { w[j][0] = *(const f32x4*)(cw + j * 1024 + c0); w[j][1] = *(const f32x4*)(cw + j * 1024 + c0 + 4); }
    bf16x8 z[7];
#pragma unroll
    for (int i = 0; i < 7; ++i) { z[i] = (bf16x8){0, 0, 0, 0, 0, 0, 0, 0}; if (t - 3 + i >= 0) z[i] = *(const bf16x8*)(Z + (size_t)(m - 3 + i) * ZW + c0); }
#pragma unroll
    for (int r = 0; r < 4; ++r) {
#pragma unroll
        for (int e = 0; e < 8; ++e) { float acc = 0.f;
#pragma unroll
            for (int j = 0; j < 4; ++j) acc += w[j][e >> 2][e & 3] * bfs(z[r + j][e]);
            y[r][e] = acc * pg8::fast_sigmoid(acc); } }
}
__device__ __forceinline__ void wave_scan_sum2(float v0, float v1, int lane, float& p0, float& p1) {
    float p = v0 + v1;
#pragma unroll
    for (int off = 1; off < 64; off <<= 1) { const float t = __shfl_up(p, off); if (lane >= off) p += t; }
    p1 = p; p0 = p - v1;
}
__device__ __forceinline__ void wave_scan_max2(float v0, float v1, int lane, float& p0, float& p1) {
    float p = fmaxf(v0, v1);
#pragma unroll
    for (int off = 1; off < 64; off <<= 1) { const float t = __shfl_up(p, off); if (lane >= off) p = fmaxf(p, t); }
    const float prev = __shfl_up(p, 1);
    p1 = p; p0 = (lane > 0) ? fmaxf(prev, v0) : v0;
}
__device__ __forceinline__ void ml_local_fast(const Frame& F, const bf16* Z, const float* cw, const float* ifg, float* CL, float* NL, float* SC, int u) {
    LAS unsigned char* Ks = F.lds; LAS unsigned char* Vs = F.lds + 128 * MS; LAS float* av = (LAS float*)(F.lds + 256 * MS); LAS float* npart = av + 128;
    const int c = u % NCHUNK, h = (u / NCHUNK) % 4, b = u / (NCHUNK * 4), tid = F_TID, lane = tid & 63, i16 = lane & 15, quad = lane >> 4;
    const int m0 = b * SEQ + c * 128;
    __syncthreads();
    if (F.wave == 0) {
        const float f0 = log_sigmoid_(ifg[(size_t)(m0 + 2 * lane) * 8 + 4 + h]), f1 = log_sigmoid_(ifg[(size_t)(m0 + 2 * lane + 1) * 8 + 4 + h]);
        float b0, b1; wave_scan_sum2(f0, f1, lane, b0, b1);
        const float bl = __shfl(b1, 63);
        const float le0 = bl - b0 + ifg[(size_t)(m0 + 2 * lane) * 8 + h], le1 = bl - b1 + ifg[(size_t)(m0 + 2 * lane + 1) * 8 + h];
        const float ml = wave_max(fmaxf(le0, le1));
        av[2 * lane] = __expf(le0 - ml); av[2 * lane + 1] = __expf(le1 - ml);
        if (lane == 0) { SC[u * 4 + 0] = bl; SC[u * 4 + 1] = ml; }
    }
    __syncthreads();
    { const int sg = tid >> 4, ch = tid & 15; float y[4][8];
      conv_silu8x4(Z, cw, m0 + 4 * sg, 512 + h * 128 + ch * 8, y);
#pragma unroll
      for (int r = 0; r < 4; ++r) { const int s = 4 * sg + r; const float sc = 0.08838834764831845f * av[s];
          f32x4 a, c2; a[0] = y[r][0] * sc; a[1] = y[r][1] * sc; a[2] = y[r][2] * sc; a[3] = y[r][3] * sc; c2[0] = y[r][4] * sc; c2[1] = y[r][5] * sc; c2[2] = y[r][6] * sc; c2[3] = y[r][7] * sc;
          *(LAS bf16x8*)(Ks + s * MS + ch * 16) = pack8(a, c2);
          *(LAS v4u*)(Vs + s * MS + ch * 16) = *(const v4u*)(Z + (size_t)(m0 + s) * ZW + Z_MV + h * 128 + ch * 8); } }
    __syncthreads();
    { const int d = tid & 127, sq = tid >> 7; float acc = 0.f;
      for (int s = sq * 32; s < sq * 32 + 32; ++s) acc += bfs(*(const LAS short*)(Ks + s * MS + d * 2));
      npart[sq * 128 + d] = acc; }
    const int w = F.wave;
    f32x4 acc[8];
#pragma unroll
    for (int dt = 0; dt < 8; ++dt) acc[dt] = (f32x4){0.f, 0.f, 0.f, 0.f};
#pragma unroll
    for (int ks = 0; ks < 4; ++ks) {
        const int rbase = 32 * ks + 8 * quad + (i16 >> 2), cb = 4 * (i16 & 3) * 2;
        const bf16x8 af = lds_frag_tr2(Vs + rbase * MS + 16 * w * 2 + cb, Vs + (rbase + 4) * MS + 16 * w * 2 + cb);
#pragma unroll
        for (int dt = 0; dt < 8; ++dt) acc[dt] = MFMA16(af, lds_frag_tr2(Ks + rbase * MS + dt * 32 + cb, Ks + (rbase + 4) * MS + dt * 32 + cb), acc[dt]); }
    float* ct = CL + (size_t)u * 16384;
#pragma unroll
    for (int dt = 0; dt < 8; ++dt)
#pragma unroll
        for (int rg = 0; rg < 4; ++rg) ct[(16 * w + 4 * quad + rg) * 128 + 16 * dt + i16] = acc[dt][rg];
    __syncthreads();
    if (tid < 128) NL[(size_t)u * 128 + tid] = (npart[tid] + npart[128 + tid]) + (npart[256 + tid] + npart[384 + tid]);
}
__device__ __forceinline__ void ml_out_fast(const Frame& F, const bf16* Z, const float* cw, const float* ifg, const float* CP, const float* NP, const float* SC, const float* ng, bf16* HA, int u, const XcdBarrier& bar, int wait_inst) {
    LAS unsigned char* Qs = F.lds; LAS unsigned char* Ks = Qs + 128 * MS; LAS unsigned char* Vs = Ks + 128 * MS; LAS unsigned char* Cs = Vs + 128 * MS;
    LAS float* gv = (LAS float*)(Cs + 144 * MS); LAS float* cmx = gv + 128; LAS float* bv = cmx + 128;
    const int c = u % NCHUNK, h = (u / NCHUNK) % 4, b = u / (NCHUNK * 4), tid = F_TID, lane = tid & 63, i16 = lane & 15, quad = lane >> 4;
    const int m0 = b * SEQ + c * 128;
    float mprev = 0.f;
    __syncthreads();
#define ML_OUT_GATES() do { mprev = SC[u * 4 + 2]; if (F.wave == 0) { \
        const float f0 = log_sigmoid_(ifg[(size_t)(m0 + 2 * lane) * 8 + 4 + h]), f1 = log_sigmoid_(ifg[(size_t)(m0 + 2 * lane + 1) * 8 + 4 + h]); \
        float b0, b1; wave_scan_sum2(f0, f1, lane, b0, b1); \
        const float g0 = ifg[(size_t)(m0 + 2 * lane) * 8 + h] - b0, g1 = ifg[(size_t)(m0 + 2 * lane + 1) * 8 + h] - b1; \
        float c0, c1; wave_scan_max2(g0, g1, lane, c0, c1); \
        gv[2 * lane] = g0; gv[2 * lane + 1] = g1; cmx[2 * lane] = fmaxf(c0, mprev); cmx[2 * lane + 1] = fmaxf(c1, mprev); bv[2 * lane] = b0; bv[2 * lane + 1] = b1; } } while (0)
    if (wait_inst < 0) ML_OUT_GATES();
    { const int sg = tid >> 4, ch = tid & 15; float y[4][8];
      conv_silu8x4(Z, cw, m0 + 4 * sg, h * 128 + ch * 8, y);
#pragma unroll
      for (int r = 0; r < 4; ++r) { f32x4 a, c2; a[0] = y[r][0]; a[1] = y[r][1]; a[2] = y[r][2]; a[3] = y[r][3]; c2[0] = y[r][4]; c2[1] = y[r][5]; c2[2] = y[r][6]; c2[3] = y[r][7];
          *(LAS bf16x8*)(Qs + (4 * sg + r) * MS + ch * 16) = pack8(a, c2); }
      conv_silu8x4(Z, cw, m0 + 4 * sg, 512 + h * 128 + ch * 8, y);
#pragma unroll
      for (int r = 0; r < 4; ++r) { const float sc = 0.08838834764831845f; f32x4 a, c2; a[0] = y[r][0] * sc; a[1] = y[r][1] * sc; a[2] = y[r][2] * sc; a[3] = y[r][3] * sc; c2[0] = y[r][4] * sc; c2[1] = y[r][5] * sc; c2[2] = y[r][6] * sc; c2[3] = y[r][7] * sc;
          *(LAS bf16x8*)(Ks + (4 * sg + r) * MS + ch * 16) = pack8(a, c2); }
#pragma unroll
      for (int r = 0; r < 4; ++r) { const int s = 4 * sg + r; *(LAS v4u*)(Vs + s * MS + ch * 16) = *(const v4u*)(Z + (size_t)(m0 + s) * ZW + Z_MV + h * 128 + ch * 8); }
      if (wait_inst >= 0) { split_wait(bar, wait_inst, tid); ML_OUT_GATES(); }
#pragma unroll
      for (int r = 0; r < 4; ++r) { const int s = 4 * sg + r;
          const f32x4 p0 = *(const f32x4*)(CP + (size_t)u * 16384 + s * 128 + ch * 8), p1 = *(const f32x4*)(CP + (size_t)u * 16384 + s * 128 + ch * 8 + 4);
          *(LAS bf16x8*)(Cs + s * MS + ch * 16) = pack8(p0, p1); } }
#undef ML_OUT_GATES
    for (int it = tid; it < 16 * 16; it += 512) { const int rr = it >> 4, ch = it & 15;
        f32x4 p0 = (f32x4){0.f, 0.f, 0.f, 0.f}, p1 = p0;
        if (rr == 0) { p0 = *(const f32x4*)(NP + (size_t)u * 128 + ch * 8); p1 = *(const f32x4*)(NP + (size_t)u * 128 + ch * 8 + 4); }
        *(LAS bf16x8*)(Cs + (128 + rr) * MS + ch * 16) = pack8(p0, p1); }
    __syncthreads();
    const int w = F.wave, t = 16 * w + i16;
    bf16x8 qf[4];
#pragma unroll
    for (int ks = 0; ks < 4; ++ks) qf[ks] = lds_frag(Qs + t * MS + (32 * ks + 8 * quad) * 2);
    f32x4 acc[9];
#pragma unroll
    for (int et = 0; et < 9; ++et) { acc[et] = (f32x4){0.f, 0.f, 0.f, 0.f};
#pragma unroll
        for (int ks = 0; ks < 4; ++ks) acc[et] = MFMA16(lds_frag(Cs + (16 * et + i16) * MS + (32 * ks + 8 * quad) * 2), qf[ks], acc[et]); }
    const float cm = cmx[t], winter = __expf(mprev - cm);
    const float qn = __shfl(acc[8][0], i16);
#pragma unroll
    for (int et = 0; et < 8; ++et) acc[et] = acc[et] * winter;
    float den = winter * qn;
    f32x4 sv[8]; float dsum = 0.f;
#pragma unroll
    for (int js = 0; js < 8; ++js) { sv[js] = (f32x4){0.f, 0.f, 0.f, 0.f};
        if (js <= w) {
#pragma unroll
            for (int ks = 0; ks < 4; ++ks) sv[js] = MFMA16(lds_frag(Ks + (16 * js + i16) * MS + (32 * ks + 8 * quad) * 2), qf[ks], sv[js]);
#pragma unroll
            for (int rg = 0; rg < 4; ++rg) { const int s = 16 * js + 4 * quad + rg; const float wgt = (s <= t) ? __expf(gv[s] - cm) : 0.f; sv[js][rg] *= wgt; dsum += sv[js][rg]; } } }
    den += quad_sum(dsum);
#pragma unroll
    for (int kk = 0; kk < 4; ++kk) { if (2 * kk <= w) { const bf16x8 pf = pack8(sv[2 * kk], sv[2 * kk + 1]);
            const LAS unsigned char* vb = Vs + (32 * kk + 4 * quad + (i16 >> 2)) * MS + (4 * (i16 & 3)) * 2;
#pragma unroll
            for (int et = 0; et < 8; ++et) acc[et] = MFMA16(lds_frag_tr2(vb + et * 32, vb + 16 * MS + et * 32), pf, acc[et]); } }
    const float dn = fmaxf(fabsf(den), __expf(-bv[t] - cm)), inv = 1.f / dn;
    float ss = 0.f;
#pragma unroll
    for (int et = 0; et < 8; ++et) { acc[et] = acc[et] * inv; ss += (acc[et][0] * acc[et][0] + acc[et][1] * acc[et][1]) + (acc[et][2] * acc[et][2] + acc[et][3] * acc[et][3]); }
    const float rstd = rsqrtf(quad_sum(ss) * (1.f / 128) + EPS);
    const bf16* mo = Z + (size_t)(m0 + t) * ZW + Z_MO + h * 128; bf16* op = (bf16*)mo;
    uint2 mwv[8]; f32x4 ggv[8];
#pragma unroll
    for (int et = 0; et < 8; ++et) { const int e0 = 16 * et + 4 * quad; mwv[et] = *(const uint2*)(mo + e0); ggv[et] = *(const f32x4*)(ng + h * 128 + e0); }
#pragma unroll
    for (int et = 0; et < 8; ++et) { const int e0 = 16 * et + 4 * quad; const uint2 mw = mwv[et]; const f32x4 gg = ggv[et];
        const float o0 = acc[et][0] * rstd * gg[0] * pg8::fast_sigmoid(pg8::bflo(mw.x)), o1 = acc[et][1] * rstd * gg[1] * pg8::fast_sigmoid(pg8::bfhi(mw.x));
        const float o2 = acc[et][2] * rstd * gg[2] * pg8::fast_sigmoid(pg8::bflo(mw.y)), o3 = acc[et][3] * rstd * gg[3] * pg8::fast_sigmoid(pg8::bfhi(mw.y));
        uint2 wv; wv.x = pg8::cvt_pk_bf16(o0, o1); wv.y = pg8::cvt_pk_bf16(o2, o3); *(uint2*)(op + e0) = wv; }
}
#define MEGA_TOKEN_MIXER_PHASES \
    if (IN(PH_P2)) { \
        for (int u = c; u < 512; u += F.G) ml_local_fast(F, Z, args.in[4], (const float*)(ws + WS_IFG), (float*)(ws + WS_CL), (float*)(ws + WS_NL), (float*)(ws + WS_MSC), u); \
        split_arrive(bar, 0, F_TID);                              \
        for (int job = c; job < 256; job += F.G) cross_job(F, Z, (const bf16*)(ws + WS_KVM), args.in[12], args.in[13], job); \
        dil_phase(F, Z, args.in[8], args.in[9], (float*)(ws + WS_LSE), c); \
        split_arrive(bar, 1, F_TID);                              \
    } \
    if (IN(PH_SCAN)) { split_wait(bar, 0, F_TID); ml_scan_phase(F, (float*)(ws + WS_CL), (float*)(ws + WS_NL), (float*)(ws + WS_MSC)); \
        split_wait(bar, 1, F_TID); dil_merge_phase(F, Z, (const float*)(ws + WS_LSE)); \
        split_arrive(bar, 5, F_TID);                              } \
    if (IN(PH_MLOUT)) { int wi_ = 5; \
        for (int u = c; u < 512; u += F.G) { ml_out_fast(F, Z, args.in[4], (const float*)(ws + WS_IFG), (const float*)(ws + WS_CL), (const float*)(ws + WS_NL), (const float*)(ws + WS_MSC), args.in[7], (bf16*)(ws + WS_HA), u, bar, wi_); wi_ = -1; } \
        if (wi_ >= 0) split_wait(bar, 5, F_TID); \
        split_arrive(bar, 2, F_TID);                              \
    }
__device__ __forceinline__ void p0_prologue(const Frame& F, const Args& a) {
    const float* x = a.in[0]; const float* mem = a.in[1]; const float* ln1_g = a.in[2]; const float* w_in = a.in[3];
    const float* m_i_b = a.in[5]; const float* m_f_b = a.in[6]; const float* mem_norm_g = a.in[10]; const float* w_mem_kv = a.in[11];
    unsigned char* ws = a.ws;
    bf16* XN = (bf16*)a.out; float* IFG = (float*)(ws + WS_IFG);
    LAS float* wif = (LAS float*)(F.lds + 8 * 8448);
    for (int k = F_TID; k < 1024; k += NWAVES * 64) { const f32x4 wa = *(const f32x4*)(w_in + (size_t)k * IN_TOTAL + 2048), wb = *(const f32x4*)(w_in + (size_t)k * IN_TOTAL + 2052);
        wif[k] = wa.x; wif[1024 + k] = wa.y; wif[2048 + k] = wa.z; wif[3072 + k] = wa.w; wif[4096 + k] = wb.x; wif[5120 + k] = wb.y; wif[6144 + k] = wb.z; wif[7168 + k] = wb.w; }
    __syncthreads();
    constexpr int I0 = 16 * 64, I1 = 16 * 88, I3 = 16 * 32;
    constexpr int NITEMS = I0 + I1 + I3;
    for (int it = F.gw; it < NITEMS; it += F.NGW) {
        int r = it;
        if (r < I0) { p0_transpose_item(w_in, IN_TOTAL, 1024, (bf16*)(ws + WS_W1Z), r / 64, r % 64, F_LANE); continue; } r -= I0;
        if (r < I1) { p0_transpose_item(w_in + 2056, IN_TOTAL, 1024, (bf16*)(ws + WS_W1Z) + (size_t)2048 * 1024, r / 88, r % 88, F_LANE); continue; } r -= I1;
        p0_transpose_item(w_mem_kv, 1024, 1024, (bf16*)(ws + WS_WKV), r / 32, r % 32, F_LANE);
    }
    cv_range(a, CV_WGU, CV_WGU + CV_LATE, F.gw, F.NGW, F_LANE);
    for (int mb = F.gw; mb < M; mb += 4 * F.NGW) {
        f32x4 vv[4][4];
#pragma unroll
        for (int q = 0; q < 4; ++q) { const int m = mb + q * F.NGW; if (m < M) row_load(x + (size_t)m * D, F_LANE, vv[q]); }
#pragma unroll
        for (int q = 0; q < 4; ++q) { const int m = mb + q * F.NGW; if (m >= M) break;
            f32x4 (&v)[4] = vv[q];
            rms_row_finish(ln1_g, XN + (size_t)m * D, F_LANE, v);
            float acc[8];
#pragma unroll
            for (int j = 0; j < 8; ++j) { float s = 0.f;
#pragma unroll
                for (int jj = 0; jj < 4; ++jj) { const f32x4 w4 = *(const LAS f32x4*)(wif + j * 1024 + 4 * F_LANE + 256 * jj); s += (v[jj].x * w4.x + v[jj].y * w4.y) + (v[jj].z * w4.z + v[jj].w * w4.w); }
                acc[j] = wave_sum(s); }
            if (F_LANE == 0) {
                f32x4 o0, o1;
                o0.x = acc[0] + m_i_b[0]; o0.y = acc[1] + m_i_b[1]; o0.z = acc[2] + m_i_b[2]; o0.w = acc[3] + m_i_b[3];
                o1.x = acc[4] + m_f_b[0]; o1.y = acc[5] + m_f_b[1]; o1.z = acc[6] + m_f_b[2]; o1.w = acc[7] + m_f_b[3];
                *(f32x4*)(IFG + (size_t)m * 8) = o0; *(f32x4*)(IFG + (size_t)m * 8 + 4) = o1;
            }
        }
    }
    for (int m = F.gw; m < MROWS; m += F.NGW) { f32x4 v[4]; rms_row_to_bf16(mem + (size_t)m * D, mem_norm_g, (bf16*)(ws + WS_MEMN) + (size_t)m * D, F_LANE, v); }
}

__device__ __forceinline__ void kv_norm_tile(const Frame& F, bf16* KVM, const float* kg, int pm, int pn) {
    VM_WAIT(); __syncthreads();
    const float g0 = kg[2 * F_LANE], g1 = kg[2 * F_LANE + 1];
    for (int it = F.wave; it < 512; it += NWAVES) {
        const int row = pm * 256 + (it >> 1), h = pn * 2 + (it & 1);
        unsigned* p = (unsigned*)(KVM + (size_t)row * 1024 + h * 128) + F_LANE;
        const unsigned w = __hip_atomic_load(p, RLX_AGENT);
        const float a = pg8::bflo(w), b = pg8::bfhi(w);
        const float rstd = rsqrtf(wave_sum(a * a + b * b) * (1.f / 128) + EPS);
        *p = pk2(a * rstd * g0, b * rstd * g1);
    }
}

__global__ void __launch_bounds__(NWAVES * 64, 2) mega_fwd(Args args) {
    extern __shared__ __attribute__((aligned(16))) unsigned char lds_raw[];
    Frame F;
    F.lds = (LAS unsigned char*)lds_raw;
    F.wave = __builtin_amdgcn_readfirstlane((int)threadIdx.x >> 6);
    F.G = gridDim.x;
    { const int bx = blockIdx.x; const int vcu = (F.G % 8 == 0) ? (bx % 8) * (F.G / 8) + bx / 8 : bx; F.gw = vcu * NWAVES + F.wave; F.NGW = F.G * NWAVES; }
    unsigned char* ws = args.ws;
    gu32* ctl = (gu32*)(ws + WS_CTL);
    volatile LAS unsigned* MISC = (volatile LAS unsigned*)(F.lds + MISC_OFF);
    for (int u = F_TID; u < (LDS_BYTES - LDSCTL_OFF) / 4; u += NWAVES * 64) ((LAS unsigned*)(F.lds + LDSCTL_OFF))[u] = 0u;
    __syncthreads();
    const int lo = args.ph_lo, hi = args.ph_hi;
    XcdBarrier bar = xcd_barrier_post((unsigned*)(ctl + CW_BAR) + args.li * XCD_BAR_WORDS, MISC + 8, F_TID);
#ifndef PHASE_MASK
#define PHASE_MASK 0xFFFF
#endif
#define IN(k) (((PHASE_MASK >> (k)) & 1) && lo <= (k) && (k) < hi)
#define SEAM(k) do { if (IN(k) && IN((k) + 1)) xcd_barrier(bar, F_TID); } while (0)
    const int c = (int)blockIdx.x;
    bf16* XN = (bf16*)args.out; bf16* GS = (bf16*)((unsigned char*)args.out + 32 * MiB);
    bf16* Z = (bf16*)(ws + WS_Z);

    if (IN(PH_P0)) { p0_prologue(F, args); }
    SEAM(PH_P0);
    if (IN(PH_P1)) {
        { pg8::Gemm g{XN, (const bf16*)(ws + WS_W1Z), 1024, 1024, nullptr}; pg8::StaticOrder S; S.init(M, ZW, F.G, c);
          pg8::EpiStoreBf16 E{Z, ZW};
          pg8::gemm_phase<pg8::EpiStoreBf16, pg8::StaticOrder, true, false>(F.lds, g, S, E, F.wave); }
        { pg8::Gemm g{(const bf16*)(ws + WS_MEMN), (const bf16*)(ws + WS_WKV), 1024, 1024, nullptr}; pg8::StaticOrder S; S.init(MROWS, 1024, F.G, (c + 64) % F.G);
          pg8::EpiStoreBf16 E{(bf16*)(ws + WS_KVM), 1024};
          pg8::gemm_phase<pg8::EpiStoreBf16, pg8::StaticOrder, true, false>(F.lds, g, S, E, F.wave);
        }
    }
    SEAM(PH_P1);
    MEGA_TOKEN_MIXER_PHASES
    if (IN(PH_MIX)) {
        bf16* MIXED = (bf16*)(ws + WS_MIXED);
        const bf16* WGATE = (const bf16*)(ws + WS_WGATE); const bf16* WA = (const bf16*)(ws + WS_WA); const bf16* WB = (const bf16*)(ws + WS_WB); const bf16* WC = (const bf16*)(ws + WS_WC); const bf16* HA = Z + Z_MO;
        pg8::StaticOrder S; S.init(M, 1024, F.G, c);
        pg8::StaticOrder Sg0; Sg0.init(M, 1024, F.G, c, 0); pg8::StaticOrder Sg1; Sg1.init(M, 1024, F.G, c, 4); pg8::StaticOrder Sg2; Sg2.init(M, 1024, F.G, c, 8);
        pg8::Unit u0;
        if (S.next(0, u0)) {
            const size_t pm = (size_t)u0.pm * 256, pn = (size_t)u0.pn * 256;
            const pg8::Chain cA{HA + pm * ZW, WA + pn * 512, ZW, 512}, cG0{XN + pm * 1024, WGATE + pn * 1024, 1024, 1024}, cB{Z + Z_DQ + pm * ZW, WB + pn * 256, ZW, 256},
                             cG2{XN + pm * 1024, WGATE + (2048 + pn) * 1024, 1024, 1024}, cC{Z + Z_XQ + pm * ZW, WC + pn * 512, ZW, 512};
            { pg8::Gemm g{XN, WGATE, 1024, 1024, nullptr}; pg8::EpiGate E{GS, args.in[18] + 1024};
              pg8::gemm_phase<pg8::EpiGate, pg8::StaticOrder, true, false, 2>(F.lds, g, Sg1, E, F.wave, cB); }
            split_wait(bar, 2, F_TID);
            { pg8::Gemm g{Z + Z_DQ, WB, ZW, 256, nullptr}; pg8::EpiMix<0> E{GS, MIXED};
              pg8::gemm_phase<pg8::EpiMix<0>, pg8::StaticOrder, true, false, 3>(F.lds, g, S, E, F.wave, cG2); }
            { pg8::Gemm g{XN, WGATE, 1024, 1024, nullptr}; pg8::EpiGate E{GS, args.in[18] + 2048};
              pg8::gemm_phase<pg8::EpiGate, pg8::StaticOrder, true, false, 3>(F.lds, g, Sg2, E, F.wave, cC); }
            { pg8::Gemm g{Z + Z_XQ, WC, ZW, 512, nullptr}; pg8::EpiMix<1> E{GS, MIXED};
              pg8::gemm_phase<pg8::EpiMix<1>, pg8::StaticOrder, true, false, 3>(F.lds, g, S, E, F.wave, cG0); }
            { pg8::Gemm g{XN, WGATE, 1024, 1024, nullptr}; pg8::EpiGate E{GS, args.in[18]};
              pg8::gemm_phase<pg8::EpiGate, pg8::StaticOrder, true, false, 3>(F.lds, g, Sg0, E, F.wave, cA); }
            { pg8::Gemm g{HA, WA, ZW, 512, nullptr}; pg8::EpiMix<2> E{GS, MIXED};
              pg8::gemm_phase<pg8::EpiMix<2>, pg8::StaticOrder, true, false, 1>(F.lds, g, S, E, F.wave); }
        }
    }
    split_arrive(bar, 8, F_TID);
    cv_range(args, 0, CV_WGU / 2, F.gw, F.NGW, F_LANE);
    split_wait(bar, 8, F_TID);
    if (IN(PH_WOUT)) {
        pg8::StaticOrder S; S.init(M, 1024, F.G, c);
        pg8::Gemm g{GS, (const bf16*)(ws + WS_WOUT), 1024, 1024, nullptr}; pg8::EpiRes E{args.in[0], (float*)(ws + WS_H1)};
        pg8::gemm_phase<pg8::EpiRes, pg8::StaticOrder, false, false>(F.lds, g, S, E, F.wave);
    }
    split_arrive(bar, 3, F_TID);
    MEGA_MOE_PHASES
#undef IN
#undef SEAM
}

extern "C" void kernel_launch(void* const* d_in, const int* in_sizes, int n_in, void* d_out, int out_size, void* d_ws, size_t ws_size, hipStream_t stream) {
    static int grid = 0;
    if (grid == 0) {
        if (n_in != 28 || out_size != M * D || ws_size < WS_END) { fprintf(stderr, "kernel_launch: unexpected shapes n_in %d out %d ws %zu\n", n_in, out_size, ws_size); grid = -1; return; }
        int dev = 0, cus = 0;
        if (hipGetDevice(&dev) != hipSuccess || hipDeviceGetAttribute(&cus, hipDeviceAttributeMultiprocessorCount, dev) != hipSuccess) { grid = -1; return; }
        if (hipFuncSetAttribute((const void*)mega_fwd, hipFuncAttributeMaxDynamicSharedMemorySize, LDS_BYTES) != hipSuccess) { fprintf(stderr, "kernel_launch: hipFuncSetAttribute failed\n"); grid = -1; return; }
        grid = cus;
    }
    if (grid < 0) return;
    (void)hipMemsetAsync((unsigned char*)d_ws + WS_CTL, 0, 1 * MiB, stream);
    Args a{};
    for (int i = 0; i < 28; ++i) a.in[i] = (const float*)d_in[i];
    a.out = (float*)d_out; a.ws = (unsigned char*)d_ws; a.ph_lo = 0; a.ph_hi = PH_END; a.li = 0; a.pad = 0;
    hipLaunchKernelGGL(mega_fwd, dim3(grid), dim3(NWAVES * 64), LDS_BYTES, stream, a);
}
```

```cpp
#include <hip/hip_runtime.h>
#include <cstdio>
#include <cstdint>
#include <cmath>

constexpr int D = 1024, BATCH = 4, SEQ = 4096, M = BATCH * SEQ;
constexpr int MEM_LEN = 256, MROWS = BATCH * MEM_LEN;
constexpr float EPS = 1e-6f;
constexpr int IN_TOTAL = 4872;
constexpr int ZW = 4864;
constexpr int Z_MQ = 0, Z_MK = 512, Z_MV = 1024, Z_MO = 1536, Z_DQ = 2048, Z_DK = 2816, Z_DV = 3584, Z_XQ = 4352;
constexpr int NCHUNK = SEQ / 128;
typedef unsigned short bf16;

constexpr size_t MiB = 1u << 20;
constexpr size_t WS_CTL = 0;
constexpr size_t WS_IFG = 1 * MiB;
constexpr size_t WS_LSE = 2 * MiB;
constexpr size_t WS_MSC = 3 * MiB;
constexpr size_t WS_NL = 3 * MiB + 64 * 1024;
constexpr size_t WS_WGATE = 8 * MiB;
constexpr size_t WS_WA = 14 * MiB;
constexpr size_t WS_WB = 15 * MiB;
constexpr size_t WS_WC = 16 * MiB;
constexpr size_t WS_WOUT = 17 * MiB;
constexpr size_t WS_HA = 19 * MiB;
constexpr size_t WS_Z = 35 * MiB;
constexpr size_t WS_CL = 187 * MiB;
constexpr size_t WS_W1Z = 219 * MiB;
constexpr size_t WS_WKV = 229 * MiB;
constexpr size_t WS_MEMN = 231 * MiB;
constexpr size_t WS_KVM = 251 * MiB;
constexpr size_t WS_MIXED = 187 * MiB;
constexpr size_t WS_END = 253 * MiB;

__device__ __forceinline__ unsigned f2bf(float f) { unsigned u = __float_as_uint(f); return (u + 0x7fffu + ((u >> 16) & 1u)) >> 16; }
__device__ __forceinline__ float bf2f(bf16 h) { return __uint_as_float(((unsigned)h) << 16); }
#define DPP_F(v, ctrl, rmask) __builtin_bit_cast(float, __builtin_amdgcn_update_dpp(0, __builtin_bit_cast(int, (v)), (ctrl), (rmask), 0xf, false))
__device__ __forceinline__ float wave_sum(float v) {
    v += DPP_F(v, 0xB1, 0xf); v += DPP_F(v, 0x4E, 0xf); v += DPP_F(v, 0x141, 0xf); v += DPP_F(v, 0x140, 0xf);
    v += DPP_F(v, 0x142, 0xa); v += DPP_F(v, 0x143, 0xc);
    return __builtin_bit_cast(float, __builtin_amdgcn_readlane(__builtin_bit_cast(int, v), 63));
}
#define DPP_FM(v, ctrl, rmask) __builtin_bit_cast(float, __builtin_amdgcn_update_dpp(__builtin_bit_cast(int, (v)), __builtin_bit_cast(int, (v)), (ctrl), (rmask), 0xf, false))
__device__ __forceinline__ float wave_max(float v) {
    v = fmaxf(v, DPP_FM(v, 0xB1, 0xf)); v = fmaxf(v, DPP_FM(v, 0x4E, 0xf)); v = fmaxf(v, DPP_FM(v, 0x141, 0xf)); v = fmaxf(v, DPP_FM(v, 0x140, 0xf));
    v = fmaxf(v, DPP_FM(v, 0x142, 0xa)); v = fmaxf(v, DPP_FM(v, 0x143, 0xc));
    return __builtin_bit_cast(float, __builtin_amdgcn_readlane(__builtin_bit_cast(int, v), 63));
}
__device__ __forceinline__ float sigmoidf_(float x) { return 1.f / (1.f + __expf(-x)); }
__device__ __forceinline__ float siluf_(float x) { return x / (1.f + __expf(-x)); }
__device__ __forceinline__ float log_sigmoid_(float x) { return fminf(x, 0.f) - log1pf(__expf(-fabsf(x))); }

namespace pg8 {
#define PG8_LAS __attribute__((address_space(3)))
typedef unsigned short bf16_t;
typedef short bf16x8 __attribute__((ext_vector_type(8)));
typedef float f32x4 __attribute__((ext_vector_type(4)));
typedef unsigned u32x4 __attribute__((ext_vector_type(4)));
constexpr int BM = 256, BK = 64, HALF = 128, HTB = HALF * BK * 2  , STAGE_BYTES = 8 * HTB, NXCD = 8, WGM = 8;

__host__ __device__ __forceinline__ int lds_byte(int r, int c) { const int st = (r >> 4) * 2 + (c >> 5), rr = r & 15, cc = c & 31, ob = rr * 64 + cc * 2; return st * 1024 + (ob ^ (((ob >> 9) & 1) << 5)); }
__host__ __device__ __forceinline__ void stage_rc(int b, int& R, int& C) { const int st = b / 1024, sb = b % 1024, swz = sb ^ (((sb >> 9) & 1) << 5); R = (st >> 1) * 16 + swz / 64; C = (st & 1) * 32 + (swz % 64) / 2; }
__host__ __device__ __forceinline__ int perm32(int rho) { const int n = rho >> 4, i = rho & 15; return 8 * (i >> 2) + 4 * n + (i & 3); }

struct Unit { int pm, pn, bt, aux; };
struct Gemm { const bf16_t* A; const bf16_t* Bt; int lda, K; const int* rowidx; };

struct StaticOrder {
    int nM, nN, nwg, G, c, btoff;
    __host__ __device__ __forceinline__ void init(int M, int N, int G_, int c_, int btoff_ = 0) { nM = M / BM; nN = N / BM; nwg = nM * nN; G = G_; c = c_; btoff = btoff_; }
    __host__ __device__ __forceinline__ bool next(int i, Unit& u) const {
        const long L = (long)i * G + c; if (L >= nwg) return false;
        int wgid = (int)L; { const int q = nwg / NXCD, r = nwg % NXCD, xcd = wgid % NXCD, off = wgid / NXCD; wgid = (xcd < r ? xcd * (q + 1) : r * (q + 1) + (xcd - r) * q) + off; }
        const int nig = WGM * nN, gid = wgid / nig, fm = gid * WGM, gsz = (nM - fm) < WGM ? (nM - fm) : WGM;
        u.pm = fm + ((wgid % nig) % gsz); u.pn = (wgid % nig) / gsz; u.bt = u.pn + btoff; u.aux = 0; return true;
    }
};

typedef __bf16 bf16x2_t __attribute__((ext_vector_type(2)));
typedef float f32x2_t __attribute__((ext_vector_type(2)));
__device__ __forceinline__ unsigned cvt_pk_bf16(float lo, float hi) { const f32x2_t v = {lo, hi}; const bf16x2_t r = __builtin_convertvector(v, bf16x2_t); return __builtin_bit_cast(unsigned, r); }


struct Chain { const bf16_t* A; const bf16_t* Bt; int lda, K; };
template <class Epi, class Sched, bool ALIGN_EPI, bool GATHER, int CH = 0>
__device__ __forceinline__ void gemm_phase(PG8_LAS unsigned char* lds, const Gemm g, const Sched& S, const Epi& E, int wave_id, const Chain nx = Chain{nullptr, nullptr, 0, 0}) {
    int tid_; { int l; asm volatile("v_mbcnt_lo_u32_b32 %0, -1, 0\n\tv_mbcnt_hi_u32_b32 %0, -1, %0" : "=v"(l)); tid_ = wave_id * 64 + l; }
    const int tid = tid_, wid = wave_id, lane = tid & 63, wr = wid >> 2, wc = wid & 3, fr = lane & 15, fq = lane >> 4;
    const int K = g.K, nt = K / BK, lda = g.lda;
    unsigned voffA[2], voffB[2]; int RA[2], CA[2];
#pragma unroll
    for (int i = 0; i < 2; ++i) { int R, C; stage_rc(tid * 16 + i * 8192, R, C); const int Rb = Epi::PERM ? ((R & ~31) + perm32(R & 31)) : R;
        RA[i] = R; CA[i] = C; voffA[i] = (unsigned)(R * lda + C) * 2u; voffB[i] = (unsigned)(Rb * K + C) * 2u; }
    unsigned voffA_n[2], voffB_n[2]; size_t hstepA_n = 0, hstepB_n = 0;
    if constexpr ((CH & 2) != 0) {
#pragma unroll
        for (int i = 0; i < 2; ++i) { const int Rb = (RA[i] & ~31) + perm32(RA[i] & 31); voffA_n[i] = (unsigned)(RA[i] * nx.lda + CA[i]) * 2u; voffB_n[i] = (unsigned)(Rb * nx.K + CA[i]) * 2u; }
        hstepA_n = (size_t)HALF * nx.lda * 2; hstepB_n = (size_t)HALF * nx.K * 2;
    }
    const size_t kstep = (size_t)(BK * 2);
    const size_t hstepA = (size_t)HALF * lda * 2, tstepA = 2 * hstepA;
    const size_t hstepB = (size_t)HALF * K * 2, tstepB = 2 * hstepB;
    const unsigned ldsw = (unsigned)wid * 1024u;
    const int aoff = lds_byte(wr * 64 + fr, fq * 8), boff = lds_byte(wc * 32 + fr, fq * 8);
#define PG8_SA(b, h) (((b) * 2 + (h)) * HTB)
#define PG8_SB(b, h) ((4 + (b) * 2 + (h)) * HTB)
#define PG8_STAGE(bufoff, gbase, voff) do { _Pragma("unroll") for (int _i = 0; _i < 2; ++_i) \
        __builtin_amdgcn_global_load_lds((const unsigned*)((const char*)(gbase) + (voff)[_i]), (PG8_LAS unsigned*)(lds + (bufoff) + ldsw + _i * 8192), 16, 0, 0); } while (0)
#define PG8_LDA(dst, b, h) do { _Pragma("unroll") for (int m = 0; m < 4; ++m) _Pragma("unroll") for (int k = 0; k < 2; ++k) dst[m][k] = *(const PG8_LAS bf16x8*)(lds + PG8_SA(b, h) + aoff + m * 2048 + k * 1024); } while (0)
#define PG8_LDB(dst, b, h) do { _Pragma("unroll") for (int n = 0; n < 2; ++n) _Pragma("unroll") for (int k = 0; k < 2; ++k) dst[n][k] = *(const PG8_LAS bf16x8*)(lds + PG8_SB(b, h) + boff + n * 2048 + k * 1024); } while (0)
#define PG8_MMA(ai, bj, At, Bt) do { __builtin_amdgcn_s_setprio(1); _Pragma("unroll") for (int m = 0; m < 4; ++m) _Pragma("unroll") for (int n = 0; n < 2; ++n) _Pragma("unroll") for (int k = 0; k < 2; ++k) \
        acc[ai][bj][m][n] = __builtin_amdgcn_mfma_f32_16x16x32_bf16(Bt[n][k], At[m][k], acc[ai][bj][m][n], 0, 0, 0); __builtin_amdgcn_s_setprio(0); } while (0)
#define PG8_WAIT_V(n) asm volatile("s_waitcnt vmcnt(" #n ")" ::: "memory")
#define PG8_WAIT_L(n) asm volatile("s_waitcnt lgkmcnt(" #n ")" ::: "memory")
#define PG8_BAR __builtin_amdgcn_s_barrier()
#define PG8_SCHED __builtin_amdgcn_sched_barrier(0)
    Unit cur, nxt; int ui = 0;
    if (!S.next(0, cur)) return;
    f32x4 acc[2][2][4][2];
#pragma unroll
    for (int a = 0; a < 2; ++a)
#pragma unroll
        for (int b = 0; b < 2; ++b)
#pragma unroll
            for (int m = 0; m < 4; ++m)
#pragma unroll
                for (int n = 0; n < 2; ++n) acc[a][b][m][n] = (f32x4){0.f, 0.f, 0.f, 0.f};
    bf16x8 At[4][2], B0[2][2], B1[2][2];
    unsigned gAc[2][2], gAn[2][2];
    if constexpr (GATHER) {
#pragma unroll
        for (int h = 0; h < 2; ++h)
#pragma unroll
            for (int i = 0; i < 2; ++i) { unsigned _r = (unsigned)g.rowidx[cur.pm * BM + h * HALF + RA[i]]; _r = _r < 16384u ? _r : 0u; gAc[h][i] = (_r * (unsigned)lda + (unsigned)CA[i]) * 2u; }
    }
    const char* cA = GATHER ? (const char*)g.A : (const char*)g.A + (size_t)cur.pm * tstepA; const char* cB = (const char*)g.Bt + (size_t)cur.bt * tstepB;
#define PG8_STAGE_A(bufoff, p, h, useN) do { if constexpr (GATHER) { unsigned _v[2]; _v[0] = (useN) ? gAn[h][0] : gAc[h][0]; _v[1] = (useN) ? gAn[h][1] : gAc[h][1]; PG8_STAGE(bufoff, p, _v); } \
        else if constexpr ((CH & 2) != 0) { unsigned _v[2]; _v[0] = ((useN) && chain_now) ? voffA_n[0] : voffA[0]; _v[1] = ((useN) && chain_now) ? voffA_n[1] : voffA[1]; \
            PG8_STAGE(bufoff, (p) + (h) * (((useN) && chain_now) ? hstepA_n : hstepA), _v); } \
        else { PG8_STAGE(bufoff, (p) + (h) * hstepA, voffA); } } while (0)
#define PG8_STAGE_B(bufoff, p, h, useN) do { if constexpr ((CH & 2) != 0) { unsigned _v[2]; _v[0] = ((useN) && chain_now) ? voffB_n[0] : voffB[0]; _v[1] = ((useN) && chain_now) ? voffB_n[1] : voffB[1]; \
            PG8_STAGE(bufoff, (p) + (h) * (((useN) && chain_now) ? hstepB_n : hstepB), _v); } \
        else { PG8_STAGE(bufoff, (p) + (h) * hstepB, voffB); } } while (0)
    bool chain_now = false;
    if constexpr ((CH & 1) == 0) {
    PG8_STAGE(PG8_SB(0, 0), cB, voffB); PG8_STAGE(PG8_SB(0, 1), cB + hstepB, voffB); PG8_STAGE_A(PG8_SA(0, 0), cA, 0, false); PG8_STAGE_A(PG8_SA(0, 1), cA, 1, false);
    if (wr == 1) PG8_BAR;
    PG8_WAIT_V(2); PG8_BAR;
    PG8_STAGE(PG8_SB(1, 0), cB + kstep, voffB); PG8_STAGE_A(PG8_SA(1, 0), cA + kstep, 0, false); PG8_STAGE(PG8_SB(1, 1), cB + hstepB + kstep, voffB);
    PG8_WAIT_V(6); PG8_BAR;
    }
    for (;;) {
        const bool has_next = S.next(ui + 1, nxt);
        const char* nA = GATHER ? (const char*)g.A : (has_next ? (const char*)g.A + (size_t)nxt.pm * tstepA : (((CH & 2) != 0) ? (const char*)nx.A : cA)); const char* nB = has_next ? (const char*)g.Bt + (size_t)nxt.bt * tstepB : (((CH & 2) != 0) ? (const char*)nx.Bt : cB);
        if constexpr ((CH & 2) != 0) chain_now = !has_next;
        if constexpr (GATHER) {
#pragma unroll
            for (int h = 0; h < 2; ++h)
#pragma unroll
                for (int i = 0; i < 2; ++i) { unsigned _r = has_next ? (unsigned)g.rowidx[nxt.pm * BM + h * HALF + RA[i]] : 0u; _r = _r < 16384u ? _r : 0u; gAn[h][i] = has_next ? (_r * (unsigned)lda + (unsigned)CA[i]) * 2u : gAc[h][i]; }
        }
        for (int t = 0; t < nt; t += 2) {
            const bool last = (t == nt - 2);
            const char* a1 = cA + (size_t)(t + 1) * kstep;
            const char* a2 = last ? nA : cA + (size_t)(t + 2) * kstep; const char* b2 = last ? nB : cB + (size_t)(t + 2) * kstep;
            const char* a3 = a2 + kstep; const char* b3 = b2 + kstep;
            PG8_LDB(B0, 0, 0); PG8_LDB(B1, 0, 1); PG8_SCHED; PG8_LDA(At, 0, 0); PG8_STAGE_A(PG8_SA(1, 1), a1, 1, false);
            PG8_WAIT_V(8); PG8_WAIT_L(0); PG8_BAR; PG8_MMA(0, 0, At, B0); PG8_MMA(0, 1, At, B1); PG8_BAR; PG8_SCHED;
            PG8_LDA(At, 0, 1); PG8_STAGE_B(PG8_SB(0, 0), b2, 0, last); PG8_STAGE_B(PG8_SB(0, 1), b2, 1, last); PG8_STAGE_A(PG8_SA(0, 0), a2, 0, last);
            PG8_WAIT_V(8); PG8_WAIT_L(0); PG8_BAR; PG8_MMA(1, 0, At, B0); PG8_MMA(1, 1, At, B1); PG8_BAR; PG8_SCHED;
            PG8_LDB(B0, 1, 0); PG8_LDB(B1, 1, 1); PG8_SCHED; PG8_LDA(At, 1, 0); PG8_STAGE_A(PG8_SA(0, 1), a2, 1, last);
            PG8_WAIT_V(8); PG8_WAIT_L(0); PG8_BAR; PG8_MMA(0, 0, At, B0); PG8_MMA(0, 1, At, B1); PG8_BAR; PG8_SCHED;
            PG8_LDA(At, 1, 1); PG8_STAGE_B(PG8_SB(1, 0), b3, 0, last); PG8_STAGE_B(PG8_SB(1, 1), b3, 1, last); PG8_STAGE_A(PG8_SA(1, 0), a3, 0, last);
            PG8_WAIT_V(8); PG8_WAIT_L(0); PG8_BAR; PG8_MMA(1, 0, At, B0); PG8_MMA(1, 1, At, B1); PG8_BAR; PG8_SCHED;
        }
        if constexpr (ALIGN_EPI) { if (wr == 0) PG8_BAR; }
        E(acc, cur, wr, wc, fr, fq);
        if (!has_next) { if constexpr ((CH & 2) != 0) { if constexpr (ALIGN_EPI) { if (wr == 1) PG8_BAR; } return; } break; }
#pragma unroll
        for (int a = 0; a < 2; ++a)
#pragma unroll
            for (int b = 0; b < 2; ++b)
#pragma unroll
                for (int m = 0; m < 4; ++m)
#pragma unroll
                    for (int n = 0; n < 2; ++n) acc[a][b][m][n] = (f32x4){0.f, 0.f, 0.f, 0.f};
        cur = nxt; cA = nA; cB = nB; ++ui;
        if constexpr (GATHER) {
#pragma unroll
            for (int h = 0; h < 2; ++h)
#pragma unroll
                for (int i = 0; i < 2; ++i) gAc[h][i] = gAn[h][i];
        }
        if constexpr (ALIGN_EPI) { if (wr == 1) PG8_BAR; }
    }
    PG8_WAIT_V(0);
    if constexpr (!ALIGN_EPI) { if (wr == 0) PG8_BAR; }
    PG8_BAR;
#undef PG8_SA
#undef PG8_SB
#undef PG8_STAGE
#undef PG8_STAGE_A
#undef PG8_STAGE_B
#undef PG8_LDA
#undef PG8_LDB
#undef PG8_MMA
#undef PG8_WAIT_V
#undef PG8_WAIT_L
#undef PG8_BAR
#undef PG8_SCHED
}
}
namespace pg8 {
struct EpiStoreBf16 {
    static constexpr bool PERM = true;
    bf16_t* O; int ldc;
    __device__ __forceinline__ void operator()(const f32x4 (&acc)[2][2][4][2], const Unit& u, int wr, int wc, int fr, int fq) const {
        const int row0 = u.pm * BM + wr * 64 + fr, col0 = u.pn * BM + wc * 32 + 8 * fq;
#pragma unroll
        for (int ai = 0; ai < 2; ++ai)
#pragma unroll
            for (int m = 0; m < 4; ++m) { bf16_t* rowp = O + (size_t)(row0 + ai * HALF + m * 16) * ldc + col0;
#pragma unroll
                for (int bj = 0; bj < 2; ++bj) { const f32x4 v0 = acc[ai][bj][m][0], v1 = acc[ai][bj][m][1];
                    u32x4 w; w.x = cvt_pk_bf16(v0[0], v0[1]); w.y = cvt_pk_bf16(v0[2], v0[3]); w.z = cvt_pk_bf16(v1[0], v1[1]); w.w = cvt_pk_bf16(v1[2], v1[3]);
                    *(u32x4*)(rowp + bj * HALF) = w; } }
    }
};
__device__ __forceinline__ float fast_sigmoid(float x) { return __builtin_amdgcn_rcpf(1.f + __builtin_amdgcn_exp2f(-1.4426950408889634f * x)); }
struct EpiGate {
    static constexpr bool PERM = true;
    bf16_t* O; const float* bias;
    __device__ __forceinline__ void operator()(const f32x4 (&acc)[2][2][4][2], const Unit& u, int wr, int wc, int fr, int fq) const {
        const int row0 = u.pm * BM + wr * 64 + fr, col0 = u.pn * BM + wc * 32 + 8 * fq;
        f32x4 bv[2][2];
#pragma unroll
        for (int bj = 0; bj < 2; ++bj)
#pragma unroll
            for (int n = 0; n < 2; ++n) bv[bj][n] = *(const f32x4*)(bias + col0 + bj * HALF + 4 * n);
#pragma unroll
        for (int ai = 0; ai < 2; ++ai)
#pragma unroll
            for (int m = 0; m < 4; ++m) { bf16_t* rowp = O + (size_t)(row0 + ai * HALF + m * 16) * 1024 + col0;
#pragma unroll
                for (int bj = 0; bj < 2; ++bj) { f32x4 v0 = acc[ai][bj][m][0] + bv[bj][0], v1 = acc[ai][bj][m][1] + bv[bj][1];
#pragma unroll
                    for (int j = 0; j < 4; ++j) { v0[j] = fast_sigmoid(v0[j]); v1[j] = fast_sigmoid(v1[j]); }
                    u32x4 w; w.x = cvt_pk_bf16(v0[0], v0[1]); w.y = cvt_pk_bf16(v0[2], v0[3]); w.z = cvt_pk_bf16(v1[0], v1[1]); w.w = cvt_pk_bf16(v1[2], v1[3]);
                    *(u32x4*)(rowp + bj * HALF) = w; } }
    }
};
__device__ __forceinline__ float bflo(unsigned w) { return __uint_as_float(w << 16); }
__device__ __forceinline__ float bfhi(unsigned w) { return __uint_as_float(w & 0xffff0000u); }
template <int MODE>
struct EpiMix {
    static constexpr bool PERM = true;
    bf16_t* GS; bf16_t* MIXED;
    __device__ __forceinline__ void operator()(const f32x4 (&acc)[2][2][4][2], const Unit& u, int wr, int wc, int fr, int fq) const {
        const int row0 = u.pm * BM + wr * 64 + fr, col0 = u.pn * BM + wc * 32 + 8 * fq;
#pragma unroll
        for (int ai = 0; ai < 2; ++ai) {
            u32x4 gw[4][2], pw[4][2];
#pragma unroll
            for (int m = 0; m < 4; ++m)
#pragma unroll
                for (int bj = 0; bj < 2; ++bj) { const size_t o = (size_t)(row0 + ai * HALF + m * 16) * 1024 + col0 + bj * HALF;
                    gw[m][bj] = *(const u32x4*)(GS + o); if (MODE != 0) pw[m][bj] = *(const u32x4*)(MIXED + o); }
#pragma unroll
            for (int m = 0; m < 4; ++m)
#pragma unroll
                for (int bj = 0; bj < 2; ++bj) { const size_t o = (size_t)(row0 + ai * HALF + m * 16) * 1024 + col0 + bj * HALF; const u32x4 g = gw[m][bj];
                    f32x4 t0, t1;
                    t0[0] = bflo(g.x) * acc[ai][bj][m][0][0]; t0[1] = bfhi(g.x) * acc[ai][bj][m][0][1]; t0[2] = bflo(g.y) * acc[ai][bj][m][0][2]; t0[3] = bfhi(g.y) * acc[ai][bj][m][0][3];
                    t1[0] = bflo(g.z) * acc[ai][bj][m][1][0]; t1[1] = bfhi(g.z) * acc[ai][bj][m][1][1]; t1[2] = bflo(g.w) * acc[ai][bj][m][1][2]; t1[3] = bfhi(g.w) * acc[ai][bj][m][1][3];
                    if (MODE != 0) { const u32x4 p = pw[m][bj];
                        t0[0] += bflo(p.x); t0[1] += bfhi(p.x); t0[2] += bflo(p.y); t0[3] += bfhi(p.y); t1[0] += bflo(p.z); t1[1] += bfhi(p.z); t1[2] += bflo(p.w); t1[3] += bfhi(p.w); }
                    u32x4 w; w.x = cvt_pk_bf16(t0[0], t0[1]); w.y = cvt_pk_bf16(t0[2], t0[3]); w.z = cvt_pk_bf16(t1[0], t1[1]); w.w = cvt_pk_bf16(t1[2], t1[3]);
                    if (MODE != 2) *(u32x4*)(MIXED + o) = w; else *(u32x4*)(GS + o) = w; }
            asm volatile("" ::: "memory");
        }
    }
};
struct EpiRes {
    static constexpr bool PERM = false;
    const float* x; float* out;
    __device__ __forceinline__ void operator()(const f32x4 (&acc)[2][2][4][2], const Unit& u, int wr, int wc, int fr, int fq) const {
        const int row0 = u.pm * BM + wr * 64 + fr, col0 = u.pn * BM + wc * 32 + 4 * fq;
#pragma unroll
        for (int ai = 0; ai < 2; ++ai)
#pragma unroll
            for (int mp = 0; mp < 2; ++mp) {
                f32x4 xv[2][2][2];
#pragma unroll
                for (int mm = 0; mm < 2; ++mm)
#pragma unroll
                    for (int bj = 0; bj < 2; ++bj)
#pragma unroll
                        for (int n = 0; n < 2; ++n) xv[mm][bj][n] = *(const f32x4*)(x + (size_t)(row0 + ai * HALF + (2 * mp + mm) * 16) * 1024 + col0 + bj * HALF + n * 16);
#pragma unroll
                for (int mm = 0; mm < 2; ++mm)
#pragma unroll
                    for (int bj = 0; bj < 2; ++bj)
#pragma unroll
                        for (int n = 0; n < 2; ++n) *(f32x4*)(out + (size_t)(row0 + ai * HALF + (2 * mp + mm) * 16) * 1024 + col0 + bj * HALF + n * 16) = xv[mm][bj][n] + acc[ai][bj][2 * mp + mm][n];
                asm volatile("" ::: "memory");
            }
    }
};
}
constexpr int NWAVES = 8;
constexpr int SCR_BYTES = 146432;
constexpr int LDSCTL_OFF = SCR_BYTES, MISC_OFF = LDSCTL_OFF + 320;
constexpr int LDS_BYTES = 147456;
#define GAS __attribute__((address_space(1)))
#define LAS __attribute__((address_space(3)))
typedef unsigned v4u __attribute__((ext_vector_type(4)));
typedef float f32x4 __attribute__((ext_vector_type(4)));
typedef short bf16x8 __attribute__((ext_vector_type(8)));
typedef short s16x4 __attribute__((ext_vector_type(4)));
typedef GAS unsigned gu32;
#define RLX_AGENT __ATOMIC_RELAXED, __HIP_MEMORY_SCOPE_AGENT
#define LDS_WAIT() asm volatile("s_waitcnt lgkmcnt(0)" ::: "memory")
#define VM_WAIT() asm volatile("s_waitcnt vmcnt(0)" ::: "memory")
__device__ __forceinline__ int lane_id() { int l; asm volatile("v_mbcnt_lo_u32_b32 %0, -1, 0\n\tv_mbcnt_hi_u32_b32 %0, -1, %0" : "=v"(l)); return l; }
__device__ __forceinline__ unsigned pk2(float lo, float hi) { return pg8::cvt_pk_bf16(lo, hi); }

constexpr int CW_BAR = 4096;
constexpr int CW_ECNT = 32768;

#define XB_TMO      128
#define XB_XCNT(j)  (256  + 64 * (j))
#define XB_XSUB(j)  (1280 + 64 * (j))
#define XB_XGEN(j)  (2304 + 64 * (j))
#define XB_TOP      3328
#define XB_TOPGEN   3392
#define XCD_BAR_WORDS 3456
#define XB_SPIN_CAP (1u << 18)
__device__ __forceinline__ unsigned xb_ld(unsigned* p)              { return __hip_atomic_load(p, __ATOMIC_RELAXED, __HIP_MEMORY_SCOPE_AGENT); }
__device__ __forceinline__ unsigned xb_add(unsigned* p, unsigned v) { return __hip_atomic_fetch_add(p, v, __ATOMIC_RELAXED, __HIP_MEMORY_SCOPE_AGENT); }
__device__ __forceinline__ unsigned xb_xcc_id() { return (unsigned)__builtin_amdgcn_s_getreg((3 << 11) | 20) & 0xFu; }
#define XB_SPIN(cond, bar) do { unsigned _sp = 0; while (cond) { __builtin_amdgcn_s_sleep(1); \
    if ((++_sp & 255u) == 0u) { if (xb_ld(&(bar)[XB_TMO])) break; if (_sp > XB_SPIN_CAP) { atomicAdd(&(bar)[XB_TMO], 1u); break; } } } } while (0)
struct XcdBarrier { unsigned* bar; unsigned x; volatile LAS unsigned* st; };
__device__ __forceinline__ XcdBarrier xcd_barrier_post(unsigned* bar, volatile LAS unsigned* st, int tid) {
    XcdBarrier b; b.bar = bar; b.x = xb_xcc_id(); b.st = st;
    if (tid == 0) (void)xb_add(&bar[XB_XCNT(b.x)], 1u);
    return b;
}
__device__ __forceinline__ void xcd_barrier_complete(unsigned* bar, unsigned x, unsigned& nloc, unsigned& nx) {
    const unsigned G = gridDim.x * gridDim.y * gridDim.z;
    unsigned sum, cnt, mine, sp = 0u;
    for (;;) {
        sum = 0u; cnt = 0u; mine = 0u;
#pragma unroll
        for (unsigned j = 0; j < 16; ++j) { const unsigned c = xb_ld(&bar[XB_XCNT(j)]); sum += c; cnt += (c > 0u) ? 1u : 0u; mine = (j == x) ? c : mine; }
        if (sum == G) break;
        __builtin_amdgcn_s_sleep(1);
        if ((++sp & 255u) == 0u) { if (xb_ld(&bar[XB_TMO])) break; if (sp > XB_SPIN_CAP) { atomicAdd(&bar[XB_TMO], 1u); break; } }
    }
    nloc = mine > 0u ? mine : 1u; nx = cnt > 0u ? cnt : 1u;
}
__device__ __forceinline__ void xcd_barrier(const XcdBarrier& b, int tid) {
    asm volatile("s_waitcnt vmcnt(0)" ::: "memory");
    __syncthreads();
    if (tid == 0) {
        unsigned* bar = b.bar;
        __builtin_amdgcn_s_waitcnt(0);
        unsigned nloc = b.st[0], nx = b.st[1];
        if (nloc == 0u) { xcd_barrier_complete(bar, b.x, nloc, nx); b.st[0] = nloc; b.st[1] = nx; }
        const unsigned old = xb_add(&bar[XB_XSUB(b.x)], 1u);
        const unsigned gen = old / nloc;
        if (old + 1u == (gen + 1u) * nloc) {
            __builtin_amdgcn_fence(__ATOMIC_RELEASE, "agent");
            asm volatile("s_waitcnt vmcnt(0)" ::: "memory");
            const unsigned og = xb_add(&bar[XB_TOP], 1u);
            const unsigned tg = og / nx;
            if (og + 1u == (tg + 1u) * nx) xb_add(&bar[XB_TOPGEN], 1u);
            else XB_SPIN(xb_ld(&bar[XB_TOPGEN]) == tg, bar);
            __builtin_amdgcn_fence(__ATOMIC_ACQUIRE, "agent");
            xb_add(&bar[XB_XGEN(b.x)], 1u);
            asm volatile("s_waitcnt vmcnt(0)" ::: "memory");
        } else {
            XB_SPIN(xb_ld(&bar[XB_XGEN(b.x)]) == gen, bar);
            __builtin_amdgcn_fence(__ATOMIC_ACQUIRE, "agent");
            asm volatile("s_waitcnt vmcnt(0)" ::: "memory");
        }
    }
    __syncthreads();
}

constexpr int CW_SPLIT_REL = 65536 - CW_BAR;
__device__ __forceinline__ void split_arrive(const XcdBarrier& b, int inst, int tid) {
    asm volatile("s_waitcnt vmcnt(0)" ::: "memory");
    __syncthreads();
    if (tid == 0) {
        unsigned* w = b.bar + CW_SPLIT_REL + inst * 2048;
        const unsigned nloc = b.st[0];
        const unsigned old = xb_add(&w[64 * b.x], 1u);
        if (old + 1u == nloc) { __builtin_amdgcn_fence(__ATOMIC_RELEASE, "agent"); asm volatile("s_waitcnt vmcnt(0)" ::: "memory"); (void)xb_add(&w[1024], 1u); }
    }
}
__device__ __forceinline__ void split_wait(const XcdBarrier& b, int inst, int tid) {
    if (tid == 0) {
        unsigned* w = b.bar + CW_SPLIT_REL + inst * 2048;
        const unsigned nx = b.st[1];
        XB_SPIN(xb_ld(&w[1024]) < nx, b.bar);
        __builtin_amdgcn_fence(__ATOMIC_ACQUIRE, "agent");
        asm volatile("s_waitcnt vmcnt(0)" ::: "memory");
    }
    __syncthreads();
}

struct Args { const float* in[28]; float* out; unsigned char* ws; int ph_lo, ph_hi, li, pad; };

struct Frame {
    LAS unsigned char* lds;
    int wave, G, gw, NGW;
#define F_LANE (lane_id())
#define F_TID (F.wave * 64 + lane_id())
};

__device__ __forceinline__ void tr_load(const float* W, int ldw, int kb, int nb, int lane, f32x4 (&v)[8]) {
    const float* src = W + (size_t)(64 * kb + 8 * (lane >> 3)) * ldw + 32 * nb + 4 * (lane & 7);
#pragma unroll
    for (int j = 0; j < 8; ++j) v[j] = *(const f32x4*)(src + (size_t)j * ldw);
}
__device__ __forceinline__ void tr_store(bf16* WT, int K, int kb, int nb, int lane, const f32x4 (&v)[8]) {
    bf16* dst = WT + (size_t)(32 * nb + 4 * (lane & 7)) * K + 64 * kb + 8 * (lane >> 3);
#pragma unroll
    for (int i = 0; i < 4; ++i) { v4u o; o.x = pk2(v[0][i], v[1][i]); o.y = pk2(v[2][i], v[3][i]); o.z = pk2(v[4][i], v[5][i]); o.w = pk2(v[6][i], v[7][i]);
        *(GAS v4u*)(dst + (size_t)i * K) = o; }
}
__device__ __forceinline__ void p0_transpose_item(const float* W, int ldw, int K, bf16* WT, int kb, int nb, int lane) { f32x4 v[8]; tr_load(W, ldw, kb, nb, lane, v); tr_store(WT, K, kb, nb, lane, v); }
__device__ __forceinline__ void row_load(const float* xrow, int lane, f32x4 (&v)[4]) {
    const GAS f32x4* xr = (const GAS f32x4*)xrow + lane;
#pragma unroll
    for (int j = 0; j < 4; ++j) v[j] = xr[64 * j];
}
__device__ __forceinline__ void rms_row_finish(const float* g, bf16* orow, int lane, f32x4 (&v)[4]) {
    float s = 0.f;
#pragma unroll
    for (int j = 0; j < 4; ++j) s += (v[j].x * v[j].x + v[j].y * v[j].y) + (v[j].z * v[j].z + v[j].w * v[j].w);
    const float rstd = rsqrtf(wave_sum(s) * (1.f / D) + EPS);
    const GAS f32x4* gr = (const GAS f32x4*)g + lane;
    GAS unsigned long long* o8 = (GAS unsigned long long*)orow + lane;
#pragma unroll
    for (int j = 0; j < 4; ++j) { const f32x4 gg = gr[64 * j]; v[j] = v[j] * rstd * gg;
        o8[64 * j] = (unsigned long long)pk2(v[j].x, v[j].y) | ((unsigned long long)pk2(v[j].z, v[j].w) << 32); }
}
__device__ __forceinline__ void rms_row_to_bf16(const float* xrow, const float* g, bf16* orow, int lane, f32x4 (&v)[4]) { row_load(xrow, lane, v); rms_row_finish(g, orow, lane, v); }

constexpr int PH_P0 = 0, PH_P1 = 1, PH_P2 = 2, PH_SCAN = 3, PH_MLOUT = 4, PH_MIX = 5, PH_WOUT = 6, PH_ROUTE = 7, PH_G1 = 8, PH_G2S = 9, PH_G2P = 10, PH_END = 11;
constexpr size_t WS_G8 = 219 * MiB;
constexpr size_t WS_H1 = 35 * MiB;
constexpr size_t WS_HN = 99 * MiB;
constexpr size_t WS_WGU = 219 * MiB;
constexpr size_t WS_WD = 19 * MiB;
constexpr size_t WS_HH = 187 * MiB;
constexpr size_t WS_Y1 = 139 * MiB;


constexpr int CV_WGU = 32 * 256, CV_LATE = 1536 + 256 + 128 + 256 + 512, CV_ITEMS = CV_WGU + CV_LATE + 32 * 128;
__device__ __forceinline__ void cv_item(const Args& a, int it, const float*& W, int& ldw, int& K, bf16*& WT, int& kb, int& nb) {
    unsigned char* ws = a.ws;
    if (it < CV_WGU) { const int e = it >> 8, q = it & 255, sub = q >> 6, r = q & 63;
        W = ((sub & 1) ? a.in[26] : a.in[25]) + (size_t)e * 1024 * 256 + (sub >> 1) * 128; ldw = 256; K = 1024; WT = (bf16*)(ws + WS_WGU) + ((size_t)e * 512 + sub * 128) * 1024; kb = r >> 2; nb = r & 3; return; }
    int r = it - CV_WGU;
    if (r < 1536) { W = a.in[17]; ldw = 3072; K = 1024; WT = (bf16*)(ws + WS_WGATE); kb = r / 96; nb = r % 96; return; } r -= 1536;
    if (r < 256) { W = a.in[14]; ldw = 1024; K = 512; WT = (bf16*)(ws + WS_WA); kb = r >> 5; nb = r & 31; return; } r -= 256;
    if (r < 128) { W = a.in[15]; ldw = 1024; K = 256; WT = (bf16*)(ws + WS_WB); kb = r >> 5; nb = r & 31; return; } r -= 128;
    if (r < 256) { W = a.in[16]; ldw = 1024; K = 512; WT = (bf16*)(ws + WS_WC); kb = r >> 5; nb = r & 31; return; } r -= 256;
    if (r < 512) { W = a.in[19]; ldw = 1024; K = 1024; WT = (bf16*)(ws + WS_WOUT); kb = r >> 5; nb = r & 31; return; } r -= 512;
    { const int e = r >> 7, q = r & 127; W = a.in[27] + (size_t)e * 256 * 1024; ldw = 1024; K = 256; WT = (bf16*)(ws + WS_WD) + (size_t)e * 1024 * 256; kb = q >> 5; nb = q & 31; }
}
__device__ __forceinline__ void bg_load(const Args& a, int it, int lane, f32x4 (&v)[8]) { const float* W; int ldw, K, kb, nb; bf16* WT; cv_item(a, it, W, ldw, K, WT, kb, nb); tr_load(W, ldw, kb, nb, lane, v); }
__device__ __forceinline__ void bg_store(const Args& a, int it, int lane, const f32x4 (&v)[8]) { const float* W; int ldw, K, kb, nb; bf16* WT; cv_item(a, it, W, ldw, K, WT, kb, nb); tr_store(WT, K, kb, nb, lane, v); }
__device__ __forceinline__ void cv_range(const Args& a, int lo, int hi, int wi, int nw, int lane) {
    for (int it = lo + wi; it < hi; it += 3 * nw) { f32x4 v0[8], v1[8], v2[8]; const int it1 = it + nw, it2 = it + 2 * nw; const bool h1 = it1 < hi, h2 = it2 < hi;
        bg_load(a, it, lane, v0); bg_load(a, h1 ? it1 : it, lane, v1); bg_load(a, h2 ? it2 : it, lane, v2);
        bg_store(a, it, lane, v0); if (h1) bg_store(a, it1, lane, v1); if (h2) bg_store(a, it2, lane, v2); }
}
constexpr size_t WS_ENT = 131 * MiB;
constexpr size_t WS_ENTW = 135 * MiB;
constexpr int TOFF_LDS = 136192;

namespace pg8 {
template <int i0, int i1, int npn_shift, int gather>
struct MoeOrder {
    const PG8_LAS int* toff; int G, c, tbeg, tend, c2;
    __device__ __forceinline__ bool next(int i, Unit& u) const {
        if (c < 0) return false;
        const int L = (i == 0) ? c : i * G + c2; const int tau = tbeg + (L >> npn_shift), pn = L & ((1 << npn_shift) - 1);
        if (tau >= tend) return false;
        int li = i0;
        while (toff[li + 1] <= tau) ++li;
        const int t = tau - toff[li], v = (li + 32) & 63, e = v & 31;
        u.pm = gather ? (v * 64 + t) : tau; u.pn = pn; u.bt = (e << npn_shift) + pn; u.aux = (tau << 16) | (v << 8) | t;
        return true;
    }
};
struct EpiGLU {
    static constexpr bool PERM = true;
    bf16_t* H; const float* entw;
    __device__ __forceinline__ void operator()(const f32x4 (&acc)[2][2][4][2], const Unit& u, int wr, int wc, int fr, int fq) const {
        const int tau = u.aux >> 16, v = (u.aux >> 8) & 255, t = u.aux & 255;
        const int col0 = u.pn * 128 + wc * 32 + 8 * fq;
        int rb = wr * 64 + fr; asm volatile("" : "+v"(rb));
        const float* wrow = entw + (size_t)v * 16384 + t * 256 + rb; bf16_t* hrow = H + ((size_t)tau * 256 + rb) * 256 + col0;
        float wv8[2][4];
#pragma unroll
        for (int ai = 0; ai < 2; ++ai)
#pragma unroll
            for (int m = 0; m < 4; ++m) wv8[ai][m] = wrow[ai * HALF + m * 16];
#pragma unroll
        for (int ai = 0; ai < 2; ++ai)
#pragma unroll
            for (int m = 0; m < 4; ++m) { const float w = wv8[ai][m];
                f32x4 h0, h1;
#pragma unroll
                for (int j = 0; j < 4; ++j) { const float g0 = acc[ai][0][m][0][j], g1 = acc[ai][0][m][1][j];
                    h0[j] = g0 * fast_sigmoid(g0) * acc[ai][1][m][0][j] * w; h1[j] = g1 * fast_sigmoid(g1) * acc[ai][1][m][1][j] * w; }
                u32x4 o; o.x = cvt_pk_bf16(h0[0], h0[1]); o.y = cvt_pk_bf16(h0[2], h0[3]); o.z = cvt_pk_bf16(h1[0], h1[1]); o.w = cvt_pk_bf16(h1[2], h1[3]);
                { unsigned long long* hp = (unsigned long long*)(hrow + (size_t)(ai * HALF + m * 16) * 256);
                  __hip_atomic_store(hp, (unsigned long long)o.x | ((unsigned long long)o.y << 32), __ATOMIC_RELAXED, __HIP_MEMORY_SCOPE_AGENT);
                  __hip_atomic_store(hp + 1, (unsigned long long)o.z | ((unsigned long long)o.w << 32), __ATOMIC_RELAXED, __HIP_MEMORY_SCOPE_AGENT); } }
    }
};
template <bool PRIMARY>
struct EpiScatter {
    static constexpr bool PERM = true;
    const int* ent; const PG8_LAS int* cnt; bf16_t* Y1; const float* H1; float* OUT;
    __device__ __forceinline__ void operator()(const f32x4 (&acc)[2][2][4][2], const Unit& u, int wr, int wc, int fr, int fq) const {
        const int v = (u.aux >> 8) & 255, t = u.aux & 255;
        int tq; asm volatile("v_mbcnt_lo_u32_b32 %0, -1, 0\n\tv_mbcnt_hi_u32_b32 %0, -1, %0" : "=v"(tq));
        const unsigned col0 = (unsigned)(u.pn * BM + wc * 32 + 8 * (tq >> 4));
        const int rb = wr * 64 + (tq & 15);
        const char* eb = (const char*)(ent + (size_t)v * 16384 + t * 256); const unsigned rb4 = (unsigned)rb * 4u; const int nv = cnt[v] - t * 256 - rb;
        unsigned tok[2][4];
#pragma unroll
        for (int ai = 0; ai < 2; ++ai)
#pragma unroll
            for (int m = 0; m < 4; ++m) tok[ai][m] = (ai * HALF + m * 16 < nv) ? *(const unsigned*)(eb + rb4 + (unsigned)(ai * HALF + m * 16) * 4u) : 0u;
#pragma unroll
        for (int ai = 0; ai < 2; ++ai)
#pragma unroll
            for (int mp = 0; mp < 2; ++mp) {
                u32x4 yv[2][2]; f32x4 hv[2][2][2];
                if (PRIMARY) {
#pragma unroll
                    for (int mm = 0; mm < 2; ++mm)
#pragma unroll
                        for (int bj = 0; bj < 2; ++bj) { const unsigned o = tok[ai][2 * mp + mm] * 1024u + col0 + bj * HALF;
                            yv[mm][bj] = *(const u32x4*)((const char*)Y1 + o * 2u); hv[mm][bj][0] = *(const f32x4*)((const char*)H1 + o * 4u); hv[mm][bj][1] = *(const f32x4*)((const char*)H1 + o * 4u + 16u); }
                }
#pragma unroll
                for (int mm = 0; mm < 2; ++mm) { const int m = 2 * mp + mm;
                    if (ai * HALF + m * 16 < nv) {
#pragma unroll
                        for (int bj = 0; bj < 2; ++bj) { const unsigned o = tok[ai][m] * 1024u + col0 + bj * HALF; const f32x4 a0 = acc[ai][bj][m][0], a1 = acc[ai][bj][m][1];
                            if (PRIMARY) { const u32x4 y = yv[mm][bj]; f32x4 t0 = hv[mm][bj][0], t1 = hv[mm][bj][1];
                                t0[0] += a0[0] + bflo(y.x); t0[1] += a0[1] + bfhi(y.x); t0[2] += a0[2] + bflo(y.y); t0[3] += a0[3] + bfhi(y.y);
                                t1[0] += a1[0] + bflo(y.z); t1[1] += a1[1] + bfhi(y.z); t1[2] += a1[2] + bflo(y.w); t1[3] += a1[3] + bfhi(y.w);
                                *(f32x4*)((char*)OUT + o * 4u) = t0; *(f32x4*)((char*)OUT + o * 4u + 16u) = t1; }
                            else { u32x4 w; w.x = cvt_pk_bf16(a0[0], a0[1]); w.y = cvt_pk_bf16(a0[2], a0[3]); w.z = cvt_pk_bf16(a1[0], a1[1]); w.w = cvt_pk_bf16(a1[2], a1[3]); *(u32x4*)((char*)Y1 + o * 2u) = w; } } } }
                asm volatile("" ::: "memory"); }
    }
};
}

__device__ __forceinline__ void route_phase(const Frame& F, const Args& a, gu32* ctl, const XcdBarrier& bar) {
    const float* ln2_g = a.in[20]; const float* w_grp = a.in[21]; const float* b_grp = a.in[22]; const float* w_er = a.in[23]; const float* b_er = a.in[24];
    const float* w_eg = a.in[25]; const float* w_eu = a.in[26]; const float* w_ed = a.in[27];
    unsigned char* ws = a.ws;
    const float* H1 = (const float*)(ws + WS_H1); bf16* HN = (bf16*)(ws + WS_HN);
    int* ENT = (int*)(ws + WS_ENT); float* ENTW = (float*)(ws + WS_ENTW);
    __syncthreads();
    cv_range(a, 0, CV_WGU, F.gw, F.NGW, F_LANE); cv_range(a, CV_WGU + CV_LATE, CV_ITEMS, F.gw, F.NGW, F_LANE);
    split_wait(bar, 3, F_TID);
    LAS float* wer = (LAS float*)F.lds;
    for (int r = F_TID; r < 4096; r += NWAVES * 64) { const f32x4 wa = *(const f32x4*)(w_er + (size_t)r * 8), wb = *(const f32x4*)(w_er + (size_t)r * 8 + 4);
        const int g = r >> 10, k = r & 1023; LAS float* d = wer + (size_t)(g * 8) * 1024 + k;
        d[0] = wa.x; d[1024] = wa.y; d[2048] = wa.z; d[3072] = wa.w; d[4096] = wb.x; d[5120] = wb.y; d[6144] = wb.z; d[7168] = wb.w; }
    __syncthreads();
    const int lane = F_LANE;
    f32x4 wgq[4][4];
#pragma unroll
    for (int jj = 0; jj < 4; ++jj)
#pragma unroll
        for (int cc = 0; cc < 4; ++cc) wgq[jj][cc] = *(const f32x4*)(w_grp + (size_t)(4 * lane + 256 * jj + cc) * 4);
    for (int mb = F.gw; mb < M; mb += 2 * F.NGW) {
        f32x4 vv[2][4];
#pragma unroll
        for (int q = 0; q < 2; ++q) { const int m = mb + q * F.NGW; if (m < M) row_load(H1 + (size_t)m * D, lane, vv[q]); }
#pragma unroll
        for (int q = 0; q < 2; ++q) { const int m = mb + q * F.NGW; if (m >= M) break;
            f32x4 (&v)[4] = vv[q];
            rms_row_finish(ln2_g, HN + (size_t)m * D, lane, v);
            float gl[4] = {0.f, 0.f, 0.f, 0.f};
#pragma unroll
            for (int jj = 0; jj < 4; ++jj)
#pragma unroll
                for (int cc = 0; cc < 4; ++cc) { const float y = v[jj][cc]; const f32x4 w4 = wgq[jj][cc]; gl[0] += y * w4.x; gl[1] += y * w4.y; gl[2] += y * w4.z; gl[3] += y * w4.w; }
#pragma unroll
            for (int j = 0; j < 4; ++j) gl[j] = wave_sum(gl[j]) + b_grp[j];
            int gi = 0; float gmax = gl[0];
#pragma unroll
            for (int j = 1; j < 4; ++j) if (gl[j] > gmax) { gmax = gl[j]; gi = j; }
            float gden = 0.f;
#pragma unroll
            for (int j = 0; j < 4; ++j) gden += __expf(gl[j] - gmax);
            const float gw = 1.f / gden;
            gi = __builtin_amdgcn_readfirstlane(gi);
            const LAS float* we = wer + (size_t)(gi * 8) * 1024 + 4 * lane;
            float el[8];
#pragma unroll
            for (int j = 0; j < 8; ++j) { float s = 0.f;
#pragma unroll
                for (int jj = 0; jj < 4; ++jj) { const f32x4 w4 = *(const LAS f32x4*)(we + j * 1024 + 256 * jj); s += (v[jj].x * w4.x + v[jj].y * w4.y) + (v[jj].z * w4.z + v[jj].w * w4.w); }
                el[j] = wave_sum(s) + b_er[gi * 8 + j]; }
            int i0 = 0; float m0 = el[0];
#pragma unroll
            for (int j = 1; j < 8; ++j) if (el[j] > m0) { m0 = el[j]; i0 = j; }
            int i1 = -1; float m1 = -INFINITY;
#pragma unroll
            for (int j = 0; j < 8; ++j) if (j != i0 && el[j] > m1) { m1 = el[j]; i1 = j; }
            const float e1 = __expf(m1 - m0), w0 = gw / (1.f + e1), w1 = gw * e1 / (1.f + e1);
            if (lane == 0) {
                const int v0 = gi * 8 + i0, v1 = 32 + gi * 8 + i1;
                const unsigned r0 = __hip_atomic_fetch_add(ctl + CW_ECNT + 64 * v0, 1u, RLX_AGENT), r1 = __hip_atomic_fetch_add(ctl + CW_ECNT + 64 * v1, 1u, RLX_AGENT);
                ENT[(size_t)v0 * 16384 + r0] = m; ENTW[(size_t)v0 * 16384 + r0] = w0;
                ENT[(size_t)v1 * 16384 + r1] = m; ENTW[(size_t)v1 * 16384 + r1] = w1;
            }
        }
    }
}
__device__ __forceinline__ void moe_tile_offsets(const Frame& F, gu32* ctl) {
    LAS int* toff = (LAS int*)(F.lds + TOFF_LDS);
    __syncthreads();
    if (F_TID < 64) toff[80 + F_TID] = (int)__hip_atomic_load(ctl + CW_ECNT + 64 * F_TID, RLX_AGENT);
    __syncthreads();
    if (F_TID == 0) { int acc = 0; for (int i = 0; i < 64; ++i) { toff[i] = acc; acc += (toff[80 + ((i + 32) & 63)] + 255) >> 8; } toff[64] = acc; }
    __syncthreads();
}
constexpr int CW_SDONE = CW_ECNT + 64 * 64;
#define TOFFP ((const LAS int*)(F.lds + TOFF_LDS))
constexpr int G2LS = 528;
template <bool PRIMARY>
__device__ __forceinline__ void g2e_phase(const Frame& F, unsigned char* ws, float* OUT, int c, int G, const XcdBarrier& bar, int wait_inst) {
    LAS unsigned char* Bs = F.lds;
    const LAS int* toff = TOFFP; const LAS int* cnt = TOFFP + 80;
    const bf16* HH = (const bf16*)(ws + WS_HH); const bf16* WD = (const bf16*)(ws + WS_WD); const int* ENT = (const int*)(ws + WS_ENT);
    bf16* Y1 = (bf16*)(ws + WS_Y1); const float* H1 = (const float*)(ws + WS_H1);
    const int tid = F_TID, lane = tid & 63, i16 = lane & 15, quad = lane >> 4, w = F.wave;
    for (int u = (c >= 0 ? c : 256); u < 256; u += G) {
        const int e = u >> 3, pn = (u >> 1) & 3, hh = u & 1, v = (PRIMARY ? 0 : 32) + e, li = (v + 32) & 63;
        const int n = __builtin_amdgcn_readfirstlane(cnt[v]), hbase = __builtin_amdgcn_readfirstlane(toff[li]) * 256;
        const int half = ((((n + 1) >> 1) + 15) & ~15), rbeg = hh ? half : 0, rend = hh ? n : (half < n ? half : n);
        const int nstrip = (rend > rbeg) ? ((rend - rbeg + 15) >> 4) : 0;
        __syncthreads();
        bf16x8 af[8]; unsigned tok = 0u; int row = rbeg + 16 * w + i16;
        if (nstrip > 0) {
            const v4u* gb = (const v4u*)(WD + ((size_t)e * 1024 + pn * 256) * 256);
            v4u rb[16];
#pragma unroll
            for (int i = 0; i < 16; ++i) rb[i] = gb[tid + 512 * i];
            if (wait_inst >= 0) { split_wait(bar, wait_inst, tid); wait_inst = -1; }
            if (w < nstrip) { if (row < rend) tok = (unsigned)ENT[(size_t)v * 16384 + row];
                const bf16* hrow = HH + ((size_t)hbase + row) * 256 + 8 * quad;
#pragma unroll
                for (int ks = 0; ks < 8; ++ks) af[ks] = *(const bf16x8*)(hrow + 32 * ks); }
            const int c0 = tid >> 5, ch = tid & 31, L0 = 16 * ((c0 >> 2) & 1) + 4 * ((c0 >> 3) & 1) + (c0 & 3);
            LAS unsigned char* sb = Bs + L0 * G2LS + ch * 16;
#pragma unroll
            for (int i = 0; i < 16; ++i) *(LAS v4u*)(sb + (32 * (i >> 1) + 8 * (i & 1)) * G2LS) = rb[i];
        }
        __syncthreads();
        for (int s = w; s < nstrip; s += NWAVES) {
            const bool valid = row < rend;
            const unsigned ob = tok * 1024u + (unsigned)(pn * 256 + 8 * quad);
            v4u yv[8]; f32x4 hv[8][2];
            if (PRIMARY) {
#pragma unroll
                for (int p = 0; p < 8; ++p) { const unsigned o = ob + 32u * p; yv[p] = *(const v4u*)((const char*)Y1 + o * 2u); hv[p][0] = *(const f32x4*)((const char*)H1 + o * 4u); hv[p][1] = *(const f32x4*)((const char*)H1 + o * 4u + 16u); }
            }
            bf16x8 afn[8]; unsigned tokn = 0u; const int rown = row + 16 * NWAVES; const bool more = s + NWAVES < nstrip;
            if (!PRIMARY && more) { if (rown < rend) tokn = (unsigned)ENT[(size_t)v * 16384 + rown];
                const bf16* hrow = HH + ((size_t)hbase + rown) * 256 + 8 * quad;
#pragma unroll
                for (int ks = 0; ks < 8; ++ks) afn[ks] = *(const bf16x8*)(hrow + 32 * ks); }
            f32x4 acc[16];
#pragma unroll
            for (int nt = 0; nt < 16; ++nt) { acc[nt] = (f32x4){0.f, 0.f, 0.f, 0.f};
#pragma unroll
                for (int ks = 0; ks < 8; ++ks) acc[nt] = __builtin_amdgcn_mfma_f32_16x16x32_bf16(*(const LAS bf16x8*)(Bs + (16 * nt + i16) * G2LS + (32 * ks + 8 * quad) * 2), af[ks], acc[nt], 0, 0, 0);
                if (nt & 1) asm volatile("" ::: "memory"); }
            if (PRIMARY && more) { if (rown < rend) tokn = (unsigned)ENT[(size_t)v * 16384 + rown];
                const bf16* hrow = HH + ((size_t)hbase + rown) * 256 + 8 * quad;
#pragma unroll
                for (int ks = 0; ks < 8; ++ks) af[ks] = *(const bf16x8*)(hrow + 32 * ks); }
            if (valid) {
#pragma unroll
                for (int p = 0; p < 8; ++p) { const unsigned o = ob + 32u * p; const f32x4 a0 = acc[2 * p], a1 = acc[2 * p + 1];
                    if (PRIMARY) { const v4u y = yv[p]; f32x4 t0 = hv[p][0], t1 = hv[p][1];
                        t0[0] += a0[0] + pg8::bflo(y.x); t0[1] += a0[1] + pg8::bfhi(y.x); t0[2] += a0[2] + pg8::bflo(y.y); t0[3] += a0[3] + pg8::bfhi(y.y);
                        t1[0] += a1[0] + pg8::bflo(y.z); t1[1] += a1[1] + pg8::bfhi(y.z); t1[2] += a1[2] + pg8::bflo(y.w); t1[3] += a1[3] + pg8::bfhi(y.w);
                        *(f32x4*)((char*)OUT + o * 4u) = t0; *(f32x4*)((char*)OUT + o * 4u + 16u) = t1; }
                    else { v4u wv; wv.x = pg8::cvt_pk_bf16(a0[0], a0[1]); wv.y = pg8::cvt_pk_bf16(a0[2], a0[3]); wv.z = pg8::cvt_pk_bf16(a1[0], a1[1]); wv.w = pg8::cvt_pk_bf16(a1[2], a1[3]); *(v4u*)((char*)Y1 + o * 2u) = wv; } }
            }
            if (more) {
                if (!PRIMARY) {
#pragma unroll
                    for (int ks = 0; ks < 8; ++ks) af[ks] = afn[ks]; }
                tok = tokn; row = rown; }
        }
    }
    if (wait_inst >= 0) split_wait(bar, wait_inst, tid);
    __syncthreads();
}
#define MEGA_MOE_PHASES \
    if (IN(PH_ROUTE)) { route_phase(F, args, ctl, bar); } \
    SEAM(PH_ROUTE); \
    if (IN(PH_G1)) { moe_tile_offsets(F, ctl); \
        const int tS = __builtin_amdgcn_readfirstlane(TOFFP[32]), tA = __builtin_amdgcn_readfirstlane(TOFFP[64]);     \
        const int c2 = (c - 2 * tS + F.G) % F.G;     \
        {     \
            pg8::MoeOrder<0, 64, 1, 1> S{TOFFP, F.G, c, 0, tA, c2}; \
            pg8::Gemm g{(const bf16*)(ws + WS_HN), (const bf16*)(ws + WS_WGU), 1024, 1024, (const int*)(ws + WS_ENT)}; \
            pg8::EpiGLU E{(bf16*)(ws + WS_HH), (const float*)(ws + WS_ENTW)}; \
            pg8::gemm_phase<pg8::EpiGLU, pg8::MoeOrder<0, 64, 1, 1>, true, true>(F.lds, g, S, E, F.wave); } \
        {     \
            int nsec = 0; for (int i = 0;; ++i) { const int L = (i == 0) ? c : i * F.G + c2; if (L >= 2 * tA) break; if (L < 2 * tS) ++nsec; } \
            VM_WAIT(); __syncthreads(); \
            if (F_TID == 0 && nsec > 0) { __hip_atomic_fetch_add(ctl + CW_SDONE, (unsigned)nsec, RLX_AGENT); }     \
            const int nbusy = (F.G == 256 && 2 * tA > F.G) ? (2 * tA - F.G) : 0;     \
            const int nfree = F.G - nbusy, cf = (c2 >= nbusy) ? (c2 - nbusy) : -1; \
            if (cf >= 0) { \
                if (F_TID == 0) { unsigned sp = 0; while (__hip_atomic_load(ctl + CW_SDONE, RLX_AGENT) < (unsigned)(2 * tS)) { __builtin_amdgcn_s_sleep(2); if (++sp > (1u << 22)) break; } \
                    __builtin_amdgcn_fence(__ATOMIC_ACQUIRE, "agent"); VM_WAIT(); } \
                __syncthreads(); \
            } \
            g2e_phase<false>(F, ws, args.out, cf, nfree, bar, -1); } \
        split_arrive(bar, 4, F_TID);     \
    } \
    if (IN(PH_G2P)) { moe_tile_offsets(F, ctl); g2e_phase<true>(F, ws, args.out, c, F.G, bar, 4); }
__device__ __forceinline__ void ml_scan_phase(const Frame& F, float* CL, float* NL, float* SC) {
    const int gt = F.gw * 64 + F_LANE, NT = F.NGW * 64;
    for (int e = gt; e < 16 * 16512; e += NT) {
        const int bh = e / 16512, r = e % 16512; const bool isn = r >= 16384;
        float* p0 = isn ? (NL + (size_t)bh * NCHUNK * 128 + (r - 16384)) : (CL + (size_t)bh * NCHUNK * 16384 + r);
        const size_t stride = isn ? 128 : 16384;
        float loc[NCHUNK];
#pragma unroll
        for (int c = 0; c < NCHUNK; ++c) loc[c] = p0[c * stride];
        float st = 0.f, mcur = 0.f;
#pragma unroll
        for (int c = 0; c < NCHUNK; ++c) {
            const int u = bh * NCHUNK + c;
            const float bl = SC[u * 4 + 0], ml = SC[u * 4 + 1];
            const float mnew = fmaxf(bl + mcur, ml), dec = __expf(bl + mcur - mnew), sl = __expf(ml - mnew);
            p0[c * stride] = st; st = dec * st + sl * loc[c];
            if (r == 0) SC[u * 4 + 2] = mcur;
            mcur = mnew;
        }
    }
}
#define MFMA16(a, b, c) __builtin_amdgcn_mfma_f32_16x16x32_bf16((a), (b), (c), 0, 0, 0)
__device__ __forceinline__ bf16x8 lds_frag(const LAS unsigned char* p) { return *(const LAS bf16x8*)p; }
__device__ __forceinline__ bf16x8 lds_frag_tr2(const LAS unsigned char* p0, const LAS unsigned char* p1) {
    const s16x4 a = __builtin_amdgcn_ds_read_tr16_b64_v4i16((LAS s16x4*)p0), b = __builtin_amdgcn_ds_read_tr16_b64_v4i16((LAS s16x4*)p1);
    bf16x8 r; r[0] = a[0]; r[1] = a[1]; r[2] = a[2]; r[3] = a[3]; r[4] = b[0]; r[5] = b[1]; r[6] = b[2]; r[7] = b[3]; return r;
}
__device__ __forceinline__ bf16x8 pack8(f32x4 a, f32x4 b) {
    v4u w; w.x = pg8::cvt_pk_bf16(a[0], a[1]); w.y = pg8::cvt_pk_bf16(a[2], a[3]); w.z = pg8::cvt_pk_bf16(b[0], b[1]); w.w = pg8::cvt_pk_bf16(b[2], b[3]);
    return __builtin_bit_cast(bf16x8, w);
}
__device__ __forceinline__ float bfs(short s) { return __uint_as_float(((unsigned)(unsigned short)s) << 16); }
__device__ __forceinline__ float quad_sum(float v) { v += __shfl_xor(v, 16); v += __shfl_xor(v, 32); return v; }
__device__ __forceinline__ float quad_max(float v) { v = fmaxf(v, __shfl_xor(v, 16)); v = fmaxf(v, __shfl_xor(v, 32)); return v; }

constexpr int XS = 272;
__device__ __forceinline__ void cross_job(const Frame& F, bf16* Z, const bf16* kvm, const float* qg, const float* kg, int job) {
    const int b = job >> 6, h = (job >> 4) & 3, qblk = job & 15;
    LAS unsigned char* Ks = F.lds; LAS unsigned char* Vs = F.lds + 256 * XS;
    const int tid = F_TID, lane = tid & 63, i16 = lane & 15, quad = lane >> 4;
    __syncthreads();
    for (int c = tid; c < 256 * 16; c += 512) { const int row = c >> 4, ch = c & 15;
        const v4u* src = (const v4u*)(kvm + (size_t)(b * MEM_LEN + row) * 1024 + h * 128 + ch * 8);
        const bf16x8 kr = __builtin_bit_cast(bf16x8, src[0]); float kv[8]; float ss = 0.f;
#pragma unroll
        for (int e = 0; e < 8; ++e) { kv[e] = bfs(kr[e]); ss += kv[e] * kv[e]; }
        ss += DPP_F(ss, 0xB1, 0xf); ss += DPP_F(ss, 0x4E, 0xf); ss += DPP_F(ss, 0x141, 0xf); ss += DPP_F(ss, 0x140, 0xf);
        const float rstd = rsqrtf(ss * (1.f / 128) + EPS);
        const f32x4 g0 = *(const f32x4*)(kg + ch * 8), g1 = *(const f32x4*)(kg + ch * 8 + 4);
        f32x4 a, c2; a[0] = kv[0] * rstd * g0[0]; a[1] = kv[1] * rstd * g0[1]; a[2] = kv[2] * rstd * g0[2]; a[3] = kv[3] * rstd * g0[3];
        c2[0] = kv[4] * rstd * g1[0]; c2[1] = kv[5] * rstd * g1[1]; c2[2] = kv[6] * rstd * g1[2]; c2[3] = kv[7] * rstd * g1[3];
        *(LAS bf16x8*)(Ks + row * XS + ch * 16) = pack8(a, c2); *(LAS v4u*)(Vs + row * XS + ch * 16) = src[64]; }
    __syncthreads();
    for (int pass = 0; pass < 2; ++pass) {
        const int t0 = qblk * 256 + pass * 128 + F.wave * 16;
        bf16* qrow = Z + (size_t)(b * SEQ + t0 + i16) * ZW + Z_XQ + h * 128;
        bf16x8 qf[4]; float ss = 0.f; float qv[4][8];
#pragma unroll
        for (int ks = 0; ks < 4; ++ks) { const bf16x8 raw = *(const bf16x8*)(qrow + 32 * ks + 8 * quad);
#pragma unroll
            for (int e = 0; e < 8; ++e) { qv[ks][e] = bfs(raw[e]); ss += qv[ks][e] * qv[ks][e]; } }
        const float rstd = rsqrtf(quad_sum(ss) * (1.f / 128) + EPS) * 0.08838834764831845f;
#pragma unroll
        for (int ks = 0; ks < 4; ++ks) { const f32x4 g0 = *(const f32x4*)(qg + 32 * ks + 8 * quad), g1 = *(const f32x4*)(qg + 32 * ks + 8 * quad + 4);
            f32x4 a, c2; a[0] = qv[ks][0] * rstd * g0[0]; a[1] = qv[ks][1] * rstd * g0[1]; a[2] = qv[ks][2] * rstd * g0[2]; a[3] = qv[ks][3] * rstd * g0[3];
            c2[0] = qv[ks][4] * rstd * g1[0]; c2[1] = qv[ks][5] * rstd * g1[1]; c2[2] = qv[ks][6] * rstd * g1[2]; c2[3] = qv[ks][7] * rstd * g1[3];
            qf[ks] = pack8(a, c2); }
        f32x4 s[16];
#pragma unroll
        for (int jt = 0; jt < 16; ++jt) { s[jt] = (f32x4){0.f, 0.f, 0.f, 0.f};
#pragma unroll
            for (int ks = 0; ks < 4; ++ks) s[jt] = MFMA16(lds_frag(Ks + (16 * jt + i16) * XS + (32 * ks + 8 * quad) * 2), qf[ks], s[jt]);
            if (jt & 1) asm volatile("" ::: "memory"); }
        float mx = -INFINITY;
#pragma unroll
        for (int jt = 0; jt < 16; ++jt) mx = fmaxf(mx, fmaxf(fmaxf(s[jt][0], s[jt][1]), fmaxf(s[jt][2], s[jt][3])));
        mx = quad_max(mx);
        float l = 0.f;
#pragma unroll
        for (int jt = 0; jt < 16; ++jt) {
#pragma unroll
            for (int r = 0; r < 4; ++r) { s[jt][r] = __expf(s[jt][r] - mx); l += s[jt][r]; } }
        l = quad_sum(l);
        f32x4 o[8];
#pragma unroll
        for (int dt = 0; dt < 8; ++dt) o[dt] = (f32x4){0.f, 0.f, 0.f, 0.f};
#pragma unroll
        for (int kk = 0; kk < 8; ++kk) { const bf16x8 pf = pack8(s[2 * kk], s[2 * kk + 1]);
            const LAS unsigned char* vb = Vs + (32 * kk + 4 * quad + (i16 >> 2)) * XS + (4 * (i16 & 3)) * 2;
#pragma unroll
            for (int dt = 0; dt < 8; ++dt) o[dt] = MFMA16(lds_frag_tr2(vb + dt * 32, vb + 16 * XS + dt * 32), pf, o[dt]);
            asm volatile("" ::: "memory"); }
        const float inv = 1.f / l;
#pragma unroll
        for (int dt = 0; dt < 8; ++dt) { uint2 w; w.x = pg8::cvt_pk_bf16(o[dt][0] * inv, o[dt][1] * inv); w.y = pg8::cvt_pk_bf16(o[dt][2] * inv, o[dt][3] * inv);
            *(uint2*)(qrow + 16 * dt + 4 * quad) = w; }
    }
}

constexpr int DS = 144;
struct DilUnit { int b, g, h, r, res, blk; };
__device__ __forceinline__ DilUnit dil_decode(int u) {
    DilUnit d; const int rb = u & 31; d.h = (u >> 5) & 3; d.g = (u >> 7) % 3; d.b = u / 384;
    const int lr = (d.g == 0) ? 0 : (d.g == 1 ? 2 : 4), nblk = 32 >> lr; d.r = 1 << lr; d.res = rb / nblk; d.blk = rb % nblk; return d;
}
struct DilPre { v4u kw[4], vw[4]; bf16x8 qraw[2]; f32x4 kg0, kg1; };
__device__ __forceinline__ void dil_load(const bf16* Z, const float* kg, const DilUnit& d, int tid, int wave, DilPre& p) {
    const int colk = Z_DK + d.g * 256 + d.h * 64, colv = Z_DV + d.g * 256 + d.h * 64, colq = Z_DQ + d.g * 256 + d.h * 64;
#pragma unroll
    for (int it = 0; it < 4; ++it) { const int c = tid + 512 * it, j = c >> 3, ch = c & 7, ak0 = 128 * (d.blk - 1) + j, ak = ak0 < 0 ? 0 : ak0;
        const bf16* rowp = Z + (size_t)(d.b * SEQ + ak * d.r + d.res) * ZW; p.kw[it] = *(const v4u*)(rowp + colk + ch * 8); p.vw[it] = *(const v4u*)(rowp + colv + ch * 8); }
    const int lane = tid & 63, i16 = lane & 15, quad = lane >> 4, aq = 128 * d.blk + 16 * wave + i16;
    const bf16* qrow = Z + (size_t)(d.b * SEQ + aq * d.r + d.res) * ZW + colq;
#pragma unroll
    for (int ks = 0; ks < 2; ++ks) p.qraw[ks] = *(const bf16x8*)(qrow + 32 * ks + 8 * quad);
    p.kg0 = *(const f32x4*)(kg + d.g * 64 + (tid & 7) * 8); p.kg1 = *(const f32x4*)(kg + d.g * 64 + (tid & 7) * 8 + 4);
}
__device__ __forceinline__ void dil_stage(LAS unsigned char* Ks, LAS unsigned char* Vs, const DilUnit& d, int tid, const DilPre& p) {
    const f32x4 g0 = p.kg0, g1 = p.kg1;
#pragma unroll
    for (int it = 0; it < 4; ++it) { const int c = tid + 512 * it, j = c >> 3, ch = c & 7; const bool ok = d.blk > 0 || j >= 128;
        const v4u kwv = ok ? p.kw[it] : (v4u){0u, 0u, 0u, 0u}, vwv = ok ? p.vw[it] : (v4u){0u, 0u, 0u, 0u};
        const bf16x8 kr = __builtin_bit_cast(bf16x8, kwv); float kv[8]; float ss = 0.f;
#pragma unroll
        for (int e = 0; e < 8; ++e) { kv[e] = bfs(kr[e]); ss += kv[e] * kv[e]; }
        ss += DPP_F(ss, 0xB1, 0xf); ss += DPP_F(ss, 0x4E, 0xf); ss += DPP_F(ss, 0x141, 0xf);
        const float rstd = rsqrtf(ss * (1.f / 64) + EPS);
        f32x4 a, c2; a[0] = kv[0] * rstd * g0[0]; a[1] = kv[1] * rstd * g0[1]; a[2] = kv[2] * rstd * g0[2]; a[3] = kv[3] * rstd * g0[3];
        c2[0] = kv[4] * rstd * g1[0]; c2[1] = kv[5] * rstd * g1[1]; c2[2] = kv[6] * rstd * g1[2]; c2[3] = kv[7] * rstd * g1[3];
        *(LAS bf16x8*)(Ks + j * DS + ch * 16) = pack8(a, c2); *(LAS v4u*)(Vs + j * DS + ch * 16) = vwv; }
}
__device__ __forceinline__ void dil_compute(const LAS unsigned char* Ks, const LAS unsigned char* Vs, bf16* Z, const f32x4 (&qgv)[2][2], float* LSE, const DilUnit& d, int tid, int w, const bf16x8 (&qraw)[2]) {
    const int lane = tid & 63, i16 = lane & 15, quad = lane >> 4, g = d.g, blk = d.blk;
    const int aq = 128 * blk + 16 * w + i16;
    const int mrow = d.b * SEQ + aq * d.r + d.res;
    bf16* qrow = Z + (size_t)mrow * ZW + Z_DQ + g * 256 + d.h * 64;
    bf16x8 qf[2]; { float qv[2][8]; float ss = 0.f;
#pragma unroll
        for (int ks = 0; ks < 2; ++ks) {
#pragma unroll
            for (int e = 0; e < 8; ++e) { qv[ks][e] = bfs(qraw[ks][e]); ss += qv[ks][e] * qv[ks][e]; } }
        const float rstd = rsqrtf(quad_sum(ss) * (1.f / 64) + EPS) * 0.125f;
#pragma unroll
        for (int ks = 0; ks < 2; ++ks) { const f32x4 g0 = qgv[ks][0], g1 = qgv[ks][1];
            f32x4 a, c2; a[0] = qv[ks][0] * rstd * g0[0]; a[1] = qv[ks][1] * rstd * g0[1]; a[2] = qv[ks][2] * rstd * g0[2]; a[3] = qv[ks][3] * rstd * g0[3];
            c2[0] = qv[ks][4] * rstd * g1[0]; c2[1] = qv[ks][5] * rstd * g1[1]; c2[2] = qv[ks][6] * rstd * g1[2]; c2[3] = qv[ks][7] * rstd * g1[3];
            qf[ks] = pack8(a, c2); } }
    f32x4 s[10]; float mx = -INFINITY;
#pragma unroll
    for (int dj = 0; dj < 9; ++dj) { s[dj] = (f32x4){0.f, 0.f, 0.f, 0.f};
#pragma unroll
        for (int ks = 0; ks < 2; ++ks) s[dj] = MFMA16(lds_frag(Ks + (16 * (w + dj) + i16) * DS + (32 * ks + 8 * quad) * 2), qf[ks], s[dj]);
#pragma unroll
        for (int rg = 0; rg < 4; ++rg) { const int jj = 16 * dj + 4 * quad + rg; const bool ok = (jj >= i16) && (jj <= i16 + 128) && (blk > 0 || 16 * w + jj >= 128);
            s[dj][rg] = ok ? s[dj][rg] : -INFINITY; mx = fmaxf(mx, s[dj][rg]); } }
    mx = quad_max(mx);
    float l = 0.f;
#pragma unroll
    for (int dj = 0; dj < 9; ++dj)
#pragma unroll
        for (int rg = 0; rg < 4; ++rg) { s[dj][rg] = __expf(s[dj][rg] - mx); l += s[dj][rg]; }
    l = quad_sum(l);
    s[9] = (f32x4){0.f, 0.f, 0.f, 0.f};
    f32x4 o[4];
#pragma unroll
    for (int dt = 0; dt < 4; ++dt) o[dt] = (f32x4){0.f, 0.f, 0.f, 0.f};
#pragma unroll
    for (int kk = 0; kk < 5; ++kk) { const bf16x8 pf = pack8(s[2 * kk], s[2 * kk + 1]);
        const LAS unsigned char* vb = Vs + (16 * w + 32 * kk + 4 * quad + (i16 >> 2)) * DS + (4 * (i16 & 3)) * 2;
#pragma unroll
        for (int dt = 0; dt < 4; ++dt) o[dt] = MFMA16(lds_frag_tr2(vb + dt * 32, vb + 16 * DS + dt * 32), pf, o[dt]); }
    const float inv = 1.f / l;
#pragma unroll
    for (int dt = 0; dt < 4; ++dt) { uint2 wv; wv.x = pg8::cvt_pk_bf16(o[dt][0] * inv, o[dt][1] * inv); wv.y = pg8::cvt_pk_bf16(o[dt][2] * inv, o[dt][3] * inv);
        *(uint2*)(qrow + 16 * dt + 4 * quad) = wv; }
    LSE[((size_t)g * M + mrow) * 4 + d.h] = mx + __logf(l);
}
__device__ __forceinline__ void dil_phase(const Frame& F, bf16* Z, const float* qg, const float* kg, float* LSE, int c) {
    LAS unsigned char* Ks = F.lds; LAS unsigned char* Vs = F.lds + 256 * DS;
    const int tid = F_TID;
    __syncthreads();
    if (tid < 128) *(LAS v4u*)(Vs + (256 + (tid >> 3)) * DS + (tid & 7) * 16) = (v4u){0u, 0u, 0u, 0u};
    DilUnit cur = dil_decode(c < 1536 ? c : 0); DilPre pre; dil_load(Z, kg, cur, tid, F.wave, pre);
    for (int u = c; u < 1536; u += F.G) {
        __syncthreads();
        dil_stage(Ks, Vs, cur, tid, pre);
        bf16x8 qr[2] = {pre.qraw[0], pre.qraw[1]};
        __syncthreads();
        const DilUnit now = cur; const int un = u + F.G;
        f32x4 qgv[2][2];
#pragma unroll
        for (int ks = 0; ks < 2; ++ks) { qgv[ks][0] = *(const f32x4*)(qg + now.g * 64 + 32 * ks + 8 * ((tid & 63) >> 4)); qgv[ks][1] = *(const f32x4*)(qg + now.g * 64 + 32 * ks + 8 * ((tid & 63) >> 4) + 4); }
        cur = dil_decode(un < 1536 ? un : u); dil_load(Z, kg, cur, tid, F.wave, pre);
        asm volatile("" ::: "memory");
        dil_compute(Ks, Vs, Z, qgv, LSE, now, tid, F.wave, qr);
    }
}
__device__ __forceinline__ void dil_merge_phase(const Frame& F, bf16* Z, const float* LSE) {
    const int gt = F.gw * 64 + F_LANE, NT = F.NGW * 64;
    for (int it0 = gt; it0 < M * 32; it0 += 2 * NT) {
        float l[2][3]; bf16x8 av[2][3]; bf16* pp[2];
#pragma unroll
        for (int q = 0; q < 2; ++q) { const int it = it0 + q * NT; const int m = (it < M * 32) ? (it >> 5) : 0, h = (it >> 3) & 3, ch = it & 7;
            l[q][0] = LSE[((size_t)0 * M + m) * 4 + h]; l[q][1] = LSE[((size_t)1 * M + m) * 4 + h]; l[q][2] = LSE[((size_t)2 * M + m) * 4 + h];
            pp[q] = Z + (size_t)m * ZW + Z_DQ + h * 64 + ch * 8;
            av[q][0] = *(const bf16x8*)pp[q]; av[q][1] = *(const bf16x8*)(pp[q] + 256); av[q][2] = *(const bf16x8*)(pp[q] + 512); }
#pragma unroll
        for (int q = 0; q < 2; ++q) { if (it0 + q * NT >= M * 32) break;
            const float mxl = fmaxf(l[q][0], fmaxf(l[q][1], l[q][2])), e0 = __expf(l[q][0] - mxl), e1 = __expf(l[q][1] - mxl), e2 = __expf(l[q][2] - mxl), inv = 1.f / (e0 + e1 + e2);
            f32x4 x, y;
#pragma unroll
            for (int e = 0; e < 4; ++e) { x[e] = (e0 * bfs(av[q][0][e]) + e1 * bfs(av[q][1][e]) + e2 * bfs(av[q][2][e])) * inv; y[e] = (e0 * bfs(av[q][0][e + 4]) + e1 * bfs(av[q][1][e + 4]) + e2 * bfs(av[q][2][e + 4])) * inv; }
            *(bf16x8*)pp[q] = pack8(x, y); }
    }
}

constexpr int MS = 272;
__device__ __forceinline__ void conv_silu8(const bf16* Z, const float* cw, int m, int c0, float (&y)[8]) {
    const int t = m % SEQ;
#pragma unroll
    for (int e = 0; e < 8; ++e) y[e] = 0.f;
#pragma unroll
    for (int j = 0; j < 4; ++j) { if (t - 3 + j >= 0) { const bf16x8 z = *(const bf16x8*)(Z + (size_t)(m - 3 + j) * ZW + c0);
            const f32x4 w0 = *(const f32x4*)(cw + j * 1024 + c0), w1 = *(const f32x4*)(cw + j * 1024 + c0 + 4);
            y[0] += w0[0] * bfs(z[0]); y[1] += w0[1] * bfs(z[1]); y[2] += w0[2] * bfs(z[2]); y[3] += w0[3] * bfs(z[3]);
            y[4] += w1[0] * bfs(z[4]); y[5] += w1[1] * bfs(z[5]); y[6] += w1[2] * bfs(z[6]); y[7] += w1[3] * bfs(z[7]); } }
#pragma unroll
    for (int e = 0; e < 8; ++e) y[e] = y[e] * pg8::fast_sigmoid(y[e]);
}
__device__ __forceinline__ void conv_silu8x4(const bf16* Z, const float* cw, int m, int c0, float (&y)[4][8]) {
    const int t = m % SEQ;
    f32x4 w[4][2];
#pragma unroll
    for (int j = 0; j < 4; ++j) { w[j][0] = *(const f32x4*)(cw + j * 1024 + c0); w[j][1] = *(const f32x4*)(cw + j * 1024 + c0 + 4); }
    bf16x8 z[7];
#pragma unroll
    for (int i = 0; i < 7; ++i) { z[i] = (bf16x8){0, 0, 0, 0, 0, 0, 0, 0}; if (t - 3 + i >= 0) z[i] = *(const bf16x8*)(Z + (size_t)(m - 3 + i) * ZW + c0); }
#pragma unroll
    for (int r = 0; r < 4; ++r) {
#pragma unroll
        for (int e = 0; e < 8; ++e) { float acc = 0.f;
#pragma unroll
            for (int j = 0; j < 4; ++j) acc += w[j][e >> 2][e & 3] * bfs(z[r + j][e]);
            y[r][e] = acc * pg8::fast_sigmoid(acc); } }
}
__device__ __forceinline__ void wave_scan_sum2(float v0, float v1, int lane, float& p0, float& p1) {
    float p = v0 + v1;
#pragma unroll
    for (int off = 1; off < 64; off <<= 1) { const float t = __shfl_up(p, off); if (lane >= off) p += t; }
    p1 = p; p0 = p - v1;
}
__device__ __forceinline__ void wave_scan_max2(float v0, float v1, int lane, float& p0, float& p1) {
    float p = fmaxf(v0, v1);
#pragma unroll
    for (int off = 1; off < 64; off <<= 1) { const float t = __shfl_up(p, off); if (lane >= off) p = fmaxf(p, t); }
    const float prev = __shfl_up(p, 1);
    p1 = p; p0 = (lane > 0) ? fmaxf(prev, v0) : v0;
}
__device__ __forceinline__ void ml_local_fast(const Frame& F, const bf16* Z, const float* cw, const float* ifg, float* CL, float* NL, float* SC, int u) {
    LAS unsigned char* Ks = F.lds; LAS unsigned char* Vs = F.lds + 128 * MS; LAS float* av = (LAS float*)(F.lds + 256 * MS); LAS float* npart = av + 128;
    const int c = u % NCHUNK, h = (u / NCHUNK) % 4, b = u / (NCHUNK * 4), tid = F_TID, lane = tid & 63, i16 = lane & 15, quad = lane >> 4;
    const int m0 = b * SEQ + c * 128;
    __syncthreads();
    if (F.wave == 0) {
        const float f0 = log_sigmoid_(ifg[(size_t)(m0 + 2 * lane) * 8 + 4 + h]), f1 = log_sigmoid_(ifg[(size_t)(m0 + 2 * lane + 1) * 8 + 4 + h]);
        float b0, b1; wave_scan_sum2(f0, f1, lane, b0, b1);
        const float bl = __shfl(b1, 63);
        const float le0 = bl - b0 + ifg[(size_t)(m0 + 2 * lane) * 8 + h], le1 = bl - b1 + ifg[(size_t)(m0 + 2 * lane + 1) * 8 + h];
        const float ml = wave_max(fmaxf(le0, le1));
        av[2 * lane] = __expf(le0 - ml); av[2 * lane + 1] = __expf(le1 - ml);
        if (lane == 0) { SC[u * 4 + 0] = bl; SC[u * 4 + 1] = ml; }
    }
    __syncthreads();
    { const int sg = tid >> 4, ch = tid & 15; float y[4][8];
      conv_silu8x4(Z, cw, m0 + 4 * sg, 512 + h * 128 + ch * 8, y);
#pragma unroll
      for (int r = 0; r < 4; ++r) { const int s = 4 * sg + r; const float sc = 0.08838834764831845f * av[s];
          f32x4 a, c2; a[0] = y[r][0] * sc; a[1] = y[r][1] * sc; a[2] = y[r][2] * sc; a[3] = y[r][3] * sc; c2[0] = y[r][4] * sc; c2[1] = y[r][5] * sc; c2[2] = y[r][6] * sc; c2[3] = y[r][7] * sc;
          *(LAS bf16x8*)(Ks + s * MS + ch * 16) = pack8(a, c2);
          *(LAS v4u*)(Vs + s * MS + ch * 16) = *(const v4u*)(Z + (size_t)(m0 + s) * ZW + Z_MV + h * 128 + ch * 8); } }
    __syncthreads();
    { const int d = tid & 127, sq = tid >> 7; float acc = 0.f;
      for (int s = sq * 32; s < sq * 32 + 32; ++s) acc += bfs(*(const LAS short*)(Ks + s * MS + d * 2));
      npart[sq * 128 + d] = acc; }
    const int w = F.wave;
    f32x4 acc[8];
#pragma unroll
    for (int dt = 0; dt < 8; ++dt) acc[dt] = (f32x4){0.f, 0.f, 0.f, 0.f};
#pragma unroll
    for (int ks = 0; ks < 4; ++ks) {
        const int rbase = 32 * ks + 8 * quad + (i16 >> 2), cb = 4 * (i16 & 3) * 2;
        const bf16x8 af = lds_frag_tr2(Vs + rbase * MS + 16 * w * 2 + cb, Vs + (rbase + 4) * MS + 16 * w * 2 + cb);
#pragma unroll
        for (int dt = 0; dt < 8; ++dt) acc[dt] = MFMA16(af, lds_frag_tr2(Ks + rbase * MS + dt * 32 + cb, Ks + (rbase + 4) * MS + dt * 32 + cb), acc[dt]); }
    float* ct = CL + (size_t)u * 16384;
#pragma unroll
    for (int dt = 0; dt < 8; ++dt)
#pragma unroll
        for (int rg = 0; rg < 4; ++rg) ct[(16 * w + 4 * quad + rg) * 128 + 16 * dt + i16] = acc[dt][rg];
    __syncthreads();
    if (tid < 128) NL[(size_t)u * 128 + tid] = (npart[tid] + npart[128 + tid]) + (npart[256 + tid] + npart[384 + tid]);
}
__device__ __forceinline__ void ml_out_fast(const Frame& F, const bf16* Z, const float* cw, const float* ifg, const float* CP, const float* NP, const float* SC, const float* ng, bf16* HA, int u, const XcdBarrier& bar, int wait_inst) {
    LAS unsigned char* Qs = F.lds; LAS unsigned char* Ks = Qs + 128 * MS; LAS unsigned char* Vs = Ks + 128 * MS; LAS unsigned char* Cs = Vs + 128 * MS;
    LAS float* gv = (LAS float*)(Cs + 144 * MS); LAS float* cmx = gv + 128; LAS float* bv = cmx + 128;
    const int c = u % NCHUNK, h = (u / NCHUNK) % 4, b = u / (NCHUNK * 4), tid = F_TID, lane = tid & 63, i16 = lane & 15, quad = lane >> 4;
    const int m0 = b * SEQ + c * 128;
    float mprev = 0.f;
    __syncthreads();
#define ML_OUT_GATES() do { mprev = SC[u * 4 + 2]; if (F.wave == 0) { \
        const float f0 = log_sigmoid_(ifg[(size_t)(m0 + 2 * lane) * 8 + 4 + h]), f1 = log_sigmoid_(ifg[(size_t)(m0 + 2 * lane + 1) * 8 + 4 + h]); \
        float b0, b1; wave_scan_sum2(f0, f1, lane, b0, b1); \
        const float g0 = ifg[(size_t)(m0 + 2 * lane) * 8 + h] - b0, g1 = ifg[(size_t)(m0 + 2 * lane + 1) * 8 + h] - b1; \
        float c0, c1; wave_scan_max2(g0, g1, lane, c0, c1); \
        gv[2 * lane] = g0; gv[2 * lane + 1] = g1; cmx[2 * lane] = fmaxf(c0, mprev); cmx[2 * lane + 1] = fmaxf(c1, mprev); bv[2 * lane] = b0; bv[2 * lane + 1] = b1; } } while (0)
    if (wait_inst < 0) ML_OUT_GATES();
    { const int sg = tid >> 4, ch = tid & 15; float y[4][8];
      conv_silu8x4(Z, cw, m0 + 4 * sg, h * 128 + ch * 8, y);
#pragma unroll
      for (int r = 0; r < 4; ++r) { f32x4 a, c2; a[0] = y[r][0]; a[1] = y[r][1]; a[2] = y[r][2]; a[3] = y[r][3]; c2[0] = y[r][4]; c2[1] = y[r][5]; c2[2] = y[r][6]; c2[3] = y[r][7];
          *(LAS bf16x8*)(Qs + (4 * sg + r) * MS + ch * 16) = pack8(a, c2); }
      conv_silu8x4(Z, cw, m0 + 4 * sg, 512 + h * 128 + ch * 8, y);
#pragma unroll
      for (int r = 0; r < 4; ++r) { const float sc = 0.08838834764831845f; f32x4 a, c2; a[0] = y[r][0] * sc; a[1] = y[r][1] * sc; a[2] = y[r][2] * sc; a[3] = y[r][3] * sc; c2[0] = y[r][4] * sc; c2[1] = y[r][5] * sc; c2[2] = y[r][6] * sc; c2[3] = y[r][7] * sc;
          *(LAS bf16x8*)(Ks + (4 * sg + r) * MS + ch * 16) = pack8(a, c2); }
#pragma unroll
      for (int r = 0; r < 4; ++r) { const int s = 4 * sg + r; *(LAS v4u*)(Vs + s * MS + ch * 16) = *(const v4u*)(Z + (size_t)(m0 + s) * ZW + Z_MV + h * 128 + ch * 8); }
      if (wait_inst >= 0) { split_wait(bar, wait_inst, tid); ML_OUT_GATES(); }
#pragma unroll
      for (int r = 0; r < 4; ++r) { const int s = 4 * sg + r;
          const f32x4 p0 = *(const f32x4*)(CP + (size_t)u * 16384 + s * 128 + ch * 8), p1 = *(const f32x4*)(CP + (size_t)u * 16384 + s * 128 + ch * 8 + 4);
          *(LAS bf16x8*)(Cs + s * MS + ch * 16) = pack8(p0, p1); } }
#undef ML_OUT_GATES
    for (int it = tid; it < 16 * 16; it += 512) { const int rr = it >> 4, ch = it & 15;
        f32x4 p0 = (f32x4){0.f, 0.f, 0.f, 0.f}, p1 = p0;
        if (rr == 0) { p0 = *(const f32x4*)(NP + (size_t)u * 128 + ch * 8); p1 = *(const f32x4*)(NP + (size_t)u * 128 + ch * 8 + 4); }
        *(LAS bf16x8*)(Cs + (128 + rr) * MS + ch * 16) = pack8(p0, p1); }
    __syncthreads();
    const int w = F.wave, t = 16 * w + i16;
    bf16x8 qf[4];
#pragma unroll
    for (int ks = 0; ks < 4; ++ks) qf[ks] = lds_frag(Qs + t * MS + (32 * ks + 8 * quad) * 2);
    f32x4 acc[9];
#pragma unroll
    for (int et = 0; et < 9; ++et) { acc[et] = (f32x4){0.f, 0.f, 0.f, 0.f};
#pragma unroll
        for (int ks = 0; ks < 4; ++ks) acc[et] = MFMA16(lds_frag(Cs + (16 * et + i16) * MS + (32 * ks + 8 * quad) * 2), qf[ks], acc[et]); }
    const float cm = cmx[t], winter = __expf(mprev - cm);
    const float qn = __shfl(acc[8][0], i16);
#pragma unroll
    for (int et = 0; et < 8; ++et) acc[et] = acc[et] * winter;
    float den = winter * qn;
    f32x4 sv[8]; float dsum = 0.f;
#pragma unroll
    for (int js = 0; js < 8; ++js) { sv[js] = (f32x4){0.f, 0.f, 0.f, 0.f};
        if (js <= w) {
#pragma unroll
            for (int ks = 0; ks < 4; ++ks) sv[js] = MFMA16(lds_frag(Ks + (16 * js + i16) * MS + (32 * ks + 8 * quad) * 2), qf[ks], sv[js]);
#pragma unroll
            for (int rg = 0; rg < 4; ++rg) { const int s = 16 * js + 4 * quad + rg; const float wgt = (s <= t) ? __expf(gv[s] - cm) : 0.f; sv[js][rg] *= wgt; dsum += sv[js][rg]; } } }
    den += quad_sum(dsum);
#pragma unroll
    for (int kk = 0; kk < 4; ++kk) { if (2 * kk <= w) { const bf16x8 pf = pack8(sv[2 * kk], sv[2 * kk + 1]);
            const LAS unsigned char* vb = Vs + (32 * kk + 4 * quad + (i16 >> 2)) * MS + (4 * (i16 & 3)) * 2;
#pragma unroll
            for (int et = 0; et < 8; ++et) acc[et] = MFMA16(lds_frag_tr2(vb + et * 32, vb + 16 * MS + et * 32), pf, acc[et]); } }
    const float dn = fmaxf(fabsf(den), __expf(-bv[t] - cm)), inv = 1.f / dn;
    float ss = 0.f;
#pragma unroll
    for (int et = 0; et < 8; ++et) { acc[et] = acc[et] * inv; ss += (acc[et][0] * acc[et][0] + acc[et][1] * acc[et][1]) + (acc[et][2] * acc[et][2] + acc[et][3] * acc[et][3]); }
    const float rstd = rsqrtf(quad_sum(ss) * (1.f / 128) + EPS);
    const bf16* mo = Z + (size_t)(m0 + t) * ZW + Z_MO + h * 128; bf16* op = (bf16*)mo;
    uint2 mwv[8]; f32x4 ggv[8];
#pragma unroll
    for (int et = 0; et < 8; ++et) { const int e0 = 16 * et + 4 * quad; mwv[et] = *(const uint2*)(mo + e0); ggv[et] = *(const f32x4*)(ng + h * 128 + e0); }
#pragma unroll
    for (int et = 0; et < 8; ++et) { const int e0 = 16 * et + 4 * quad; const uint2 mw = mwv[et]; const f32x4 gg = ggv[et];
        const float o0 = acc[et][0] * rstd * gg[0] * pg8::fast_sigmoid(pg8::bflo(mw.x)), o1 = acc[et][1] * rstd * gg[1] * pg8::fast_sigmoid(pg8::bfhi(mw.x));
        const float o2 = acc[et][2] * rstd * gg[2] * pg8::fast_sigmoid(pg8::bflo(mw.y)), o3 = acc[et][3] * rstd * gg[3] * pg8::fast_sigmoid(pg8::bfhi(mw.y));
        uint2 wv; wv.x = pg8::cvt_pk_bf16(o0, o1); wv.y = pg8::cvt_pk_bf16(o2, o3); *(uint2*)(op + e0) = wv; }
}
#define MEGA_TOKEN_MIXER_PHASES \
    if (IN(PH_P2)) { \
        for (int u = c; u < 512; u += F.G) ml_local_fast(F, Z, args.in[4], (const float*)(ws + WS_IFG), (float*)(ws + WS_CL), (float*)(ws + WS_NL), (float*)(ws + WS_MSC), u); \
        split_arrive(bar, 0, F_TID);                              \
        for (int job = c; job < 256; job += F.G) cross_job(F, Z, (const bf16*)(ws + WS_KVM), args.in[12], args.in[13], job); \
        dil_phase(F, Z, args.in[8], args.in[9], (float*)(ws + WS_LSE), c); \
        split_arrive(bar, 1, F_TID);                              \
    } \
    if (IN(PH_SCAN)) { split_wait(bar, 0, F_TID); ml_scan_phase(F, (float*)(ws + WS_CL), (float*)(ws + WS_NL), (float*)(ws + WS_MSC)); \
        split_wait(bar, 1, F_TID); dil_merge_phase(F, Z, (const float*)(ws + WS_LSE)); \
        split_arrive(bar, 5, F_TID);                              } \
    if (IN(PH_MLOUT)) { int wi_ = 5; \
        for (int u = c; u < 512; u += F.G) { ml_out_fast(F, Z, args.in[4], (const float*)(ws + WS_IFG), (const float*)(ws + WS_CL), (const float*)(ws + WS_NL), (const float*)(ws + WS_MSC), args.in[7], (bf16*)(ws + WS_HA), u, bar, wi_); wi_ = -1; } \
        if (wi_ >= 0) split_wait(bar, 5, F_TID); \
        split_arrive(bar, 2, F_TID);                              \
    }
__device__ __forceinline__ void p0_prologue(const Frame& F, const Args& a) {
    const float* x = a.in[0]; const float* mem = a.in[1]; const float* ln1_g = a.in[2]; const float* w_in = a.in[3];
    const float* m_i_b = a.in[5]; const float* m_f_b = a.in[6]; const float* mem_norm_g = a.in[10]; const float* w_mem_kv = a.in[11];
    unsigned char* ws = a.ws;
    bf16* XN = (bf16*)a.out; float* IFG = (float*)(ws + WS_IFG);
    LAS float* wif = (LAS float*)(F.lds + 8 * 8448);
    for (int k = F_TID; k < 1024; k += NWAVES * 64) { const f32x4 wa = *(const f32x4*)(w_in + (size_t)k * IN_TOTAL + 2048), wb = *(const f32x4*)(w_in + (size_t)k * IN_TOTAL + 2052);
        wif[k] = wa.x; wif[1024 + k] = wa.y; wif[2048 + k] = wa.z; wif[3072 + k] = wa.w; wif[4096 + k] = wb.x; wif[5120 + k] = wb.y; wif[6144 + k] = wb.z; wif[7168 + k] = wb.w; }
    __syncthreads();
    constexpr int I0 = 16 * 64, I1 = 16 * 88, I3 = 16 * 32;
    constexpr int NITEMS = I0 + I1 + I3;
    for (int it = F.gw; it < NITEMS; it += F.NGW) {
        int r = it;
        if (r < I0) { p0_transpose_item(w_in, IN_TOTAL, 1024, (bf16*)(ws + WS_W1Z), r / 64, r % 64, F_LANE); continue; } r -= I0;
        if (r < I1) { p0_transpose_item(w_in + 2056, IN_TOTAL, 1024, (bf16*)(ws + WS_W1Z) + (size_t)2048 * 1024, r / 88, r % 88, F_LANE); continue; } r -= I1;
        p0_transpose_item(w_mem_kv, 1024, 1024, (bf16*)(ws + WS_WKV), r / 32, r % 32, F_LANE);
    }
    if (F.G != 256) cv_range(a, CV_WGU, CV_WGU + CV_LATE, F.gw, F.NGW, F_LANE);
    for (int mb = F.gw; mb < M; mb += 4 * F.NGW) {
        f32x4 vv[4][4];
#pragma unroll
        for (int q = 0; q < 4; ++q) { const int m = mb + q * F.NGW; if (m < M) row_load(x + (size_t)m * D, F_LANE, vv[q]); }
#pragma unroll
        for (int q = 0; q < 4; ++q) { const int m = mb + q * F.NGW; if (m >= M) break;
            f32x4 (&v)[4] = vv[q];
            rms_row_finish(ln1_g, XN + (size_t)m * D, F_LANE, v);
            float acc[8];
#pragma unroll
            for (int j = 0; j < 8; ++j) { float s = 0.f;
#pragma unroll
                for (int jj = 0; jj < 4; ++jj) { const f32x4 w4 = *(const LAS f32x4*)(wif + j * 1024 + 4 * F_LANE + 256 * jj); s += (v[jj].x * w4.x + v[jj].y * w4.y) + (v[jj].z * w4.z + v[jj].w * w4.w); }
                acc[j] = wave_sum(s); }
            if (F_LANE == 0) {
                f32x4 o0, o1;
                o0.x = acc[0] + m_i_b[0]; o0.y = acc[1] + m_i_b[1]; o0.z = acc[2] + m_i_b[2]; o0.w = acc[3] + m_i_b[3];
                o1.x = acc[4] + m_f_b[0]; o1.y = acc[5] + m_f_b[1]; o1.z = acc[6] + m_f_b[2]; o1.w = acc[7] + m_f_b[3];
                *(f32x4*)(IFG + (size_t)m * 8) = o0; *(f32x4*)(IFG + (size_t)m * 8 + 4) = o1;
            }
        }
    }
    for (int m = F.gw; m < MROWS; m += F.NGW) { f32x4 v[4]; rms_row_to_bf16(mem + (size_t)m * D, mem_norm_g, (bf16*)(ws + WS_MEMN) + (size_t)m * D, F_LANE, v); }
}

__device__ __forceinline__ void kv_norm_tile(const Frame& F, bf16* KVM, const float* kg, int pm, int pn) {
    VM_WAIT(); __syncthreads();
    const float g0 = kg[2 * F_LANE], g1 = kg[2 * F_LANE + 1];
    for (int it = F.wave; it < 512; it += NWAVES) {
        const int row = pm * 256 + (it >> 1), h = pn * 2 + (it & 1);
        unsigned* p = (unsigned*)(KVM + (size_t)row * 1024 + h * 128) + F_LANE;
        const unsigned w = __hip_atomic_load(p, RLX_AGENT);
        const float a = pg8::bflo(w), b = pg8::bfhi(w);
        const float rstd = rsqrtf(wave_sum(a * a + b * b) * (1.f / 128) + EPS);
        *p = pk2(a * rstd * g0, b * rstd * g1);
    }
}

__global__ void __launch_bounds__(NWAVES * 64, 2) mega_fwd(Args args) {
    extern __shared__ __attribute__((aligned(16))) unsigned char lds_raw[];
    Frame F;
    F.lds = (LAS unsigned char*)lds_raw;
    F.wave = __builtin_amdgcn_readfirstlane((int)threadIdx.x >> 6);
    F.G = gridDim.x;
    { const int bx = blockIdx.x; const int vcu = (F.G % 8 == 0) ? (bx % 8) * (F.G / 8) + bx / 8 : bx; F.gw = vcu * NWAVES + F.wave; F.NGW = F.G * NWAVES; }
    unsigned char* ws = args.ws;
    gu32* ctl = (gu32*)(ws + WS_CTL);
    volatile LAS unsigned* MISC = (volatile LAS unsigned*)(F.lds + MISC_OFF);
    for (int u = F_TID; u < (LDS_BYTES - LDSCTL_OFF) / 4; u += NWAVES * 64) ((LAS unsigned*)(F.lds + LDSCTL_OFF))[u] = 0u;
    __syncthreads();
    const int lo = args.ph_lo, hi = args.ph_hi;
    XcdBarrier bar = xcd_barrier_post((unsigned*)(ctl + CW_BAR) + args.li * XCD_BAR_WORDS, MISC + 8, F_TID);
#ifndef PHASE_MASK
#define PHASE_MASK 0xFFFF
#endif
#define IN(k) (((PHASE_MASK >> (k)) & 1) && lo <= (k) && (k) < hi)
#define SEAM(k) do { if (IN(k) && IN((k) + 1)) xcd_barrier(bar, F_TID); } while (0)
    const int c = (int)blockIdx.x;
    bf16* XN = (bf16*)args.out; bf16* GS = (bf16*)((unsigned char*)args.out + 32 * MiB);
    bf16* Z = (bf16*)(ws + WS_Z);

    if (IN(PH_P0)) { p0_prologue(F, args); }
    SEAM(PH_P0);
    if (IN(PH_P1)) {
        { pg8::Gemm g{XN, (const bf16*)(ws + WS_W1Z), 1024, 1024, nullptr}; pg8::StaticOrder S; S.init(M, ZW, F.G, c);
          pg8::EpiStoreBf16 E{Z, ZW};
          pg8::gemm_phase<pg8::EpiStoreBf16, pg8::StaticOrder, true, false>(F.lds, g, S, E, F.wave); }
        { pg8::Gemm g{(const bf16*)(ws + WS_MEMN), (const bf16*)(ws + WS_WKV), 1024, 1024, nullptr}; pg8::StaticOrder S; S.init(MROWS, 1024, F.G, (c + 64) % F.G);
          pg8::EpiStoreBf16 E{(bf16*)(ws + WS_KVM), 1024};
          pg8::gemm_phase<pg8::EpiStoreBf16, pg8::StaticOrder, true, false>(F.lds, g, S, E, F.wave);
        }
        if (F.G == 256 && c >= 208) cv_range(args, CV_WGU, CV_WGU + CV_LATE, (c - 208) * NWAVES + F.wave, 48 * NWAVES, F_LANE);
    }
    SEAM(PH_P1);
    MEGA_TOKEN_MIXER_PHASES
    if (IN(PH_MIX)) {
        bf16* MIXED = (bf16*)(ws + WS_MIXED);
        const bf16* WGATE = (const bf16*)(ws + WS_WGATE); const bf16* WA = (const bf16*)(ws + WS_WA); const bf16* WB = (const bf16*)(ws + WS_WB); const bf16* WC = (const bf16*)(ws + WS_WC); const bf16* HA = Z + Z_MO;
        pg8::StaticOrder S; S.init(M, 1024, F.G, c);
        pg8::StaticOrder Sg0; Sg0.init(M, 1024, F.G, c, 0); pg8::StaticOrder Sg1; Sg1.init(M, 1024, F.G, c, 4); pg8::StaticOrder Sg2; Sg2.init(M, 1024, F.G, c, 8);
        pg8::Unit u0;
        if (S.next(0, u0)) {
            const size_t pm = (size_t)u0.pm * 256, pn = (size_t)u0.pn * 256;
            const pg8::Chain cA{HA + pm * ZW, WA + pn * 512, ZW, 512}, cG0{XN + pm * 1024, WGATE + pn * 1024, 1024, 1024}, cB{Z + Z_DQ + pm * ZW, WB + pn * 256, ZW, 256},
                             cG2{XN + pm * 1024, WGATE + (2048 + pn) * 1024, 1024, 1024}, cC{Z + Z_XQ + pm * ZW, WC + pn * 512, ZW, 512};
            { pg8::Gemm g{XN, WGATE, 1024, 1024, nullptr}; pg8::EpiGate E{GS, args.in[18] + 1024};
              pg8::gemm_phase<pg8::EpiGate, pg8::StaticOrder, true, false, 2>(F.lds, g, Sg1, E, F.wave, cB); }
            split_wait(bar, 2, F_TID);
            { pg8::Gemm g{Z + Z_DQ, WB, ZW, 256, nullptr}; pg8::EpiMix<0> E{GS, MIXED};
              pg8::gemm_phase<pg8::EpiMix<0>, pg8::StaticOrder, true, false, 3>(F.lds, g, S, E, F.wave, cG2); }
            { pg8::Gemm g{XN, WGATE, 1024, 1024, nullptr}; pg8::EpiGate E{GS, args.in[18] + 2048};
              pg8::gemm_phase<pg8::EpiGate, pg8::StaticOrder, true, false, 3>(F.lds, g, Sg2, E, F.wave, cC); }
            { pg8::Gemm g{Z + Z_XQ, WC, ZW, 512, nullptr}; pg8::EpiMix<1> E{GS, MIXED};
              pg8::gemm_phase<pg8::EpiMix<1>, pg8::StaticOrder, true, false, 3>(F.lds, g, S, E, F.wave, cG0); }
            { pg8::Gemm g{XN, WGATE, 1024, 1024, nullptr}; pg8::EpiGate E{GS, args.in[18]};
              pg8::gemm_phase<pg8::EpiGate, pg8::StaticOrder, true, false, 3>(F.lds, g, Sg0, E, F.wave, cA); }
            { pg8::Gemm g{HA, WA, ZW, 512, nullptr}; pg8::EpiMix<2> E{GS, MIXED};
              pg8::gemm_phase<pg8::EpiMix<2>, pg8::StaticOrder, true, false, 1>(F.lds, g, S, E, F.wave); }
        }
    }
    SEAM(PH_MIX);
    if (IN(PH_WOUT)) {
        pg8::StaticOrder S; S.init(M, 1024, F.G, c);
        pg8::Gemm g{GS, (const bf16*)(ws + WS_WOUT), 1024, 1024, nullptr}; pg8::EpiRes E{args.in[0], (float*)(ws + WS_H1)};
        pg8::gemm_phase<pg8::EpiRes, pg8::StaticOrder, false, false>(F.lds, g, S, E, F.wave);
    }
    split_arrive(bar, 3, F_TID);
    MEGA_MOE_PHASES
#undef IN
#undef SEAM
}

extern "C" void kernel_launch(void* const* d_in, const int* in_sizes, int n_in, void* d_out, int out_size, void* d_ws, size_t ws_size, hipStream_t stream) {
    static int grid = 0;
    if (grid == 0) {
        if (n_in != 28 || out_size != M * D || ws_size < WS_END) { fprintf(stderr, "kernel_launch: unexpected shapes n_in %d out %d ws %zu\n", n_in, out_size, ws_size); grid = -1; return; }
        int dev = 0, cus = 0;
        if (hipGetDevice(&dev) != hipSuccess || hipDeviceGetAttribute(&cus, hipDeviceAttributeMultiprocessorCount, dev) != hipSuccess) { grid = -1; return; }
        if (hipFuncSetAttribute((const void*)mega_fwd, hipFuncAttributeMaxDynamicSharedMemorySize, LDS_BYTES) != hipSuccess) { fprintf(stderr, "kernel_launch: hipFuncSetAttribute failed\n"); grid = -1; return; }
        grid = cus;
    }
    if (grid < 0) return;
    (void)hipMemsetAsync((unsigned char*)d_ws + WS_CTL, 0, 1 * MiB, stream);
    Args a{};
    for (int i = 0; i < 28; ++i) a.in[i] = (const float*)d_in[i];
    a.out = (float*)d_out; a.ws = (unsigned char*)d_ws; a.ph_lo = 0; a.ph_hi = PH_END; a.li = 0; a.pad = 0;
    hipLaunchKernelGGL(mega_fwd, dim3(grid), dim3(NWAVES * 64), LDS_BYTES, stream, a);
}
```

```cpp
#include <hip/hip_runtime.h>
#include <cstdio>
#include <cstdint>
#include <cmath>

constexpr int D = 1024, BATCH = 4, SEQ = 4096, M = BATCH * SEQ;
constexpr int MEM_LEN = 256, MROWS = BATCH * MEM_LEN;
constexpr float EPS = 1e-6f;
constexpr int IN_TOTAL = 4872;
constexpr int ZW = 4864;
constexpr int Z_MQ = 0, Z_MK = 512, Z_MV = 1024, Z_MO = 1536, Z_DQ = 2048, Z_DK = 2816, Z_DV = 3584, Z_XQ = 4352;
constexpr int NCHUNK = SEQ / 128;
typedef unsigned short bf16;

constexpr size_t MiB = 1u << 20;
constexpr size_t WS_CTL = 0;
constexpr size_t WS_IFG = 1 * MiB;
constexpr size_t WS_LSE = 2 * MiB;
constexpr size_t WS_MSC = 3 * MiB;
constexpr size_t WS_NL = 3 * MiB + 64 * 1024;
constexpr size_t WS_WGATE = 8 * MiB;
constexpr size_t WS_WA = 14 * MiB;
constexpr size_t WS_WB = 15 * MiB;
constexpr size_t WS_WC = 16 * MiB;
constexpr size_t WS_WOUT = 17 * MiB;
constexpr size_t WS_HA = 19 * MiB;
constexpr size_t WS_Z = 35 * MiB;
constexpr size_t WS_CL = 187 * MiB;
constexpr size_t WS_W1Z = 219 * MiB;
constexpr size_t WS_WKV = 229 * MiB;
constexpr size_t WS_MEMN = 231 * MiB;
constexpr size_t WS_KVM = 251 * MiB;
constexpr size_t WS_MIXED = 187 * MiB;
constexpr size_t WS_END = 253 * MiB;

__device__ __forceinline__ unsigned f2bf(float f) { unsigned u = __float_as_uint(f); return (u + 0x7fffu + ((u >> 16) & 1u)) >> 16; }
__device__ __forceinline__ float bf2f(bf16 h) { return __uint_as_float(((unsigned)h) << 16); }
#define DPP_F(v, ctrl, rmask) __builtin_bit_cast(float, __builtin_amdgcn_update_dpp(0, __builtin_bit_cast(int, (v)), (ctrl), (rmask), 0xf, false))
__device__ __forceinline__ float wave_sum(float v) {
    v += DPP_F(v, 0xB1, 0xf); v += DPP_F(v, 0x4E, 0xf); v += DPP_F(v, 0x141, 0xf); v += DPP_F(v, 0x140, 0xf);
    v += DPP_F(v, 0x142, 0xa); v += DPP_F(v, 0x143, 0xc);
    return __builtin_bit_cast(float, __builtin_amdgcn_readlane(__builtin_bit_cast(int, v), 63));
}
#define DPP_FM(v, ctrl, rmask) __builtin_bit_cast(float, __builtin_amdgcn_update_dpp(__builtin_bit_cast(int, (v)), __builtin_bit_cast(int, (v)), (ctrl), (rmask), 0xf, false))
__device__ __forceinline__ float wave_max(float v) {
    v = fmaxf(v, DPP_FM(v, 0xB1, 0xf)); v = fmaxf(v, DPP_FM(v, 0x4E, 0xf)); v = fmaxf(v, DPP_FM(v, 0x141, 0xf)); v = fmaxf(v, DPP_FM(v, 0x140, 0xf));
    v = fmaxf(v, DPP_FM(v, 0x142, 0xa)); v = fmaxf(v, DPP_FM(v, 0x143, 0xc));
    return __builtin_bit_cast(float, __builtin_amdgcn_readlane(__builtin_bit_cast(int, v), 63));
}
__device__ __forceinline__ float sigmoidf_(float x) { return 1.f / (1.f + __expf(-x)); }
__device__ __forceinline__ float siluf_(float x) { return x / (1.f + __expf(-x)); }
__device__ __forceinline__ float log_sigmoid_(float x) { return fminf(x, 0.f) - log1pf(__expf(-fabsf(x))); }

namespace pg8 {
#define PG8_LAS __attribute__((address_space(3)))
typedef unsigned short bf16_t;
typedef short bf16x8 __attribute__((ext_vector_type(8)));
typedef float f32x4 __attribute__((ext_vector_type(4)));
typedef unsigned u32x4 __attribute__((ext_vector_type(4)));
constexpr int BM = 256, BK = 64, HALF = 128, HTB = HALF * BK * 2  , STAGE_BYTES = 8 * HTB, NXCD = 8, WGM = 8;

__host__ __device__ __forceinline__ int lds_byte(int r, int c) { const int st = (r >> 4) * 2 + (c >> 5), rr = r & 15, cc = c & 31, ob = rr * 64 + cc * 2; return st * 1024 + (ob ^ (((ob >> 9) & 1) << 5)); }
__host__ __device__ __forceinline__ void stage_rc(int b, int& R, int& C) { const int st = b / 1024, sb = b % 1024, swz = sb ^ (((sb >> 9) & 1) << 5); R = (st >> 1) * 16 + swz / 64; C = (st & 1) * 32 + (swz % 64) / 2; }
__host__ __device__ __forceinline__ int perm32(int rho) { const int n = rho >> 4, i = rho & 15; return 8 * (i >> 2) + 4 * n + (i & 3); }

struct Unit { int pm, pn, bt, aux; };
struct Gemm { const bf16_t* A; const bf16_t* Bt; int lda, K; const int* rowidx; };

struct StaticOrder {
    int nM, nN, nwg, G, c, btoff;
    __host__ __device__ __forceinline__ void init(int M, int N, int G_, int c_, int btoff_ = 0) { nM = M / BM; nN = N / BM; nwg = nM * nN; G = G_; c = c_; btoff = btoff_; }
    __host__ __device__ __forceinline__ bool next(int i, Unit& u) const {
        const long L = (long)i * G + c; if (L >= nwg) return false;
        int wgid = (int)L; { const int q = nwg / NXCD, r = nwg % NXCD, xcd = wgid % NXCD, off = wgid / NXCD; wgid = (xcd < r ? xcd * (q + 1) : r * (q + 1) + (xcd - r) * q) + off; }
        const int nig = WGM * nN, gid = wgid / nig, fm = gid * WGM, gsz = (nM - fm) < WGM ? (nM - fm) : WGM;
        u.pm = fm + ((wgid % nig) % gsz); u.pn = (wgid % nig) / gsz; u.bt = u.pn + btoff; u.aux = 0; return true;
    }
};

typedef __bf16 bf16x2_t __attribute__((ext_vector_type(2)));
typedef float f32x2_t __attribute__((ext_vector_type(2)));
__device__ __forceinline__ unsigned cvt_pk_bf16(float lo, float hi) { const f32x2_t v = {lo, hi}; const bf16x2_t r = __builtin_convertvector(v, bf16x2_t); return __builtin_bit_cast(unsigned, r); }


struct Chain { const bf16_t* A; const bf16_t* Bt; int lda, K; };
template <class Epi, class Sched, bool ALIGN_EPI, bool GATHER, int CH = 0>
__device__ __forceinline__ void gemm_phase(PG8_LAS unsigned char* lds, const Gemm g, const Sched& S, const Epi& E, int wave_id, const Chain nx = Chain{nullptr, nullptr, 0, 0}) {
    int tid_; { int l; asm volatile("v_mbcnt_lo_u32_b32 %0, -1, 0\n\tv_mbcnt_hi_u32_b32 %0, -1, %0" : "=v"(l)); tid_ = wave_id * 64 + l; }
    const int tid = tid_, wid = wave_id, lane = tid & 63, wr = wid >> 2, wc = wid & 3, fr = lane & 15, fq = lane >> 4;
    const int K = g.K, nt = K / BK, lda = g.lda;
    unsigned voffA[2], voffB[2]; int RA[2], CA[2];
#pragma unroll
    for (int i = 0; i < 2; ++i) { int R, C; stage_rc(tid * 16 + i * 8192, R, C); const int Rb = Epi::PERM ? ((R & ~31) + perm32(R & 31)) : R;
        RA[i] = R; CA[i] = C; voffA[i] = (unsigned)(R * lda + C) * 2u; voffB[i] = (unsigned)(Rb * K + C) * 2u; }
    unsigned voffA_n[2], voffB_n[2]; size_t hstepA_n = 0, hstepB_n = 0;
    if constexpr ((CH & 2) != 0) {
#pragma unroll
        for (int i = 0; i < 2; ++i) { const int Rb = (RA[i] & ~31) + perm32(RA[i] & 31); voffA_n[i] = (unsigned)(RA[i] * nx.lda + CA[i]) * 2u; voffB_n[i] = (unsigned)(Rb * nx.K + CA[i]) * 2u; }
        hstepA_n = (size_t)HALF * nx.lda * 2; hstepB_n = (size_t)HALF * nx.K * 2;
    }
    const size_t kstep = (size_t)(BK * 2);
    const size_t hstepA = (size_t)HALF * lda * 2, tstepA = 2 * hstepA;
    const size_t hstepB = (size_t)HALF * K * 2, tstepB = 2 * hstepB;
    const unsigned ldsw = (unsigned)wid * 1024u;
    const int aoff = lds_byte(wr * 64 + fr, fq * 8), boff = lds_byte(wc * 32 + fr, fq * 8);
#define PG8_SA(b, h) (((b) * 2 + (h)) * HTB)
#define PG8_SB(b, h) ((4 + (b) * 2 + (h)) * HTB)
#define PG8_STAGE(bufoff, gbase, voff) do { _Pragma("unroll") for (int _i = 0; _i < 2; ++_i) \
        __builtin_amdgcn_global_load_lds((const unsigned*)((const char*)(gbase) + (voff)[_i]), (PG8_LAS unsigned*)(lds + (bufoff) + ldsw + _i * 8192), 16, 0, 0); } while (0)
#define PG8_LDA(dst, b, h) do { _Pragma("unroll") for (int m = 0; m < 4; ++m) _Pragma("unroll") for (int k = 0; k < 2; ++k) dst[m][k] = *(const PG8_LAS bf16x8*)(lds + PG8_SA(b, h) + aoff + m * 2048 + k * 1024); } while (0)
#define PG8_LDB(dst, b, h) do { _Pragma("unroll") for (int n = 0; n < 2; ++n) _Pragma("unroll") for (int k = 0; k < 2; ++k) dst[n][k] = *(const PG8_LAS bf16x8*)(lds + PG8_SB(b, h) + boff + n * 2048 + k * 1024); } while (0)
#define PG8_MMA(ai, bj, At, Bt) do { __builtin_amdgcn_s_setprio(1); _Pragma("unroll") for (int m = 0; m < 4; ++m) _Pragma("unroll") for (int n = 0; n < 2; ++n) _Pragma("unroll") for (int k = 0; k < 2; ++k) \
        acc[ai][bj][m][n] = __builtin_amdgcn_mfma_f32_16x16x32_bf16(Bt[n][k], At[m][k], acc[ai][bj][m][n], 0, 0, 0); __builtin_amdgcn_s_setprio(0); } while (0)
#define PG8_WAIT_V(n) asm volatile("s_waitcnt vmcnt(" #n ")" ::: "memory")
#define PG8_WAIT_L(n) asm volatile("s_waitcnt lgkmcnt(" #n ")" ::: "memory")
#define PG8_BAR __builtin_amdgcn_s_barrier()
#define PG8_SCHED __builtin_amdgcn_sched_barrier(0)
    Unit cur, nxt; int ui = 0;
    if (!S.next(0, cur)) return;
    f32x4 acc[2][2][4][2];
#pragma unroll
    for (int a = 0; a < 2; ++a)
#pragma unroll
        for (int b = 0; b < 2; ++b)
#pragma unroll
            for (int m = 0; m < 4; ++m)
#pragma unroll
                for (int n = 0; n < 2; ++n) acc[a][b][m][n] = (f32x4){0.f, 0.f, 0.f, 0.f};
    bf16x8 At[4][2], B0[2][2], B1[2][2];
    unsigned gAc[2][2], gAn[2][2];
    if constexpr (GATHER) {
#pragma unroll
        for (int h = 0; h < 2; ++h)
#pragma unroll
            for (int i = 0; i < 2; ++i) { unsigned _r = (unsigned)g.rowidx[cur.pm * BM + h * HALF + RA[i]]; _r = _r < 16384u ? _r : 0u; gAc[h][i] = (_r * (unsigned)lda + (unsigned)CA[i]) * 2u; }
    }
    const char* cA = GATHER ? (const char*)g.A : (const char*)g.A + (size_t)cur.pm * tstepA; const char* cB = (const char*)g.Bt + (size_t)cur.bt * tstepB;
#define PG8_STAGE_A(bufoff, p, h, useN) do { if constexpr (GATHER) { unsigned _v[2]; _v[0] = (useN) ? gAn[h][0] : gAc[h][0]; _v[1] = (useN) ? gAn[h][1] : gAc[h][1]; PG8_STAGE(bufoff, p, _v); } \
        else if constexpr ((CH & 2) != 0) { unsigned _v[2]; _v[0] = ((useN) && chain_now) ? voffA_n[0] : voffA[0]; _v[1] = ((useN) && chain_now) ? voffA_n[1] : voffA[1]; \
            PG8_STAGE(bufoff, (p) + (h) * (((useN) && chain_now) ? hstepA_n : hstepA), _v); } \
        else { PG8_STAGE(bufoff, (p) + (h) * hstepA, voffA); } } while (0)
#define PG8_STAGE_B(bufoff, p, h, useN) do { if constexpr ((CH & 2) != 0) { unsigned _v[2]; _v[0] = ((useN) && chain_now) ? voffB_n[0] : voffB[0]; _v[1] = ((useN) && chain_now) ? voffB_n[1] : voffB[1]; \
            PG8_STAGE(bufoff, (p) + (h) * (((useN) && chain_now) ? hstepB_n : hstepB), _v); } \
        else { PG8_STAGE(bufoff, (p) + (h) * hstepB, voffB); } } while (0)
    bool chain_now = false;
    if constexpr ((CH & 1) == 0) {
    PG8_STAGE(PG8_SB(0, 0), cB, voffB); PG8_STAGE(PG8_SB(0, 1), cB + hstepB, voffB); PG8_STAGE_A(PG8_SA(0, 0), cA, 0, false); PG8_STAGE_A(PG8_SA(0, 1), cA, 1, false);
    if (wr == 1) PG8_BAR;
    PG8_WAIT_V(2); PG8_BAR;
    PG8_STAGE(PG8_SB(1, 0), cB + kstep, voffB); PG8_STAGE_A(PG8_SA(1, 0), cA + kstep, 0, false); PG8_STAGE(PG8_SB(1, 1), cB + hstepB + kstep, voffB);
    PG8_WAIT_V(6); PG8_BAR;
    }
    for (;;) {
        const bool has_next = S.next(ui + 1, nxt);
        const char* nA = GATHER ? (const char*)g.A : (has_next ? (const char*)g.A + (size_t)nxt.pm * tstepA : (((CH & 2) != 0) ? (const char*)nx.A : cA)); const char* nB = has_next ? (const char*)g.Bt + (size_t)nxt.bt * tstepB : (((CH & 2) != 0) ? (const char*)nx.Bt : cB);
        if constexpr ((CH & 2) != 0) chain_now = !has_next;
        if constexpr (GATHER) {
#pragma unroll
            for (int h = 0; h < 2; ++h)
#pragma unroll
                for (int i = 0; i < 2; ++i) { unsigned _r = has_next ? (unsigned)g.rowidx[nxt.pm * BM + h * HALF + RA[i]] : 0u; _r = _r < 16384u ? _r : 0u; gAn[h][i] = has_next ? (_r * (unsigned)lda + (unsigned)CA[i]) * 2u : gAc[h][i]; }
        }
        for (int t = 0; t < nt; t += 2) {
            const bool last = (t == nt - 2);
            const char* a1 = cA + (size_t)(t + 1) * kstep;
            const char* a2 = last ? nA : cA + (size_t)(t + 2) * kstep; const char* b2 = last ? nB : cB + (size_t)(t + 2) * kstep;
            const char* a3 = a2 + kstep; const char* b3 = b2 + kstep;
            PG8_LDB(B0, 0, 0); PG8_LDB(B1, 0, 1); PG8_SCHED; PG8_LDA(At, 0, 0); PG8_STAGE_A(PG8_SA(1, 1), a1, 1, false);
            PG8_WAIT_V(8); PG8_WAIT_L(0); PG8_BAR; PG8_MMA(0, 0, At, B0); PG8_MMA(0, 1, At, B1); PG8_BAR; PG8_SCHED;
            PG8_LDA(At, 0, 1); PG8_STAGE_B(PG8_SB(0, 0), b2, 0, last); PG8_STAGE_B(PG8_SB(0, 1), b2, 1, last); PG8_STAGE_A(PG8_SA(0, 0), a2, 0, last);
            PG8_WAIT_V(8); PG8_WAIT_L(0); PG8_BAR; PG8_MMA(1, 0, At, B0); PG8_MMA(1, 1, At, B1); PG8_BAR; PG8_SCHED;
            PG8_LDB(B0, 1, 0); PG8_LDB(B1, 1, 1); PG8_SCHED; PG8_LDA(At, 1, 0); PG8_STAGE_A(PG8_SA(0, 1), a2, 1, last);
            PG8_WAIT_V(8); PG8_WAIT_L(0); PG8_BAR; PG8_MMA(0, 0, At, B0); PG8_MMA(0, 1, At, B1); PG8_BAR; PG8_SCHED;
            PG8_LDA(At, 1, 1); PG8_STAGE_B(PG8_SB(1, 0), b3, 0, last); PG8_STAGE_B(PG8_SB(1, 1), b3, 1, last); PG8_STAGE_A(PG8_SA(1, 0), a3, 0, last);
            PG8_WAIT_V(8); PG8_WAIT_L(0); PG8_BAR; PG8_MMA(1, 0, At, B0); PG8_MMA(1, 1, At, B1); PG8_BAR; PG8_SCHED;
        }
        if constexpr (ALIGN_EPI) { if (wr == 0) PG8_BAR; }
        E(acc, cur, wr, wc, fr, fq);
        if (!has_next) { if constexpr ((CH & 2) != 0) { if constexpr (ALIGN_EPI) { if (wr == 1) PG8_BAR; } return; } break; }
#pragma unroll
        for (int a = 0; a < 2; ++a)
#pragma unroll
            for (int b = 0; b < 2; ++b)
#pragma unroll
                for (int m = 0; m < 4; ++m)
#pragma unroll
                    for (int n = 0; n < 2; ++n) acc[a][b][m][n] = (f32x4){0.f, 0.f, 0.f, 0.f};
        cur = nxt; cA = nA; cB = nB; ++ui;
        if constexpr (GATHER) {
#pragma unroll
            for (int h = 0; h < 2; ++h)
#pragma unroll
                for (int i = 0; i < 2; ++i) gAc[h][i] = gAn[h][i];
        }
        if constexpr (ALIGN_EPI) { if (wr == 1) PG8_BAR; }
    }
    PG8_WAIT_V(0);
    if constexpr (!ALIGN_EPI) { if (wr == 0) PG8_BAR; }
    PG8_BAR;
#undef PG8_SA
#undef PG8_SB
#undef PG8_STAGE
#undef PG8_STAGE_A
#undef PG8_STAGE_B
#undef PG8_LDA
#undef PG8_LDB
#undef PG8_MMA
#undef PG8_WAIT_V
#undef PG8_WAIT_L
#undef PG8_BAR
#undef PG8_SCHED
}
}
namespace pg8 {
struct EpiStoreBf16 {
    static constexpr bool PERM = true;
    bf16_t* O; int ldc;
    __device__ __forceinline__ void operator()(const f32x4 (&acc)[2][2][4][2], const Unit& u, int wr, int wc, int fr, int fq) const {
        const int row0 = u.pm * BM + wr * 64 + fr, col0 = u.pn * BM + wc * 32 + 8 * fq;
#pragma unroll
        for (int ai = 0; ai < 2; ++ai)
#pragma unroll
            for (int m = 0; m < 4; ++m) { bf16_t* rowp = O + (size_t)(row0 + ai * HALF + m * 16) * ldc + col0;
#pragma unroll
                for (int bj = 0; bj < 2; ++bj) { const f32x4 v0 = acc[ai][bj][m][0], v1 = acc[ai][bj][m][1];
                    u32x4 w; w.x = cvt_pk_bf16(v0[0], v0[1]); w.y = cvt_pk_bf16(v0[2], v0[3]); w.z = cvt_pk_bf16(v1[0], v1[1]); w.w = cvt_pk_bf16(v1[2], v1[3]);
                    *(u32x4*)(rowp + bj * HALF) = w; } }
    }
};
__device__ __forceinline__ float fast_sigmoid(float x) { return __builtin_amdgcn_rcpf(1.f + __builtin_amdgcn_exp2f(-1.4426950408889634f * x)); }
struct EpiGate {
    static constexpr bool PERM = true;
    bf16_t* O; const float* bias;
    __device__ __forceinline__ void operator()(const f32x4 (&acc)[2][2][4][2], const Unit& u, int wr, int wc, int fr, int fq) const {
        const int row0 = u.pm * BM + wr * 64 + fr, col0 = u.pn * BM + wc * 32 + 8 * fq;
        f32x4 bv[2][2];
#pragma unroll
        for (int bj = 0; bj < 2; ++bj)
#pragma unroll
            for (int n = 0; n < 2; ++n) bv[bj][n] = *(const f32x4*)(bias + col0 + bj * HALF + 4 * n);
#pragma unroll
        for (int ai = 0; ai < 2; ++ai)
#pragma unroll
            for (int m = 0; m < 4; ++m) { bf16_t* rowp = O + (size_t)(row0 + ai * HALF + m * 16) * 1024 + col0;
#pragma unroll
                for (int bj = 0; bj < 2; ++bj) { f32x4 v0 = acc[ai][bj][m][0] + bv[bj][0], v1 = acc[ai][bj][m][1] + bv[bj][1];
#pragma unroll
                    for (int j = 0; j < 4; ++j) { v0[j] = fast_sigmoid(v0[j]); v1[j] = fast_sigmoid(v1[j]); }
                    u32x4 w; w.x = cvt_pk_bf16(v0[0], v0[1]); w.y = cvt_pk_bf16(v0[2], v0[3]); w.z = cvt_pk_bf16(v1[0], v1[1]); w.w = cvt_pk_bf16(v1[2], v1[3]);
                    *(u32x4*)(rowp + bj * HALF) = w; } }
    }
};
__device__ __forceinline__ float bflo(unsigned w) { return __uint_as_float(w << 16); }
__device__ __forceinline__ float bfhi(unsigned w) { return __uint_as_float(w & 0xffff0000u); }
template <int MODE>
struct EpiMix {
    static constexpr bool PERM = true;
    bf16_t* GS; bf16_t* MIXED;
    __device__ __forceinline__ void operator()(const f32x4 (&acc)[2][2][4][2], const Unit& u, int wr, int wc, int fr, int fq) const {
        const int row0 = u.pm * BM + wr * 64 + fr, col0 = u.pn * BM + wc * 32 + 8 * fq;
#pragma unroll
        for (int ai = 0; ai < 2; ++ai) {
            u32x4 gw[4][2], pw[4][2];
#pragma unroll
            for (int m = 0; m < 4; ++m)
#pragma unroll
                for (int bj = 0; bj < 2; ++bj) { const size_t o = (size_t)(row0 + ai * HALF + m * 16) * 1024 + col0 + bj * HALF;
                    gw[m][bj] = *(const u32x4*)(GS + o); if (MODE != 0) pw[m][bj] = *(const u32x4*)(MIXED + o); }
#pragma unroll
            for (int m = 0; m < 4; ++m)
#pragma unroll
                for (int bj = 0; bj < 2; ++bj) { const size_t o = (size_t)(row0 + ai * HALF + m * 16) * 1024 + col0 + bj * HALF; const u32x4 g = gw[m][bj];
                    f32x4 t0, t1;
                    t0[0] = bflo(g.x) * acc[ai][bj][m][0][0]; t0[1] = bfhi(g.x) * acc[ai][bj][m][0][1]; t0[2] = bflo(g.y) * acc[ai][bj][m][0][2]; t0[3] = bfhi(g.y) * acc[ai][bj][m][0][3];
                    t1[0] = bflo(g.z) * acc[ai][bj][m][1][0]; t1[1] = bfhi(g.z) * acc[ai][bj][m][1][1]; t1[2] = bflo(g.w) * acc[ai][bj][m][1][2]; t1[3] = bfhi(g.w) * acc[ai][bj][m][1][3];
                    if (MODE != 0) { const u32x4 p = pw[m][bj];
                        t0[0] += bflo(p.x); t0[1] += bfhi(p.x); t0[2] += bflo(p.y); t0[3] += bfhi(p.y); t1[0] += bflo(p.z); t1[1] += bfhi(p.z); t1[2] += bflo(p.w); t1[3] += bfhi(p.w); }
                    u32x4 w; w.x = cvt_pk_bf16(t0[0], t0[1]); w.y = cvt_pk_bf16(t0[2], t0[3]); w.z = cvt_pk_bf16(t1[0], t1[1]); w.w = cvt_pk_bf16(t1[2], t1[3]);
                    if (MODE != 2) *(u32x4*)(MIXED + o) = w; else *(u32x4*)(GS + o) = w; }
            asm volatile("" ::: "memory");
        }
    }
};
struct EpiRes {
    static constexpr bool PERM = false;
    const float* x; float* out;
    __device__ __forceinline__ void operator()(const f32x4 (&acc)[2][2][4][2], const Unit& u, int wr, int wc, int fr, int fq) const {
        const int row0 = u.pm * BM + wr * 64 + fr, col0 = u.pn * BM + wc * 32 + 4 * fq;
#pragma unroll
        for (int ai = 0; ai < 2; ++ai)
#pragma unroll
            for (int mp = 0; mp < 2; ++mp) {
                f32x4 xv[2][2][2];
#pragma unroll
                for (int mm = 0; mm < 2; ++mm)
#pragma unroll
                    for (int bj = 0; bj < 2; ++bj)
#pragma unroll
                        for (int n = 0; n < 2; ++n) xv[mm][bj][n] = *(const f32x4*)(x + (size_t)(row0 + ai * HALF + (2 * mp + mm) * 16) * 1024 + col0 + bj * HALF + n * 16);
#pragma unroll
                for (int mm = 0; mm < 2; ++mm)
#pragma unroll
                    for (int bj = 0; bj < 2; ++bj)
#pragma unroll
                        for (int n = 0; n < 2; ++n) *(f32x4*)(out + (size_t)(row0 + ai * HALF + (2 * mp + mm) * 16) * 1024 + col0 + bj * HALF + n * 16) = xv[mm][bj][n] + acc[ai][bj][2 * mp + mm][n];
                asm volatile("" ::: "memory");
            }
    }
};
}
constexpr int NWAVES = 8;
constexpr int SCR_BYTES = 146432;
constexpr int LDSCTL_OFF = SCR_BYTES, MISC_OFF = LDSCTL_OFF + 320;
constexpr int LDS_BYTES = 147456;
#define GAS __attribute__((address_space(1)))
#define LAS __attribute__((address_space(3)))
typedef unsigned v4u __attribute__((ext_vector_type(4)));
typedef float f32x4 __attribute__((ext_vector_type(4)));
typedef short bf16x8 __attribute__((ext_vector_type(8)));
typedef short s16x4 __attribute__((ext_vector_type(4)));
typedef GAS unsigned gu32;
#define RLX_AGENT __ATOMIC_RELAXED, __HIP_MEMORY_SCOPE_AGENT
#define LDS_WAIT() asm volatile("s_waitcnt lgkmcnt(0)" ::: "memory")
#define VM_WAIT() asm volatile("s_waitcnt vmcnt(0)" ::: "memory")
__device__ __forceinline__ int lane_id() { int l; asm volatile("v_mbcnt_lo_u32_b32 %0, -1, 0\n\tv_mbcnt_hi_u32_b32 %0, -1, %0" : "=v"(l)); return l; }
__device__ __forceinline__ unsigned pk2(float lo, float hi) { return pg8::cvt_pk_bf16(lo, hi); }

constexpr int CW_BAR = 4096;
constexpr int CW_ECNT = 32768;

#define XB_TMO      128
#define XB_XCNT(j)  (256  + 64 * (j))
#define XB_XSUB(j)  (1280 + 64 * (j))
#define XB_XGEN(j)  (2304 + 64 * (j))
#define XB_TOP      3328
#define XB_TOPGEN   3392
#define XCD_BAR_WORDS 3456
#define XB_SPIN_CAP (1u << 18)
__device__ __forceinline__ unsigned xb_ld(unsigned* p)              { return __hip_atomic_load(p, __ATOMIC_RELAXED, __HIP_MEMORY_SCOPE_AGENT); }
__device__ __forceinline__ unsigned xb_add(unsigned* p, unsigned v) { return __hip_atomic_fetch_add(p, v, __ATOMIC_RELAXED, __HIP_MEMORY_SCOPE_AGENT); }
__device__ __forceinline__ unsigned xb_xcc_id() { return (unsigned)__builtin_amdgcn_s_getreg((3 << 11) | 20) & 0xFu; }
#define XB_SPIN(cond, bar) do { unsigned _sp = 0; while (cond) { __builtin_amdgcn_s_sleep(1); \
    if ((++_sp & 255u) == 0u) { if (xb_ld(&(bar)[XB_TMO])) break; if (_sp > XB_SPIN_CAP) { atomicAdd(&(bar)[XB_TMO], 1u); break; } } } } while (0)
struct XcdBarrier { unsigned* bar; unsigned x; volatile LAS unsigned* st; };
__device__ __forceinline__ XcdBarrier xcd_barrier_post(unsigned* bar, volatile LAS unsigned* st, int tid) {
    XcdBarrier b; b.bar = bar; b.x = xb_xcc_id(); b.st = st;
    if (tid == 0) (void)xb_add(&bar[XB_XCNT(b.x)], 1u);
    return b;
}
__device__ __forceinline__ void xcd_barrier_complete(unsigned* bar, unsigned x, unsigned& nloc, unsigned& nx) {
    const unsigned G = gridDim.x * gridDim.y * gridDim.z;
    unsigned sum, cnt, mine, sp = 0u;
    for (;;) {
        sum = 0u; cnt = 0u; mine = 0u;
#pragma unroll
        for (unsigned j = 0; j < 16; ++j) { const unsigned c = xb_ld(&bar[XB_XCNT(j)]); sum += c; cnt += (c > 0u) ? 1u : 0u; mine = (j == x) ? c : mine; }
        if (sum == G) break;
        __builtin_amdgcn_s_sleep(1);
        if ((++sp & 255u) == 0u) { if (xb_ld(&bar[XB_TMO])) break; if (sp > XB_SPIN_CAP) { atomicAdd(&bar[XB_TMO], 1u); break; } }
    }
    nloc = mine > 0u ? mine : 1u; nx = cnt > 0u ? cnt : 1u;
}
__device__ __forceinline__ void xcd_barrier(const XcdBarrier& b, int tid) {
    asm volatile("s_waitcnt vmcnt(0)" ::: "memory");
    __syncthreads();
    if (tid == 0) {
        unsigned* bar = b.bar;
        __builtin_amdgcn_s_waitcnt(0);
        unsigned nloc = b.st[0], nx = b.st[1];
        if (nloc == 0u) { xcd_barrier_complete(bar, b.x, nloc, nx); b.st[0] = nloc; b.st[1] = nx; }
        const unsigned old = xb_add(&bar[XB_XSUB(b.x)], 1u);
        const unsigned gen = old / nloc;
        if (old + 1u == (gen + 1u) * nloc) {
            __builtin_amdgcn_fence(__ATOMIC_RELEASE, "agent");
            asm volatile("s_waitcnt vmcnt(0)" ::: "memory");
            const unsigned og = xb_add(&bar[XB_TOP], 1u);
            const unsigned tg = og / nx;
            if (og + 1u == (tg + 1u) * nx) xb_add(&bar[XB_TOPGEN], 1u);
            else XB_SPIN(xb_ld(&bar[XB_TOPGEN]) == tg, bar);
            __builtin_amdgcn_fence(__ATOMIC_ACQUIRE, "agent");
            xb_add(&bar[XB_XGEN(b.x)], 1u);
            asm volatile("s_waitcnt vmcnt(0)" ::: "memory");
        } else {
            XB_SPIN(xb_ld(&bar[XB_XGEN(b.x)]) == gen, bar);
            __builtin_amdgcn_fence(__ATOMIC_ACQUIRE, "agent");
            asm volatile("s_waitcnt vmcnt(0)" ::: "memory");
        }
    }
    __syncthreads();
}

constexpr int CW_SPLIT_REL = 65536 - CW_BAR;
__device__ __forceinline__ void split_arrive(const XcdBarrier& b, int inst, int tid) {
    asm volatile("s_waitcnt vmcnt(0)" ::: "memory");
    __syncthreads();
    if (tid == 0) {
        unsigned* w = b.bar + CW_SPLIT_REL + inst * 2048;
        const unsigned nloc = b.st[0];
        const unsigned old = xb_add(&w[64 * b.x], 1u);
        if (old + 1u == nloc) { __builtin_amdgcn_fence(__ATOMIC_RELEASE, "agent"); asm volatile("s_waitcnt vmcnt(0)" ::: "memory"); (void)xb_add(&w[1024], 1u); }
    }
}
__device__ __forceinline__ void split_wait(const XcdBarrier& b, int inst, int tid) {
    if (tid == 0) {
        unsigned* w = b.bar + CW_SPLIT_REL + inst * 2048;
        const unsigned nx = b.st[1];
        XB_SPIN(xb_ld(&w[1024]) < nx, b.bar);
        __builtin_amdgcn_fence(__ATOMIC_ACQUIRE, "agent");
        asm volatile("s_waitcnt vmcnt(0)" ::: "memory");
    }
    __syncthreads();
}

struct Args { const float* in[28]; float* out; unsigned char* ws; int ph_lo, ph_hi, li, pad; };

struct Frame {
    LAS unsigned char* lds;
    int wave, G, gw, NGW;
#define F_LANE (lane_id())
#define F_TID (F.wave * 64 + lane_id())
};

__device__ __forceinline__ void tr_load(const float* W, int ldw, int kb, int nb, int lane, f32x4 (&v)[8]) {
    const float* src = W + (size_t)(64 * kb + 8 * (lane >> 3)) * ldw + 32 * nb + 4 * (lane & 7);
#pragma unroll
    for (int j = 0; j < 8; ++j) v[j] = *(const f32x4*)(src + (size_t)j * ldw);
}
__device__ __forceinline__ void tr_store(bf16* WT, int K, int kb, int nb, int lane, const f32x4 (&v)[8]) {
    bf16* dst = WT + (size_t)(32 * nb + 4 * (lane & 7)) * K + 64 * kb + 8 * (lane >> 3);
#pragma unroll
    for (int i = 0; i < 4; ++i) { v4u o; o.x = pk2(v[0][i], v[1][i]); o.y = pk2(v[2][i], v[3][i]); o.z = pk2(v[4][i], v[5][i]); o.w = pk2(v[6][i], v[7][i]);
        *(GAS v4u*)(dst + (size_t)i * K) = o; }
}
__device__ __forceinline__ void p0_transpose_item(const float* W, int ldw, int K, bf16* WT, int kb, int nb, int lane) { f32x4 v[8]; tr_load(W, ldw, kb, nb, lane, v); tr_store(WT, K, kb, nb, lane, v); }
__device__ __forceinline__ void row_load(const float* xrow, int lane, f32x4 (&v)[4]) {
    const GAS f32x4* xr = (const GAS f32x4*)xrow + lane;
#pragma unroll
    for (int j = 0; j < 4; ++j) v[j] = xr[64 * j];
}
__device__ __forceinline__ void gain_load(const float* g, int lane, f32x4 (&gg)[4]) {
    const GAS f32x4* gr = (const GAS f32x4*)g + lane;
#pragma unroll
    for (int j = 0; j < 4; ++j) gg[j] = gr[64 * j];
}
__device__ __forceinline__ void rms_row_finish(const f32x4 (&gg)[4], bf16* orow, int lane, f32x4 (&v)[4]) {
    float s = 0.f;
#pragma unroll
    for (int j = 0; j < 4; ++j) s += (v[j].x * v[j].x + v[j].y * v[j].y) + (v[j].z * v[j].z + v[j].w * v[j].w);
    const float rstd = rsqrtf(wave_sum(s) * (1.f / D) + EPS);
    GAS unsigned long long* o8 = (GAS unsigned long long*)orow + lane;
#pragma unroll
    for (int j = 0; j < 4; ++j) { v[j] = v[j] * rstd * gg[j];
        o8[64 * j] = (unsigned long long)pk2(v[j].x, v[j].y) | ((unsigned long long)pk2(v[j].z, v[j].w) << 32); }
}

constexpr int PH_P0 = 0, PH_P1 = 1, PH_P2 = 2, PH_SCAN = 3, PH_MLOUT = 4, PH_MIX = 5, PH_WOUT = 6, PH_ROUTE = 7, PH_G1 = 8, PH_G2S = 9, PH_G2P = 10, PH_END = 11;
constexpr size_t WS_G8 = 219 * MiB;
constexpr size_t WS_H1 = 35 * MiB;
constexpr size_t WS_HN = 99 * MiB;
constexpr size_t WS_WGU = 219 * MiB;
constexpr size_t WS_WD = 19 * MiB;
constexpr size_t WS_HH = 187 * MiB;
constexpr size_t WS_Y1 = 139 * MiB;


constexpr int CV_WGU = 32 * 256, CV_LATE = 1536 + 256 + 128 + 256 + 512, CV_ITEMS = CV_WGU + CV_LATE + 32 * 128;
__device__ __forceinline__ void cv_item(const Args& a, int it, const float*& W, int& ldw, int& K, bf16*& WT, int& kb, int& nb) {
    unsigned char* ws = a.ws;
    if (it < CV_WGU) { const int e = it >> 8, q = it & 255, sub = q >> 6, r = q & 63;
        W = ((sub & 1) ? a.in[26] : a.in[25]) + (size_t)e * 1024 * 256 + (sub >> 1) * 128; ldw = 256; K = 1024; WT = (bf16*)(ws + WS_WGU) + ((size_t)e * 512 + sub * 128) * 1024; kb = r >> 2; nb = r & 3; return; }
    int r = it - CV_WGU;
    if (r < 1536) { W = a.in[17]; ldw = 3072; K = 1024; WT = (bf16*)(ws + WS_WGATE); kb = r / 96; nb = r % 96; return; } r -= 1536;
    if (r < 256) { W = a.in[14]; ldw = 1024; K = 512; WT = (bf16*)(ws + WS_WA); kb = r >> 5; nb = r & 31; return; } r -= 256;
    if (r < 128) { W = a.in[15]; ldw = 1024; K = 256; WT = (bf16*)(ws + WS_WB); kb = r >> 5; nb = r & 31; return; } r -= 128;
    if (r < 256) { W = a.in[16]; ldw = 1024; K = 512; WT = (bf16*)(ws + WS_WC); kb = r >> 5; nb = r & 31; return; } r -= 256;
    if (r < 512) { W = a.in[19]; ldw = 1024; K = 1024; WT = (bf16*)(ws + WS_WOUT); kb = r >> 5; nb = r & 31; return; } r -= 512;
    { const int e = r >> 7, q = r & 127; W = a.in[27] + (size_t)e * 256 * 1024; ldw = 1024; K = 256; WT = (bf16*)(ws + WS_WD) + (size_t)e * 1024 * 256; kb = q >> 5; nb = q & 31; }
}
__device__ __forceinline__ void bg_load(const Args& a, int it, int lane, f32x4 (&v)[8]) { const float* W; int ldw, K, kb, nb; bf16* WT; cv_item(a, it, W, ldw, K, WT, kb, nb); tr_load(W, ldw, kb, nb, lane, v); }
__device__ __forceinline__ void bg_store(const Args& a, int it, int lane, const f32x4 (&v)[8]) { const float* W; int ldw, K, kb, nb; bf16* WT; cv_item(a, it, W, ldw, K, WT, kb, nb); tr_store(WT, K, kb, nb, lane, v); }
__device__ __forceinline__ void cv_range(const Args& a, int lo, int hi, int wi, int nw, int lane) {
    for (int it = lo + wi; it < hi; it += 3 * nw) { f32x4 v0[8], v1[8], v2[8]; const int it1 = it + nw, it2 = it + 2 * nw; const bool h1 = it1 < hi, h2 = it2 < hi;
        bg_load(a, it, lane, v0); bg_load(a, h1 ? it1 : it, lane, v1); bg_load(a, h2 ? it2 : it, lane, v2);
        bg_store(a, it, lane, v0); if (h1) bg_store(a, it1, lane, v1); if (h2) bg_store(a, it2, lane, v2); }
}
constexpr size_t WS_ENT = 131 * MiB;
constexpr size_t WS_ENTW = 135 * MiB;
constexpr int TOFF_LDS = 136192;

namespace pg8 {
template <int i0, int i1, int npn_shift, int gather>
struct MoeOrder {
    const PG8_LAS int* toff; int G, c, tbeg, tend, c2;
    __device__ __forceinline__ bool next(int i, Unit& u) const {
        if (c < 0) return false;
        const int L = (i == 0) ? c : i * G + c2; const int tau = tbeg + (L >> npn_shift), pn = L & ((1 << npn_shift) - 1);
        if (tau >= tend) return false;
        int li = i0;
        while (toff[li + 1] <= tau) ++li;
        const int t = tau - toff[li], v = (li + 32) & 63, e = v & 31;
        u.pm = gather ? (v * 64 + t) : tau; u.pn = pn; u.bt = (e << npn_shift) + pn; u.aux = (tau << 16) | (v << 8) | t;
        return true;
    }
};
struct EpiGLU {
    static constexpr bool PERM = true;
    bf16_t* H; const float* entw;
    __device__ __forceinline__ void operator()(const f32x4 (&acc)[2][2][4][2], const Unit& u, int wr, int wc, int fr, int fq) const {
        const int tau = u.aux >> 16, v = (u.aux >> 8) & 255, t = u.aux & 255;
        const int col0 = u.pn * 128 + wc * 32 + 8 * fq;
        int rb = wr * 64 + fr; asm volatile("" : "+v"(rb));
        const float* wrow = entw + (size_t)v * 16384 + t * 256 + rb; bf16_t* hrow = H + ((size_t)tau * 256 + rb) * 256 + col0;
        float wv8[2][4];
#pragma unroll
        for (int ai = 0; ai < 2; ++ai)
#pragma unroll
            for (int m = 0; m < 4; ++m) wv8[ai][m] = wrow[ai * HALF + m * 16];
#pragma unroll
        for (int ai = 0; ai < 2; ++ai)
#pragma unroll
            for (int m = 0; m < 4; ++m) { const float w = wv8[ai][m];
                f32x4 h0, h1;
#pragma unroll
                for (int j = 0; j < 4; ++j) { const float g0 = acc[ai][0][m][0][j], g1 = acc[ai][0][m][1][j];
                    h0[j] = g0 * fast_sigmoid(g0) * acc[ai][1][m][0][j] * w; h1[j] = g1 * fast_sigmoid(g1) * acc[ai][1][m][1][j] * w; }
                u32x4 o; o.x = cvt_pk_bf16(h0[0], h0[1]); o.y = cvt_pk_bf16(h0[2], h0[3]); o.z = cvt_pk_bf16(h1[0], h1[1]); o.w = cvt_pk_bf16(h1[2], h1[3]);
                { unsigned long long* hp = (unsigned long long*)(hrow + (size_t)(ai * HALF + m * 16) * 256);
                  __hip_atomic_store(hp, (unsigned long long)o.x | ((unsigned long long)o.y << 32), __ATOMIC_RELAXED, __HIP_MEMORY_SCOPE_AGENT);
                  __hip_atomic_store(hp + 1, (unsigned long long)o.z | ((unsigned long long)o.w << 32), __ATOMIC_RELAXED, __HIP_MEMORY_SCOPE_AGENT); } }
    }
};
template <bool PRIMARY>
struct EpiScatter {
    static constexpr bool PERM = true;
    const int* ent; const PG8_LAS int* cnt; bf16_t* Y1; const float* H1; float* OUT;
    __device__ __forceinline__ void operator()(const f32x4 (&acc)[2][2][4][2], const Unit& u, int wr, int wc, int fr, int fq) const {
        const int v = (u.aux >> 8) & 255, t = u.aux & 255;
        int tq; asm volatile("v_mbcnt_lo_u32_b32 %0, -1, 0\n\tv_mbcnt_hi_u32_b32 %0, -1, %0" : "=v"(tq));
        const unsigned col0 = (unsigned)(u.pn * BM + wc * 32 + 8 * (tq >> 4));
        const int rb = wr * 64 + (tq & 15);
        const char* eb = (const char*)(ent + (size_t)v * 16384 + t * 256); const unsigned rb4 = (unsigned)rb * 4u; const int nv = cnt[v] - t * 256 - rb;
        unsigned tok[2][4];
#pragma unroll
        for (int ai = 0; ai < 2; ++ai)
#pragma unroll
            for (int m = 0; m < 4; ++m) tok[ai][m] = (ai * HALF + m * 16 < nv) ? *(const unsigned*)(eb + rb4 + (unsigned)(ai * HALF + m * 16) * 4u) : 0u;
#pragma unroll
        for (int ai = 0; ai < 2; ++ai)
#pragma unroll
            for (int mp = 0; mp < 2; ++mp) {
                u32x4 yv[2][2]; f32x4 hv[2][2][2];
                if (PRIMARY) {
#pragma unroll
                    for (int mm = 0; mm < 2; ++mm)
#pragma unroll
                        for (int bj = 0; bj < 2; ++bj) { const unsigned o = tok[ai][2 * mp + mm] * 1024u + col0 + bj * HALF;
                            yv[mm][bj] = *(const u32x4*)((const char*)Y1 + o * 2u); hv[mm][bj][0] = *(const f32x4*)((const char*)H1 + o * 4u); hv[mm][bj][1] = *(const f32x4*)((const char*)H1 + o * 4u + 16u); }
                }
#pragma unroll
                for (int mm = 0; mm < 2; ++mm) { const int m = 2 * mp + mm;
                    if (ai * HALF + m * 16 < nv) {
#pragma unroll
                        for (int bj = 0; bj < 2; ++bj) { const unsigned o = tok[ai][m] * 1024u + col0 + bj * HALF; const f32x4 a0 = acc[ai][bj][m][0], a1 = acc[ai][bj][m][1];
                            if (PRIMARY) { const u32x4 y = yv[mm][bj]; f32x4 t0 = hv[mm][bj][0], t1 = hv[mm][bj][1];
                                t0[0] += a0[0] + bflo(y.x); t0[1] += a0[1] + bfhi(y.x); t0[2] += a0[2] + bflo(y.y); t0[3] += a0[3] + bfhi(y.y);
                                t1[0] += a1[0] + bflo(y.z); t1[1] += a1[1] + bfhi(y.z); t1[2] += a1[2] + bflo(y.w); t1[3] += a1[3] + bfhi(y.w);
                                *(f32x4*)((char*)OUT + o * 4u) = t0; *(f32x4*)((char*)OUT + o * 4u + 16u) = t1; }
                            else { u32x4 w; w.x = cvt_pk_bf16(a0[0], a0[1]); w.y = cvt_pk_bf16(a0[2], a0[3]); w.z = cvt_pk_bf16(a1[0], a1[1]); w.w = cvt_pk_bf16(a1[2], a1[3]); *(u32x4*)((char*)Y1 + o * 2u) = w; } } } }
                asm volatile("" ::: "memory"); }
    }
};
}

__device__ __forceinline__ void route_phase(const Frame& F, const Args& a, gu32* ctl, const XcdBarrier& bar) {
    const float* ln2_g = a.in[20]; const float* w_grp = a.in[21]; const float* b_grp = a.in[22]; const float* w_er = a.in[23]; const float* b_er = a.in[24];
    const float* w_eg = a.in[25]; const float* w_eu = a.in[26]; const float* w_ed = a.in[27];
    unsigned char* ws = a.ws;
    const float* H1 = (const float*)(ws + WS_H1); bf16* HN = (bf16*)(ws + WS_HN);
    int* ENT = (int*)(ws + WS_ENT); float* ENTW = (float*)(ws + WS_ENTW);
    __syncthreads();
    cv_range(a, 0, CV_WGU, F.gw, F.NGW, F_LANE); cv_range(a, CV_WGU + CV_LATE, CV_ITEMS, F.gw, F.NGW, F_LANE);
    split_wait(bar, 3, F_TID);
    LAS float* wer = (LAS float*)F.lds;
    { const int t0 = F_TID; f32x4 wa[8], wb[8];
#pragma unroll
      for (int i = 0; i < 8; ++i) { const int r = t0 + 512 * i; wa[i] = *(const f32x4*)(w_er + (size_t)r * 8); wb[i] = *(const f32x4*)(w_er + (size_t)r * 8 + 4); }
#pragma unroll
      for (int i = 0; i < 8; ++i) { const int r = t0 + 512 * i, g = r >> 10, k = r & 1023; LAS float* d = wer + (size_t)(g * 8) * 1024 + k;
        d[0] = wa[i].x; d[1024] = wa[i].y; d[2048] = wa[i].z; d[3072] = wa[i].w; d[4096] = wb[i].x; d[5120] = wb[i].y; d[6144] = wb[i].z; d[7168] = wb[i].w; } }
    __syncthreads();
    const int lane = F_LANE;
    f32x4 wgq[4][4];
#pragma unroll
    for (int jj = 0; jj < 4; ++jj)
#pragma unroll
        for (int cc = 0; cc < 4; ++cc) wgq[jj][cc] = *(const f32x4*)(w_grp + (size_t)(4 * lane + 256 * jj + cc) * 4);
    f32x4 g2v[4]; gain_load(ln2_g, lane, g2v);
    const float bg0 = b_grp[0], bg1 = b_grp[1], bg2 = b_grp[2], bg3 = b_grp[3];
    const float berv = b_er[lane & 31];
    constexpr int TP = 2;
    f32x4 vn[TP][4];
#pragma unroll
    for (int q = 0; q < TP; ++q) { const int m = F.gw + q * F.NGW; row_load(H1 + (size_t)(m < M ? m : 0) * D, lane, vn[q]); }
    for (int mb = F.gw; mb < M; mb += TP * F.NGW) {
        f32x4 vv[TP][4];
#pragma unroll
        for (int q = 0; q < TP; ++q)
#pragma unroll
            for (int j = 0; j < 4; ++j) vv[q][j] = vn[q][j];
#pragma unroll
        for (int q = 0; q < TP; ++q) { const int m = mb + (TP + q) * F.NGW; row_load(H1 + (size_t)(m < M ? m : 0) * D, lane, vn[q]); }
        asm volatile("" ::: "memory");
        int lv[TP][2]; float lw[TP][2];
#pragma unroll
        for (int q = 0; q < TP; ++q) { const int m = mb + q * F.NGW; lv[q][0] = lv[q][1] = 0; lw[q][0] = lw[q][1] = 0.f; if (m >= M) continue;
            f32x4 (&v)[4] = vv[q];
            rms_row_finish(g2v, HN + (size_t)m * D, lane, v);
            float gl[4] = {0.f, 0.f, 0.f, 0.f};
#pragma unroll
            for (int jj = 0; jj < 4; ++jj)
#pragma unroll
                for (int cc = 0; cc < 4; ++cc) { const float y = v[jj][cc]; const f32x4 w4 = wgq[jj][cc]; gl[0] += y * w4.x; gl[1] += y * w4.y; gl[2] += y * w4.z; gl[3] += y * w4.w; }
            gl[0] = wave_sum(gl[0]) + bg0; gl[1] = wave_sum(gl[1]) + bg1; gl[2] = wave_sum(gl[2]) + bg2; gl[3] = wave_sum(gl[3]) + bg3;
            int gi = 0; float gmax = gl[0];
#pragma unroll
            for (int j = 1; j < 4; ++j) if (gl[j] > gmax) { gmax = gl[j]; gi = j; }
            float gden = 0.f;
#pragma unroll
            for (int j = 0; j < 4; ++j) gden += __expf(gl[j] - gmax);
            const float gw = 1.f / gden;
            gi = __builtin_amdgcn_readfirstlane(gi);
            const LAS float* we = wer + (size_t)(gi * 8) * 1024 + 4 * lane;
            float el[8];
#pragma unroll
            for (int j = 0; j < 8; ++j) { float s = 0.f;
#pragma unroll
                for (int jj = 0; jj < 4; ++jj) { const f32x4 w4 = *(const LAS f32x4*)(we + j * 1024 + 256 * jj); s += (v[jj].x * w4.x + v[jj].y * w4.y) + (v[jj].z * w4.z + v[jj].w * w4.w); }
                el[j] = wave_sum(s) + __uint_as_float(__builtin_amdgcn_readlane(__float_as_uint(berv), gi * 8 + j)); }
            int i0 = 0; float m0 = el[0];
#pragma unroll
            for (int j = 1; j < 8; ++j) if (el[j] > m0) { m0 = el[j]; i0 = j; }
            int i1 = -1; float m1 = -INFINITY;
#pragma unroll
            for (int j = 0; j < 8; ++j) if (j != i0 && el[j] > m1) { m1 = el[j]; i1 = j; }
            const float e1 = __expf(m1 - m0);
            lv[q][0] = gi * 8 + i0; lv[q][1] = 32 + gi * 8 + i1; lw[q][0] = gw / (1.f + e1); lw[q][1] = gw * e1 / (1.f + e1);
        }
        if (lane < 2 * TP) { const int q = lane >> 1, s = lane & 1, m = mb + q * F.NGW;
            const int vl = q ? (s ? lv[1][1] : lv[1][0]) : (s ? lv[0][1] : lv[0][0]); const float wl = q ? (s ? lw[1][1] : lw[1][0]) : (s ? lw[0][1] : lw[0][0]);
            if (m < M) { const unsigned r = __hip_atomic_fetch_add(ctl + CW_ECNT + 64 * vl, 1u, RLX_AGENT);
                ENT[(size_t)vl * 16384 + r] = m; ENTW[(size_t)vl * 16384 + r] = wl; } }
    }
}
__device__ __forceinline__ void moe_tile_offsets(const Frame& F, gu32* ctl) {
    LAS int* toff = (LAS int*)(F.lds + TOFF_LDS);
    __syncthreads();
    if (F_TID < 64) toff[80 + F_TID] = (int)__hip_atomic_load(ctl + CW_ECNT + 64 * F_TID, RLX_AGENT);
    __syncthreads();
    if (F_TID == 0) { int acc = 0; for (int i = 0; i < 64; ++i) { toff[i] = acc; acc += (toff[80 + ((i + 32) & 63)] + 255) >> 8; } toff[64] = acc; }
    __syncthreads();
}
constexpr int CW_SDONE = CW_ECNT + 64 * 64;
#define TOFFP ((const LAS int*)(F.lds + TOFF_LDS))
constexpr int G2LS = 528;
template <bool PRIMARY>
__device__ __forceinline__ void g2e_phase(const Frame& F, unsigned char* ws, float* OUT, int c, int G, const XcdBarrier& bar, int wait_inst) {
    LAS unsigned char* Bs = F.lds;
    const LAS int* toff = TOFFP; const LAS int* cnt = TOFFP + 80;
    const bf16* HH = (const bf16*)(ws + WS_HH); const bf16* WD = (const bf16*)(ws + WS_WD); const int* ENT = (const int*)(ws + WS_ENT);
    bf16* Y1 = (bf16*)(ws + WS_Y1); const float* H1 = (const float*)(ws + WS_H1);
    const int tid = F_TID, lane = tid & 63, i16 = lane & 15, quad = lane >> 4, w = F.wave;
    for (int u = (c >= 0 ? c : 256); u < 256; u += G) {
        const int e = u >> 3, pn = (u >> 1) & 3, hh = u & 1, v = (PRIMARY ? 0 : 32) + e, li = (v + 32) & 63;
        const int n = __builtin_amdgcn_readfirstlane(cnt[v]), hbase = __builtin_amdgcn_readfirstlane(toff[li]) * 256;
        const int half = ((((n + 1) >> 1) + 15) & ~15), rbeg = hh ? half : 0, rend = hh ? n : (half < n ? half : n);
        const int nstrip = (rend > rbeg) ? ((rend - rbeg + 15) >> 4) : 0;
        __syncthreads();
        bf16x8 af[8]; unsigned tok = 0u; int row = rbeg + 16 * w + i16;
        if (nstrip > 0) {
            const v4u* gb = (const v4u*)(WD + ((size_t)e * 1024 + pn * 256) * 256);
            v4u rb[16];
#pragma unroll
            for (int i = 0; i < 16; ++i) rb[i] = gb[tid + 512 * i];
            if (wait_inst >= 0) { split_wait(bar, wait_inst, tid); wait_inst = -1; }
            if (w < nstrip) { if (row < rend) tok = (unsigned)ENT[(size_t)v * 16384 + row];
                const bf16* hrow = HH + ((size_t)hbase + row) * 256 + 8 * quad;
#pragma unroll
                for (int ks = 0; ks < 8; ++ks) af[ks] = *(const bf16x8*)(hrow + 32 * ks); }
            const int c0 = tid >> 5, ch = tid & 31, L0 = 16 * ((c0 >> 2) & 1) + 4 * ((c0 >> 3) & 1) + (c0 & 3);
            LAS unsigned char* sb = Bs + L0 * G2LS + ch * 16;
#pragma unroll
            for (int i = 0; i < 16; ++i) *(LAS v4u*)(sb + (32 * (i >> 1) + 8 * (i & 1)) * G2LS) = rb[i];
        }
        __syncthreads();
        for (int s = w; s < nstrip; s += NWAVES) {
            const bool valid = row < rend;
            const unsigned ob = tok * 1024u + (unsigned)(pn * 256 + 8 * quad);
            v4u yv[8]; f32x4 hv[8][2];
            if (PRIMARY) {
#pragma unroll
                for (int p = 0; p < 8; ++p) { const unsigned o = ob + 32u * p; yv[p] = *(const v4u*)((const char*)Y1 + o * 2u); hv[p][0] = *(const f32x4*)((const char*)H1 + o * 4u); hv[p][1] = *(const f32x4*)((const char*)H1 + o * 4u + 16u); }
            }
            bf16x8 afn[8]; unsigned tokn = 0u; const int rown = row + 16 * NWAVES; const bool more = s + NWAVES < nstrip;
            if (!PRIMARY && more) { if (rown < rend) tokn = (unsigned)ENT[(size_t)v * 16384 + rown];
                const bf16* hrow = HH + ((size_t)hbase + rown) * 256 + 8 * quad;
#pragma unroll
                for (int ks = 0; ks < 8; ++ks) afn[ks] = *(const bf16x8*)(hrow + 32 * ks); }
            f32x4 acc[16];
#pragma unroll
            for (int nt = 0; nt < 16; ++nt) { acc[nt] = (f32x4){0.f, 0.f, 0.f, 0.f};
#pragma unroll
                for (int ks = 0; ks < 8; ++ks) acc[nt] = __builtin_amdgcn_mfma_f32_16x16x32_bf16(*(const LAS bf16x8*)(Bs + (16 * nt + i16) * G2LS + (32 * ks + 8 * quad) * 2), af[ks], acc[nt], 0, 0, 0);
                if (nt & 1) asm volatile("" ::: "memory"); }
            if (PRIMARY && more) { if (rown < rend) tokn = (unsigned)ENT[(size_t)v * 16384 + rown];
                const bf16* hrow = HH + ((size_t)hbase + rown) * 256 + 8 * quad;
#pragma unroll
                for (int ks = 0; ks < 8; ++ks) af[ks] = *(const bf16x8*)(hrow + 32 * ks); }
            if (valid) {
#pragma unroll
                for (int p = 0; p < 8; ++p) { const unsigned o = ob + 32u * p; const f32x4 a0 = acc[2 * p], a1 = acc[2 * p + 1];
                    if (PRIMARY) { const v4u y = yv[p]; f32x4 t0 = hv[p][0], t1 = hv[p][1];
                        t0[0] += a0[0] + pg8::bflo(y.x); t0[1] += a0[1] + pg8::bfhi(y.x); t0[2] += a0[2] + pg8::bflo(y.y); t0[3] += a0[3] + pg8::bfhi(y.y);
                        t1[0] += a1[0] + pg8::bflo(y.z); t1[1] += a1[1] + pg8::bfhi(y.z); t1[2] += a1[2] + pg8::bflo(y.w); t1[3] += a1[3] + pg8::bfhi(y.w);
                        *(f32x4*)((char*)OUT + o * 4u) = t0; *(f32x4*)((char*)OUT + o * 4u + 16u) = t1; }
                    else { v4u wv; wv.x = pg8::cvt_pk_bf16(a0[0], a0[1]); wv.y = pg8::cvt_pk_bf16(a0[2], a0[3]); wv.z = pg8::cvt_pk_bf16(a1[0], a1[1]); wv.w = pg8::cvt_pk_bf16(a1[2], a1[3]); *(v4u*)((char*)Y1 + o * 2u) = wv; } }
            }
            if (more) {
                if (!PRIMARY) {
#pragma unroll
                    for (int ks = 0; ks < 8; ++ks) af[ks] = afn[ks]; }
                tok = tokn; row = rown; }
        }
    }
    if (wait_inst >= 0) split_wait(bar, wait_inst, tid);
    __syncthreads();
}
#define MEGA_MOE_PHASES \
    if (IN(PH_ROUTE)) { route_phase(F, args, ctl, bar); } \
    SEAM(PH_ROUTE); \
    if (IN(PH_G1)) { moe_tile_offsets(F, ctl); \
        const int tS = __builtin_amdgcn_readfirstlane(TOFFP[32]), tA = __builtin_amdgcn_readfirstlane(TOFFP[64]);     \
        const int c2 = (c - 2 * tS + F.G) % F.G;     \
        {     \
            pg8::MoeOrder<0, 64, 1, 1> S{TOFFP, F.G, c, 0, tA, c2}; \
            pg8::Gemm g{(const bf16*)(ws + WS_HN), (const bf16*)(ws + WS_WGU), 1024, 1024, (const int*)(ws + WS_ENT)}; \
            pg8::EpiGLU E{(bf16*)(ws + WS_HH), (const float*)(ws + WS_ENTW)}; \
            pg8::gemm_phase<pg8::EpiGLU, pg8::MoeOrder<0, 64, 1, 1>, true, true>(F.lds, g, S, E, F.wave); } \
        {     \
            int nsec = 0; for (int i = 0;; ++i) { const int L = (i == 0) ? c : i * F.G + c2; if (L >= 2 * tA) break; if (L < 2 * tS) ++nsec; } \
            VM_WAIT(); __syncthreads(); \
            if (F_TID == 0 && nsec > 0) { __hip_atomic_fetch_add(ctl + CW_SDONE, (unsigned)nsec, RLX_AGENT); }     \
            const int nbusy = (F.G == 256 && 2 * tA > F.G) ? (2 * tA - F.G) : 0;     \
            const int nfree = F.G - nbusy, cf = (c2 >= nbusy) ? (c2 - nbusy) : -1; \
            if (cf >= 0) { \
                if (F_TID == 0) { unsigned sp = 0; while (__hip_atomic_load(ctl + CW_SDONE, RLX_AGENT) < (unsigned)(2 * tS)) { __builtin_amdgcn_s_sleep(2); if (++sp > (1u << 22)) break; } \
                    __builtin_amdgcn_fence(__ATOMIC_ACQUIRE, "agent"); VM_WAIT(); } \
                __syncthreads(); \
            } \
            g2e_phase<false>(F, ws, args.out, cf, nfree, bar, -1); } \
        split_arrive(bar, 4, F_TID);     \
    } \
    if (IN(PH_G2P)) { moe_tile_offsets(F, ctl); g2e_phase<true>(F, ws, args.out, c, F.G, bar, 4); }
__device__ __forceinline__ void ml_scan_phase(const Frame& F, float* CL, float* NL, float* SC) {
    const int gt = F.gw * 64 + F_LANE, NT = F.NGW * 64;
    for (int e = gt; e < 16 * 16512; e += NT) {
        const int bh = e / 16512, r = e % 16512; const bool isn = r >= 16384;
        float* p0 = isn ? (NL + (size_t)bh * NCHUNK * 128 + (r - 16384)) : (CL + (size_t)bh * NCHUNK * 16384 + r);
        const size_t stride = isn ? 128 : 16384;
        float loc[NCHUNK];
#pragma unroll
        for (int c = 0; c < NCHUNK; ++c) loc[c] = p0[c * stride];
        float st = 0.f, mcur = 0.f;
#pragma unroll
        for (int c = 0; c < NCHUNK; ++c) {
            const int u = bh * NCHUNK + c;
            const float bl = SC[u * 4 + 0], ml = SC[u * 4 + 1];
            const float mnew = fmaxf(bl + mcur, ml), dec = __expf(bl + mcur - mnew), sl = __expf(ml - mnew);
            p0[c * stride] = st; st = dec * st + sl * loc[c];
            if (r == 0) SC[u * 4 + 2] = mcur;
            mcur = mnew;
        }
    }
}
#define MFMA16(a, b, c) __builtin_amdgcn_mfma_f32_16x16x32_bf16((a), (b), (c), 0, 0, 0)
__device__ __forceinline__ bf16x8 lds_frag(const LAS unsigned char* p) { return *(const LAS bf16x8*)p; }
__device__ __forceinline__ bf16x8 lds_frag_tr2(const LAS unsigned char* p0, const LAS unsigned char* p1) {
    const s16x4 a = __builtin_amdgcn_ds_read_tr16_b64_v4i16((LAS s16x4*)p0), b = __builtin_amdgcn_ds_read_tr16_b64_v4i16((LAS s16x4*)p1);
    bf16x8 r; r[0] = a[0]; r[1] = a[1]; r[2] = a[2]; r[3] = a[3]; r[4] = b[0]; r[5] = b[1]; r[6] = b[2]; r[7] = b[3]; return r;
}
__device__ __forceinline__ bf16x8 pack8(f32x4 a, f32x4 b) {
    v4u w; w.x = pg8::cvt_pk_bf16(a[0], a[1]); w.y = pg8::cvt_pk_bf16(a[2], a[3]); w.z = pg8::cvt_pk_bf16(b[0], b[1]); w.w = pg8::cvt_pk_bf16(b[2], b[3]);
    return __builtin_bit_cast(bf16x8, w);
}
__device__ __forceinline__ float bfs(short s) { return __uint_as_float(((unsigned)(unsigned short)s) << 16); }
__device__ __forceinline__ float quad_sum(float v) { v += __shfl_xor(v, 16); v += __shfl_xor(v, 32); return v; }
__device__ __forceinline__ float quad_max(float v) { v = fmaxf(v, __shfl_xor(v, 16)); v = fmaxf(v, __shfl_xor(v, 32)); return v; }

constexpr int XS = 272;
__device__ __forceinline__ void cross_job(const Frame& F, bf16* Z, const bf16* kvm, const float* qg, const float* kg, int job) {
    const int b = job >> 6, h = (job >> 4) & 3, qblk = job & 15;
    LAS unsigned char* Ks = F.lds; LAS unsigned char* Vs = F.lds + 256 * XS;
    const int tid = F_TID, lane = tid & 63, i16 = lane & 15, quad = lane >> 4;
    __syncthreads();
    { const int ch = tid & 15, r0 = tid >> 4;
        const v4u* src = (const v4u*)(kvm + (size_t)(b * MEM_LEN + r0) * 1024 + h * 128 + ch * 8);
        v4u kw[8], vw[8];
#pragma unroll
        for (int it = 0; it < 8; ++it) { kw[it] = src[(size_t)it * 32 * 128]; vw[it] = src[(size_t)it * 32 * 128 + 64]; }
        const f32x4 g0 = *(const f32x4*)(kg + ch * 8), g1 = *(const f32x4*)(kg + ch * 8 + 4);
#pragma unroll
        for (int it = 0; it < 8; ++it) { const int row = r0 + 32 * it;
            const bf16x8 kr = __builtin_bit_cast(bf16x8, kw[it]); float kv[8]; float ss = 0.f;
#pragma unroll
            for (int e = 0; e < 8; ++e) { kv[e] = bfs(kr[e]); ss += kv[e] * kv[e]; }
            ss += DPP_F(ss, 0xB1, 0xf); ss += DPP_F(ss, 0x4E, 0xf); ss += DPP_F(ss, 0x141, 0xf); ss += DPP_F(ss, 0x140, 0xf);
            const float rstd = rsqrtf(ss * (1.f / 128) + EPS);
            f32x4 a, c2; a[0] = kv[0] * rstd * g0[0]; a[1] = kv[1] * rstd * g0[1]; a[2] = kv[2] * rstd * g0[2]; a[3] = kv[3] * rstd * g0[3];
            c2[0] = kv[4] * rstd * g1[0]; c2[1] = kv[5] * rstd * g1[1]; c2[2] = kv[6] * rstd * g1[2]; c2[3] = kv[7] * rstd * g1[3];
            *(LAS bf16x8*)(Ks + row * XS + ch * 16) = pack8(a, c2); *(LAS v4u*)(Vs + row * XS + ch * 16) = vw[it]; } }
    __syncthreads();
    for (int pass = 0; pass < 2; ++pass) {
        const int t0 = qblk * 256 + pass * 128 + F.wave * 16;
        bf16* qrow = Z + (size_t)(b * SEQ + t0 + i16) * ZW + Z_XQ + h * 128;
        bf16x8 qf[4]; float ss = 0.f; float qv[4][8];
#pragma unroll
        for (int ks = 0; ks < 4; ++ks) { const bf16x8 raw = *(const bf16x8*)(qrow + 32 * ks + 8 * quad);
#pragma unroll
            for (int e = 0; e < 8; ++e) { qv[ks][e] = bfs(raw[e]); ss += qv[ks][e] * qv[ks][e]; } }
        const float rstd = rsqrtf(quad_sum(ss) * (1.f / 128) + EPS) * 0.08838834764831845f;
#pragma unroll
        for (int ks = 0; ks < 4; ++ks) { const f32x4 g0 = *(const f32x4*)(qg + 32 * ks + 8 * quad), g1 = *(const f32x4*)(qg + 32 * ks + 8 * quad + 4);
            f32x4 a, c2; a[0] = qv[ks][0] * rstd * g0[0]; a[1] = qv[ks][1] * rstd * g0[1]; a[2] = qv[ks][2] * rstd * g0[2]; a[3] = qv[ks][3] * rstd * g0[3];
            c2[0] = qv[ks][4] * rstd * g1[0]; c2[1] = qv[ks][5] * rstd * g1[1]; c2[2] = qv[ks][6] * rstd * g1[2]; c2[3] = qv[ks][7] * rstd * g1[3];
            qf[ks] = pack8(a, c2); }
        f32x4 s[16];
#pragma unroll
        for (int jt = 0; jt < 16; ++jt) { s[jt] = (f32x4){0.f, 0.f, 0.f, 0.f};
#pragma unroll
            for (int ks = 0; ks < 4; ++ks) s[jt] = MFMA16(lds_frag(Ks + (16 * jt + i16) * XS + (32 * ks + 8 * quad) * 2), qf[ks], s[jt]);
            if (jt & 1) asm volatile("" ::: "memory"); }
        float mx = -INFINITY;
#pragma unroll
        for (int jt = 0; jt < 16; ++jt) mx = fmaxf(mx, fmaxf(fmaxf(s[jt][0], s[jt][1]), fmaxf(s[jt][2], s[jt][3])));
        mx = quad_max(mx);
        float l = 0.f;
#pragma unroll
        for (int jt = 0; jt < 16; ++jt) {
#pragma unroll
            for (int r = 0; r < 4; ++r) { s[jt][r] = __expf(s[jt][r] - mx); l += s[jt][r]; } }
        l = quad_sum(l);
        f32x4 o[8];
#pragma unroll
        for (int dt = 0; dt < 8; ++dt) o[dt] = (f32x4){0.f, 0.f, 0.f, 0.f};
#pragma unroll
        for (int kk = 0; kk < 8; ++kk) { const bf16x8 pf = pack8(s[2 * kk], s[2 * kk + 1]);
            const LAS unsigned char* vb = Vs + (32 * kk + 4 * quad + (i16 >> 2)) * XS + (4 * (i16 & 3)) * 2;
#pragma unroll
            for (int dt = 0; dt < 8; ++dt) o[dt] = MFMA16(lds_frag_tr2(vb + dt * 32, vb + 16 * XS + dt * 32), pf, o[dt]);
            asm volatile("" ::: "memory"); }
        const float inv = 1.f / l;
#pragma unroll
        for (int dt = 0; dt < 8; ++dt) { uint2 w; w.x = pg8::cvt_pk_bf16(o[dt][0] * inv, o[dt][1] * inv); w.y = pg8::cvt_pk_bf16(o[dt][2] * inv, o[dt][3] * inv);
            *(uint2*)(qrow + 16 * dt + 4 * quad) = w; }
    }
}

constexpr int DS = 144;
struct DilUnit { int b, g, h, r, res, blk; };
__device__ __forceinline__ DilUnit dil_decode(int u) {
    DilUnit d; const int rb = u & 31; d.h = (u >> 5) & 3; d.g = (u >> 7) % 3; d.b = u / 384;
    const int lr = (d.g == 0) ? 0 : (d.g == 1 ? 2 : 4), nblk = 32 >> lr; d.r = 1 << lr; d.res = rb / nblk; d.blk = rb % nblk; return d;
}
struct DilPre { v4u kw[4], vw[4]; bf16x8 qraw[2]; f32x4 kg0, kg1; };
__device__ __forceinline__ void dil_load(const bf16* Z, const float* kg, const DilUnit& d, int tid, int wave, DilPre& p) {
    const int colk = Z_DK + d.g * 256 + d.h * 64, colv = Z_DV + d.g * 256 + d.h * 64, colq = Z_DQ + d.g * 256 + d.h * 64;
#pragma unroll
    for (int it = 0; it < 4; ++it) { const int c = tid + 512 * it, j = c >> 3, ch = c & 7, ak0 = 128 * (d.blk - 1) + j, ak = ak0 < 0 ? 0 : ak0;
        const bf16* rowp = Z + (size_t)(d.b * SEQ + ak * d.r + d.res) * ZW; p.kw[it] = *(const v4u*)(rowp + colk + ch * 8); p.vw[it] = *(const v4u*)(rowp + colv + ch * 8); }
    const int lane = tid & 63, i16 = lane & 15, quad = lane >> 4, aq = 128 * d.blk + 16 * wave + i16;
    const bf16* qrow = Z + (size_t)(d.b * SEQ + aq * d.r + d.res) * ZW + colq;
#pragma unroll
    for (int ks = 0; ks < 2; ++ks) p.qraw[ks] = *(const bf16x8*)(qrow + 32 * ks + 8 * quad);
    p.kg0 = *(const f32x4*)(kg + d.g * 64 + (tid & 7) * 8); p.kg1 = *(const f32x4*)(kg + d.g * 64 + (tid & 7) * 8 + 4);
}
__device__ __forceinline__ void dil_stage(LAS unsigned char* Ks, LAS unsigned char* Vs, const DilUnit& d, int tid, const DilPre& p) {
    const f32x4 g0 = p.kg0, g1 = p.kg1;
#pragma unroll
    for (int it = 0; it < 4; ++it) { const int c = tid + 512 * it, j = c >> 3, ch = c & 7; const bool ok = d.blk > 0 || j >= 128;
        const v4u kwv = ok ? p.kw[it] : (v4u){0u, 0u, 0u, 0u}, vwv = ok ? p.vw[it] : (v4u){0u, 0u, 0u, 0u};
        const bf16x8 kr = __builtin_bit_cast(bf16x8, kwv); float kv[8]; float ss = 0.f;
#pragma unroll
        for (int e = 0; e < 8; ++e) { kv[e] = bfs(kr[e]); ss += kv[e] * kv[e]; }
        ss += DPP_F(ss, 0xB1, 0xf); ss += DPP_F(ss, 0x4E, 0xf); ss += DPP_F(ss, 0x141, 0xf);
        const float rstd = rsqrtf(ss * (1.f / 64) + EPS);
        f32x4 a, c2; a[0] = kv[0] * rstd * g0[0]; a[1] = kv[1] * rstd * g0[1]; a[2] = kv[2] * rstd * g0[2]; a[3] = kv[3] * rstd * g0[3];
        c2[0] = kv[4] * rstd * g1[0]; c2[1] = kv[5] * rstd * g1[1]; c2[2] = kv[6] * rstd * g1[2]; c2[3] = kv[7] * rstd * g1[3];
        *(LAS bf16x8*)(Ks + j * DS + ch * 16) = pack8(a, c2); *(LAS v4u*)(Vs + j * DS + ch * 16) = vwv; }
}
__device__ __forceinline__ void dil_compute(const LAS unsigned char* Ks, const LAS unsigned char* Vs, bf16* Z, const f32x4 (&qgv)[2][2], float* LSE, const DilUnit& d, int tid, int w, const bf16x8 (&qraw)[2]) {
    const int lane = tid & 63, i16 = lane & 15, quad = lane >> 4, g = d.g, blk = d.blk;
    const int aq = 128 * blk + 16 * w + i16;
    const int mrow = d.b * SEQ + aq * d.r + d.res;
    bf16* qrow = Z + (size_t)mrow * ZW + Z_DQ + g * 256 + d.h * 64;
    bf16x8 qf[2]; { float qv[2][8]; float ss = 0.f;
#pragma unroll
        for (int ks = 0; ks < 2; ++ks) {
#pragma unroll
            for (int e = 0; e < 8; ++e) { qv[ks][e] = bfs(qraw[ks][e]); ss += qv[ks][e] * qv[ks][e]; } }
        const float rstd = rsqrtf(quad_sum(ss) * (1.f / 64) + EPS) * 0.125f;
#pragma unroll
        for (int ks = 0; ks < 2; ++ks) { const f32x4 g0 = qgv[ks][0], g1 = qgv[ks][1];
            f32x4 a, c2; a[0] = qv[ks][0] * rstd * g0[0]; a[1] = qv[ks][1] * rstd * g0[1]; a[2] = qv[ks][2] * rstd * g0[2]; a[3] = qv[ks][3] * rstd * g0[3];
            c2[0] = qv[ks][4] * rstd * g1[0]; c2[1] = qv[ks][5] * rstd * g1[1]; c2[2] = qv[ks][6] * rstd * g1[2]; c2[3] = qv[ks][7] * rstd * g1[3];
            qf[ks] = pack8(a, c2); } }
    f32x4 s[10]; float mx = -INFINITY;
#pragma unroll
    for (int dj = 0; dj < 9; ++dj) { s[dj] = (f32x4){0.f, 0.f, 0.f, 0.f};
#pragma unroll
        for (int ks = 0; ks < 2; ++ks) s[dj] = MFMA16(lds_frag(Ks + (16 * (w + dj) + i16) * DS + (32 * ks + 8 * quad) * 2), qf[ks], s[dj]);
#pragma unroll
        for (int rg = 0; rg < 4; ++rg) { const int jj = 16 * dj + 4 * quad + rg; const bool ok = (jj >= i16) && (jj <= i16 + 128) && (blk > 0 || 16 * w + jj >= 128);
            s[dj][rg] = ok ? s[dj][rg] : -INFINITY; mx = fmaxf(mx, s[dj][rg]); } }
    mx = quad_max(mx);
    float l = 0.f;
#pragma unroll
    for (int dj = 0; dj < 9; ++dj)
#pragma unroll
        for (int rg = 0; rg < 4; ++rg) { s[dj][rg] = __expf(s[dj][rg] - mx); l += s[dj][rg]; }
    l = quad_sum(l);
    s[9] = (f32x4){0.f, 0.f, 0.f, 0.f};
    f32x4 o[4];
#pragma unroll
    for (int dt = 0; dt < 4; ++dt) o[dt] = (f32x4){0.f, 0.f, 0.f, 0.f};
#pragma unroll
    for (int kk = 0; kk < 5; ++kk) { const bf16x8 pf = pack8(s[2 * kk], s[2 * kk + 1]);
        const LAS unsigned char* vb = Vs + (16 * w + 32 * kk + 4 * quad + (i16 >> 2)) * DS + (4 * (i16 & 3)) * 2;
#pragma unroll
        for (int dt = 0; dt < 4; ++dt) o[dt] = MFMA16(lds_frag_tr2(vb + dt * 32, vb + 16 * DS + dt * 32), pf, o[dt]); }
    const float inv = 1.f / l;
#pragma unroll
    for (int dt = 0; dt < 4; ++dt) { uint2 wv; wv.x = pg8::cvt_pk_bf16(o[dt][0] * inv, o[dt][1] * inv); wv.y = pg8::cvt_pk_bf16(o[dt][2] * inv, o[dt][3] * inv);
        *(uint2*)(qrow + 16 * dt + 4 * quad) = wv; }
    LSE[((size_t)g * M + mrow) * 4 + d.h] = mx + __logf(l);
}
__device__ __forceinline__ void dil_phase(const Frame& F, bf16* Z, const float* qg, const float* kg, float* LSE, int c) {
    LAS unsigned char* Ks = F.lds; LAS unsigned char* Vs = F.lds + 256 * DS;
    const int tid = F_TID;
    __syncthreads();
    if (tid < 128) *(LAS v4u*)(Vs + (256 + (tid >> 3)) * DS + (tid & 7) * 16) = (v4u){0u, 0u, 0u, 0u};
    DilUnit cur = dil_decode(c < 1536 ? c : 0); DilPre pre; dil_load(Z, kg, cur, tid, F.wave, pre);
    for (int u = c; u < 1536; u += F.G) {
        __syncthreads();
        dil_stage(Ks, Vs, cur, tid, pre);
        bf16x8 qr[2] = {pre.qraw[0], pre.qraw[1]};
        __syncthreads();
        const DilUnit now = cur; const int un = u + F.G;
        f32x4 qgv[2][2];
#pragma unroll
        for (int ks = 0; ks < 2; ++ks) { qgv[ks][0] = *(const f32x4*)(qg + now.g * 64 + 32 * ks + 8 * ((tid & 63) >> 4)); qgv[ks][1] = *(const f32x4*)(qg + now.g * 64 + 32 * ks + 8 * ((tid & 63) >> 4) + 4); }
        cur = dil_decode(un < 1536 ? un : u); dil_load(Z, kg, cur, tid, F.wave, pre);
        asm volatile("" ::: "memory");
        dil_compute(Ks, Vs, Z, qgv, LSE, now, tid, F.wave, qr);
    }
}
__device__ __forceinline__ void dil_merge_phase(const Frame& F, bf16* Z, const float* LSE) {
    const int gt = F.gw * 64 + F_LANE, NT = F.NGW * 64;
    for (int it0 = gt; it0 < M * 32; it0 += 2 * NT) {
        float l[2][3]; bf16x8 av[2][3]; bf16* pp[2];
#pragma unroll
        for (int q = 0; q < 2; ++q) { const int it = it0 + q * NT; const int m = (it < M * 32) ? (it >> 5) : 0, h = (it >> 3) & 3, ch = it & 7;
            l[q][0] = LSE[((size_t)0 * M + m) * 4 + h]; l[q][1] = LSE[((size_t)1 * M + m) * 4 + h]; l[q][2] = LSE[((size_t)2 * M + m) * 4 + h];
            pp[q] = Z + (size_t)m * ZW + Z_DQ + h * 64 + ch * 8;
            av[q][0] = *(const bf16x8*)pp[q]; av[q][1] = *(const bf16x8*)(pp[q] + 256); av[q][2] = *(const bf16x8*)(pp[q] + 512); }
#pragma unroll
        for (int q = 0; q < 2; ++q) { if (it0 + q * NT >= M * 32) break;
            const float mxl = fmaxf(l[q][0], fmaxf(l[q][1], l[q][2])), e0 = __expf(l[q][0] - mxl), e1 = __expf(l[q][1] - mxl), e2 = __expf(l[q][2] - mxl), inv = 1.f / (e0 + e1 + e2);
            f32x4 x, y;
#pragma unroll
            for (int e = 0; e < 4; ++e) { x[e] = (e0 * bfs(av[q][0][e]) + e1 * bfs(av[q][1][e]) + e2 * bfs(av[q][2][e])) * inv; y[e] = (e0 * bfs(av[q][0][e + 4]) + e1 * bfs(av[q][1][e + 4]) + e2 * bfs(av[q][2][e + 4])) * inv; }
            *(bf16x8*)pp[q] = pack8(x, y); }
    }
}

constexpr int MS = 272;
__device__ __forceinline__ void conv_silu8(const bf16* Z, const float* cw, int m, int c0, float (&y)[8]) {
    const int t = m % SEQ;
#pragma unroll
    for (int e = 0; e < 8; ++e) y[e] = 0.f;
#pragma unroll
    for (int j = 0; j < 4; ++j) { if (t - 3 + j >= 0) { const bf16x8 z = *(const bf16x8*)(Z + (size_t)(m - 3 + j) * ZW + c0);
            const f32x4 w0 = *(const f32x4*)(cw + j * 1024 + c0), w1 = *(const f32x4*)(cw + j * 1024 + c0 + 4);
            y[0] += w0[0] * bfs(z[0]); y[1] += w0[1] * bfs(z[1]); y[2] += w0[2] * bfs(z[2]); y[3] += w0[3] * bfs(z[3]);
            y[4] += w1[0] * bfs(z[4]); y[5] += w1[1] * bfs(z[5]); y[6] += w1[2] * bfs(z[6]); y[7] += w1[3] * bfs(z[7]); } }
#pragma unroll
    for (int e = 0; e < 8; ++e) y[e] = y[e] * pg8::fast_sigmoid(y[e]);
}
struct ConvRows { f32x4 w[4][2]; bf16x8 z[7]; };
__device__ __forceinline__ void conv_load(const bf16* Z, const float* cw, int m, int c0, ConvRows& R) {
    const int t = m % SEQ;
#pragma unroll
    for (int j = 0; j < 4; ++j) { R.w[j][0] = *(const f32x4*)(cw + j * 1024 + c0); R.w[j][1] = *(const f32x4*)(cw + j * 1024 + c0 + 4); }
#pragma unroll
    for (int i = 0; i < 7; ++i) { const int back = (t - 3 + i >= 0) ? (3 - i) : -i; R.z[i] = *(const bf16x8*)(Z + (size_t)(m - back) * ZW + c0); }
}
__device__ __forceinline__ void conv_finish(const ConvRows& R, int m, float (&y)[4][8]) {
    const int t = m % SEQ;
    bf16x8 z[7];
#pragma unroll
    for (int i = 0; i < 7; ++i) z[i] = (t - 3 + i >= 0) ? R.z[i] : (bf16x8){0, 0, 0, 0, 0, 0, 0, 0};
#pragma unroll
    for (int r = 0; r < 4; ++r) {
#pragma unroll
        for (int e = 0; e < 8; ++e) { float acc = 0.f;
#pragma unroll
            for (int j = 0; j < 4; ++j) acc += R.w[j][e >> 2][e & 3] * bfs(z[r + j][e]);
            y[r][e] = acc * pg8::fast_sigmoid(acc); } }
}
__device__ __forceinline__ void conv_silu8x4(const bf16* Z, const float* cw, int m, int c0, float (&y)[4][8]) { ConvRows R; conv_load(Z, cw, m, c0, R); conv_finish(R, m, y); }
__device__ __forceinline__ void wave_scan_sum2(float v0, float v1, int lane, float& p0, float& p1) {
    float p = v0 + v1;
#pragma unroll
    for (int off = 1; off < 64; off <<= 1) { const float t = __shfl_up(p, off); if (lane >= off) p += t; }
    p1 = p; p0 = p - v1;
}
__device__ __forceinline__ void wave_scan_max2(float v0, float v1, int lane, float& p0, float& p1) {
    float p = fmaxf(v0, v1);
#pragma unroll
    for (int off = 1; off < 64; off <<= 1) { const float t = __shfl_up(p, off); if (lane >= off) p = fmaxf(p, t); }
    const float prev = __shfl_up(p, 1);
    p1 = p; p0 = (lane > 0) ? fmaxf(prev, v0) : v0;
}
__device__ __forceinline__ void ml_local_fast(const Frame& F, const bf16* Z, const float* cw, const float* ifg, float* CL, float* NL, float* SC, int u) {
    LAS unsigned char* Ks = F.lds; LAS unsigned char* Vs = F.lds + 128 * MS; LAS float* av = (LAS float*)(F.lds + 256 * MS); LAS float* npart = av + 128;
    const int c = u % NCHUNK, h = (u / NCHUNK) % 4, b = u / (NCHUNK * 4), tid = F_TID, lane = tid & 63, i16 = lane & 15, quad = lane >> 4;
    const int m0 = b * SEQ + c * 128;
    const int sg = tid >> 4, ch = tid & 15;
    ConvRows rk; conv_load(Z, cw, m0 + 4 * sg, 512 + h * 128 + ch * 8, rk);
    v4u vr[4];
#pragma unroll
    for (int r = 0; r < 4; ++r) vr[r] = *(const v4u*)(Z + (size_t)(m0 + 4 * sg + r) * ZW + Z_MV + h * 128 + ch * 8);
    __syncthreads();
    if (F.wave == 0) {
        const float f0 = log_sigmoid_(ifg[(size_t)(m0 + 2 * lane) * 8 + 4 + h]), f1 = log_sigmoid_(ifg[(size_t)(m0 + 2 * lane + 1) * 8 + 4 + h]);
        float b0, b1; wave_scan_sum2(f0, f1, lane, b0, b1);
        const float bl = __shfl(b1, 63);
        const float le0 = bl - b0 + ifg[(size_t)(m0 + 2 * lane) * 8 + h], le1 = bl - b1 + ifg[(size_t)(m0 + 2 * lane + 1) * 8 + h];
        const float ml = wave_max(fmaxf(le0, le1));
        av[2 * lane] = __expf(le0 - ml); av[2 * lane + 1] = __expf(le1 - ml);
        if (lane == 0) { SC[u * 4 + 0] = bl; SC[u * 4 + 1] = ml; }
    }
    __syncthreads();
    { float y[4][8];
      conv_finish(rk, m0 + 4 * sg, y);
#pragma unroll
      for (int r = 0; r < 4; ++r) { const int s = 4 * sg + r; const float sc = 0.08838834764831845f * av[s];
          f32x4 a, c2; a[0] = y[r][0] * sc; a[1] = y[r][1] * sc; a[2] = y[r][2] * sc; a[3] = y[r][3] * sc; c2[0] = y[r][4] * sc; c2[1] = y[r][5] * sc; c2[2] = y[r][6] * sc; c2[3] = y[r][7] * sc;
          *(LAS bf16x8*)(Ks + s * MS + ch * 16) = pack8(a, c2);
          *(LAS v4u*)(Vs + s * MS + ch * 16) = vr[r]; } }
    __syncthreads();
    { const int d = tid & 127, sq = tid >> 7; float acc = 0.f;
      for (int s = sq * 32; s < sq * 32 + 32; ++s) acc += bfs(*(const LAS short*)(Ks + s * MS + d * 2));
      npart[sq * 128 + d] = acc; }
    const int w = F.wave;
    f32x4 acc[8];
#pragma unroll
    for (int dt = 0; dt < 8; ++dt) acc[dt] = (f32x4){0.f, 0.f, 0.f, 0.f};
#pragma unroll
    for (int ks = 0; ks < 4; ++ks) {
        const int rbase = 32 * ks + 8 * quad + (i16 >> 2), cb = 4 * (i16 & 3) * 2;
        const bf16x8 af = lds_frag_tr2(Vs + rbase * MS + 16 * w * 2 + cb, Vs + (rbase + 4) * MS + 16 * w * 2 + cb);
#pragma unroll
        for (int dt = 0; dt < 8; ++dt) acc[dt] = MFMA16(af, lds_frag_tr2(Ks + rbase * MS + dt * 32 + cb, Ks + (rbase + 4) * MS + dt * 32 + cb), acc[dt]); }
    float* ct = CL + (size_t)u * 16384;
#pragma unroll
    for (int dt = 0; dt < 8; ++dt)
#pragma unroll
        for (int rg = 0; rg < 4; ++rg) ct[(16 * w + 4 * quad + rg) * 128 + 16 * dt + i16] = acc[dt][rg];
    __syncthreads();
    if (tid < 128) NL[(size_t)u * 128 + tid] = (npart[tid] + npart[128 + tid]) + (npart[256 + tid] + npart[384 + tid]);
}
__device__ __forceinline__ void ml_out_fast(const Frame& F, const bf16* Z, const float* cw, const float* ifg, const float* CP, const float* NP, const float* SC, const float* ng, bf16* HA, int u, const XcdBarrier& bar, int wait_inst) {
    LAS unsigned char* Qs = F.lds; LAS unsigned char* Ks = Qs + 128 * MS; LAS unsigned char* Vs = Ks + 128 * MS; LAS unsigned char* Cs = Vs + 128 * MS;
    LAS float* gv = (LAS float*)(Cs + 144 * MS); LAS float* cmx = gv + 128; LAS float* bv = cmx + 128;
    const int c = u % NCHUNK, h = (u / NCHUNK) % 4, b = u / (NCHUNK * 4), tid = F_TID, lane = tid & 63, i16 = lane & 15, quad = lane >> 4;
    const int m0 = b * SEQ + c * 128;
    float mprev = 0.f;
    const int sg = tid >> 4, ch = tid & 15;
    ConvRows rq, rk; conv_load(Z, cw, m0 + 4 * sg, h * 128 + ch * 8, rq); conv_load(Z, cw, m0 + 4 * sg, 512 + h * 128 + ch * 8, rk);
    v4u vr[4]; f32x4 cp[4][2];
#pragma unroll
    for (int r = 0; r < 4; ++r) vr[r] = *(const v4u*)(Z + (size_t)(m0 + 4 * sg + r) * ZW + Z_MV + h * 128 + ch * 8);
    if (wait_inst < 0) {
#pragma unroll
        for (int r = 0; r < 4; ++r) { const int s = 4 * sg + r; cp[r][0] = *(const f32x4*)(CP + (size_t)u * 16384 + s * 128 + ch * 8); cp[r][1] = *(const f32x4*)(CP + (size_t)u * 16384 + s * 128 + ch * 8 + 4); } }
    __syncthreads();
#define ML_OUT_GATES() do { mprev = SC[u * 4 + 2]; if (F.wave == 0) { \
        const float f0 = log_sigmoid_(ifg[(size_t)(m0 + 2 * lane) * 8 + 4 + h]), f1 = log_sigmoid_(ifg[(size_t)(m0 + 2 * lane + 1) * 8 + 4 + h]); \
        float b0, b1; wave_scan_sum2(f0, f1, lane, b0, b1); \
        const float g0 = ifg[(size_t)(m0 + 2 * lane) * 8 + h] - b0, g1 = ifg[(size_t)(m0 + 2 * lane + 1) * 8 + h] - b1; \
        float c0, c1; wave_scan_max2(g0, g1, lane, c0, c1); \
        gv[2 * lane] = g0; gv[2 * lane + 1] = g1; cmx[2 * lane] = fmaxf(c0, mprev); cmx[2 * lane + 1] = fmaxf(c1, mprev); bv[2 * lane] = b0; bv[2 * lane + 1] = b1; } } while (0)
    if (wait_inst < 0) ML_OUT_GATES();
    { float y[4][8];
      conv_finish(rq, m0 + 4 * sg, y);
#pragma unroll
      for (int r = 0; r < 4; ++r) { f32x4 a, c2; a[0] = y[r][0]; a[1] = y[r][1]; a[2] = y[r][2]; a[3] = y[r][3]; c2[0] = y[r][4]; c2[1] = y[r][5]; c2[2] = y[r][6]; c2[3] = y[r][7];
          *(LAS bf16x8*)(Qs + (4 * sg + r) * MS + ch * 16) = pack8(a, c2); }
      conv_finish(rk, m0 + 4 * sg, y);
#pragma unroll
      for (int r = 0; r < 4; ++r) { const float sc = 0.08838834764831845f; f32x4 a, c2; a[0] = y[r][0] * sc; a[1] = y[r][1] * sc; a[2] = y[r][2] * sc; a[3] = y[r][3] * sc; c2[0] = y[r][4] * sc; c2[1] = y[r][5] * sc; c2[2] = y[r][6] * sc; c2[3] = y[r][7] * sc;
          *(LAS bf16x8*)(Ks + (4 * sg + r) * MS + ch * 16) = pack8(a, c2); }
#pragma unroll
      for (int r = 0; r < 4; ++r) *(LAS v4u*)(Vs + (4 * sg + r) * MS + ch * 16) = vr[r];
      if (wait_inst >= 0) { split_wait(bar, wait_inst, tid); ML_OUT_GATES();
#pragma unroll
          for (int r = 0; r < 4; ++r) { const int s = 4 * sg + r; cp[r][0] = *(const f32x4*)(CP + (size_t)u * 16384 + s * 128 + ch * 8); cp[r][1] = *(const f32x4*)(CP + (size_t)u * 16384 + s * 128 + ch * 8 + 4); } }
#pragma unroll
      for (int r = 0; r < 4; ++r) *(LAS bf16x8*)(Cs + (4 * sg + r) * MS + ch * 16) = pack8(cp[r][0], cp[r][1]); }
#undef ML_OUT_GATES
    for (int it = tid; it < 16 * 16; it += 512) { const int rr = it >> 4, ch = it & 15;
        f32x4 p0 = (f32x4){0.f, 0.f, 0.f, 0.f}, p1 = p0;
        if (rr == 0) { p0 = *(const f32x4*)(NP + (size_t)u * 128 + ch * 8); p1 = *(const f32x4*)(NP + (size_t)u * 128 + ch * 8 + 4); }
        *(LAS bf16x8*)(Cs + (128 + rr) * MS + ch * 16) = pack8(p0, p1); }
    __syncthreads();
    const int w = F.wave, t = 16 * w + i16;
    const bf16* mo = Z + (size_t)(m0 + t) * ZW + Z_MO + h * 128; bf16* op = (bf16*)mo;
    uint2 mwv[8]; f32x4 ggv[8];
#pragma unroll
    for (int et = 0; et < 8; ++et) { const int e0 = 16 * et + 4 * quad; mwv[et] = *(const uint2*)(mo + e0); ggv[et] = *(const f32x4*)(ng + h * 128 + e0); }
    asm volatile("" ::: "memory");
    bf16x8 qf[4];
#pragma unroll
    for (int ks = 0; ks < 4; ++ks) qf[ks] = lds_frag(Qs + t * MS + (32 * ks + 8 * quad) * 2);
    f32x4 acc[9];
#pragma unroll
    for (int et = 0; et < 9; ++et) { acc[et] = (f32x4){0.f, 0.f, 0.f, 0.f};
#pragma unroll
        for (int ks = 0; ks < 4; ++ks) acc[et] = MFMA16(lds_frag(Cs + (16 * et + i16) * MS + (32 * ks + 8 * quad) * 2), qf[ks], acc[et]); }
    const float cm = cmx[t], winter = __expf(mprev - cm);
    const float qn = __shfl(acc[8][0], i16);
#pragma unroll
    for (int et = 0; et < 8; ++et) acc[et] = acc[et] * winter;
    float den = winter * qn;
    f32x4 sv[8]; float dsum = 0.f;
#pragma unroll
    for (int js = 0; js < 8; ++js) { sv[js] = (f32x4){0.f, 0.f, 0.f, 0.f};
        if (js <= w) {
#pragma unroll
            for (int ks = 0; ks < 4; ++ks) sv[js] = MFMA16(lds_frag(Ks + (16 * js + i16) * MS + (32 * ks + 8 * quad) * 2), qf[ks], sv[js]);
#pragma unroll
            for (int rg = 0; rg < 4; ++rg) { const int s = 16 * js + 4 * quad + rg; const float wgt = (s <= t) ? __expf(gv[s] - cm) : 0.f; sv[js][rg] *= wgt; dsum += sv[js][rg]; } } }
    den += quad_sum(dsum);
#pragma unroll
    for (int kk = 0; kk < 4; ++kk) { if (2 * kk <= w) { const bf16x8 pf = pack8(sv[2 * kk], sv[2 * kk + 1]);
            const LAS unsigned char* vb = Vs + (32 * kk + 4 * quad + (i16 >> 2)) * MS + (4 * (i16 & 3)) * 2;
#pragma unroll
            for (int et = 0; et < 8; ++et) acc[et] = MFMA16(lds_frag_tr2(vb + et * 32, vb + 16 * MS + et * 32), pf, acc[et]); } }
    const float dn = fmaxf(fabsf(den), __expf(-bv[t] - cm)), inv = 1.f / dn;
    float ss = 0.f;
#pragma unroll
    for (int et = 0; et < 8; ++et) { acc[et] = acc[et] * inv; ss += (acc[et][0] * acc[et][0] + acc[et][1] * acc[et][1]) + (acc[et][2] * acc[et][2] + acc[et][3] * acc[et][3]); }
    const float rstd = rsqrtf(quad_sum(ss) * (1.f / 128) + EPS);
#pragma unroll
    for (int et = 0; et < 8; ++et) { const int e0 = 16 * et + 4 * quad; const uint2 mw = mwv[et]; const f32x4 gg = ggv[et];
        const float o0 = acc[et][0] * rstd * gg[0] * pg8::fast_sigmoid(pg8::bflo(mw.x)), o1 = acc[et][1] * rstd * gg[1] * pg8::fast_sigmoid(pg8::bfhi(mw.x));
        const float o2 = acc[et][2] * rstd * gg[2] * pg8::fast_sigmoid(pg8::bflo(mw.y)), o3 = acc[et][3] * rstd * gg[3] * pg8::fast_sigmoid(pg8::bfhi(mw.y));
        uint2 wv; wv.x = pg8::cvt_pk_bf16(o0, o1); wv.y = pg8::cvt_pk_bf16(o2, o3); *(uint2*)(op + e0) = wv; }
}
#define MEGA_TOKEN_MIXER_PHASES \
    if (IN(PH_P2)) { \
        for (int u = c; u < 512; u += F.G) ml_local_fast(F, Z, args.in[4], (const float*)(ws + WS_IFG), (float*)(ws + WS_CL), (float*)(ws + WS_NL), (float*)(ws + WS_MSC), u); \
        split_arrive(bar, 0, F_TID);                              \
        for (int job = c; job < 256; job += F.G) cross_job(F, Z, (const bf16*)(ws + WS_KVM), args.in[12], args.in[13], job); \
        dil_phase(F, Z, args.in[8], args.in[9], (float*)(ws + WS_LSE), c); \
        split_arrive(bar, 1, F_TID);                              \
    } \
    if (IN(PH_SCAN)) { split_wait(bar, 0, F_TID); ml_scan_phase(F, (float*)(ws + WS_CL), (float*)(ws + WS_NL), (float*)(ws + WS_MSC)); \
        split_wait(bar, 1, F_TID); dil_merge_phase(F, Z, (const float*)(ws + WS_LSE)); \
        split_arrive(bar, 5, F_TID);                              } \
    if (IN(PH_MLOUT)) { int wi_ = 5; \
        for (int u = c; u < 512; u += F.G) { ml_out_fast(F, Z, args.in[4], (const float*)(ws + WS_IFG), (const float*)(ws + WS_CL), (const float*)(ws + WS_NL), (const float*)(ws + WS_MSC), args.in[7], (bf16*)(ws + WS_HA), u, bar, wi_); wi_ = -1; } \
        if (wi_ >= 0) split_wait(bar, 5, F_TID); \
        split_arrive(bar, 2, F_TID);                              \
    }
__device__ __forceinline__ void p0_prologue(const Frame& F, const Args& a) {
    const float* x = a.in[0]; const float* mem = a.in[1]; const float* ln1_g = a.in[2]; const float* w_in = a.in[3];
    const float* m_i_b = a.in[5]; const float* m_f_b = a.in[6]; const float* mem_norm_g = a.in[10]; const float* w_mem_kv = a.in[11];
    unsigned char* ws = a.ws;
    bf16* XN = (bf16*)a.out; float* IFG = (float*)(ws + WS_IFG);
    LAS float* wif = (LAS float*)(F.lds + 8 * 8448);
    { const int t0 = F_TID; f32x4 wa[2], wb[2];
#pragma unroll
      for (int i = 0; i < 2; ++i) { const int k = t0 + 512 * i; wa[i] = *(const f32x4*)(w_in + (size_t)k * IN_TOTAL + 2048); wb[i] = *(const f32x4*)(w_in + (size_t)k * IN_TOTAL + 2052); }
#pragma unroll
      for (int i = 0; i < 2; ++i) { const int k = t0 + 512 * i;
        wif[k] = wa[i].x; wif[1024 + k] = wa[i].y; wif[2048 + k] = wa[i].z; wif[3072 + k] = wa[i].w; wif[4096 + k] = wb[i].x; wif[5120 + k] = wb[i].y; wif[6144 + k] = wb[i].z; wif[7168 + k] = wb[i].w; } }
    __syncthreads();
    constexpr int I0 = 16 * 64, I1 = 16 * 88, I3 = 16 * 32;
    constexpr int NITEMS = I0 + I1 + I3;
    for (int it = F.gw; it < NITEMS; it += F.NGW) {
        int r = it;
        if (r < I0) { p0_transpose_item(w_in, IN_TOTAL, 1024, (bf16*)(ws + WS_W1Z), r / 64, r % 64, F_LANE); continue; } r -= I0;
        if (r < I1) { p0_transpose_item(w_in + 2056, IN_TOTAL, 1024, (bf16*)(ws + WS_W1Z) + (size_t)2048 * 1024, r / 88, r % 88, F_LANE); continue; } r -= I1;
        p0_transpose_item(w_mem_kv, 1024, 1024, (bf16*)(ws + WS_WKV), r / 32, r % 32, F_LANE);
    }
    if (F.G != 256) cv_range(a, CV_WGU, CV_WGU + CV_LATE, F.gw, F.NGW, F_LANE);
    f32x4 g1v[4]; gain_load(ln1_g, F_LANE, g1v);
    for (int mb = F.gw; mb < M; mb += 4 * F.NGW) {
        f32x4 vv[4][4];
#pragma unroll
        for (int q = 0; q < 4; ++q) { const int m = mb + q * F.NGW; if (m < M) row_load(x + (size_t)m * D, F_LANE, vv[q]); }
#pragma unroll
        for (int q = 0; q < 4; ++q) { const int m = mb + q * F.NGW; if (m >= M) break;
            f32x4 (&v)[4] = vv[q];
            rms_row_finish(g1v, XN + (size_t)m * D, F_LANE, v);
            float acc[8];
#pragma unroll
            for (int j = 0; j < 8; ++j) { float s = 0.f;
#pragma unroll
                for (int jj = 0; jj < 4; ++jj) { const f32x4 w4 = *(const LAS f32x4*)(wif + j * 1024 + 4 * F_LANE + 256 * jj); s += (v[jj].x * w4.x + v[jj].y * w4.y) + (v[jj].z * w4.z + v[jj].w * w4.w); }
                acc[j] = wave_sum(s); }
            if (F_LANE == 0) {
                f32x4 o0, o1;
                o0.x = acc[0] + m_i_b[0]; o0.y = acc[1] + m_i_b[1]; o0.z = acc[2] + m_i_b[2]; o0.w = acc[3] + m_i_b[3];
                o1.x = acc[4] + m_f_b[0]; o1.y = acc[5] + m_f_b[1]; o1.z = acc[6] + m_f_b[2]; o1.w = acc[7] + m_f_b[3];
                *(f32x4*)(IFG + (size_t)m * 8) = o0; *(f32x4*)(IFG + (size_t)m * 8 + 4) = o1;
            }
        }
    }
    { f32x4 gmv[4]; gain_load(mem_norm_g, F_LANE, gmv);
      for (int m = F.gw; m < MROWS; m += F.NGW) { f32x4 v[4]; row_load(mem + (size_t)m * D, F_LANE, v); rms_row_finish(gmv, (bf16*)(ws + WS_MEMN) + (size_t)m * D, F_LANE, v); } }
}

__device__ __forceinline__ void kv_norm_tile(const Frame& F, bf16* KVM, const float* kg, int pm, int pn) {
    VM_WAIT(); __syncthreads();
    const float g0 = kg[2 * F_LANE], g1 = kg[2 * F_LANE + 1];
    for (int it = F.wave; it < 512; it += NWAVES) {
        const int row = pm * 256 + (it >> 1), h = pn * 2 + (it & 1);
        unsigned* p = (unsigned*)(KVM + (size_t)row * 1024 + h * 128) + F_LANE;
        const unsigned w = __hip_atomic_load(p, RLX_AGENT);
        const float a = pg8::bflo(w), b = pg8::bfhi(w);
        const float rstd = rsqrtf(wave_sum(a * a + b * b) * (1.f / 128) + EPS);
        *p = pk2(a * rstd * g0, b * rstd * g1);
    }
}

__global__ void __launch_bounds__(NWAVES * 64, 2) mega_fwd(Args args) {
    extern __shared__ __attribute__((aligned(16))) unsigned char lds_raw[];
    Frame F;
    F.lds = (LAS unsigned char*)lds_raw;
    F.wave = __builtin_amdgcn_readfirstlane((int)threadIdx.x >> 6);
    F.G = gridDim.x;
    { const int bx = blockIdx.x; const int vcu = (F.G % 8 == 0) ? (bx % 8) * (F.G / 8) + bx / 8 : bx; F.gw = vcu * NWAVES + F.wave; F.NGW = F.G * NWAVES; }
    unsigned char* ws = args.ws;
    gu32* ctl = (gu32*)(ws + WS_CTL);
    volatile LAS unsigned* MISC = (volatile LAS unsigned*)(F.lds + MISC_OFF);
    for (int u = F_TID; u < (LDS_BYTES - LDSCTL_OFF) / 4; u += NWAVES * 64) ((LAS unsigned*)(F.lds + LDSCTL_OFF))[u] = 0u;
    __syncthreads();
    const int lo = args.ph_lo, hi = args.ph_hi;
    XcdBarrier bar = xcd_barrier_post((unsigned*)(ctl + CW_BAR) + args.li * XCD_BAR_WORDS, MISC + 8, F_TID);
#ifndef PHASE_MASK
#define PHASE_MASK 0xFFFF
#endif
#define IN(k) (((PHASE_MASK >> (k)) & 1) && lo <= (k) && (k) < hi)
#define SEAM(k) do { if (IN(k) && IN((k) + 1)) xcd_barrier(bar, F_TID); } while (0)
    const int c = (int)blockIdx.x;
    bf16* XN = (bf16*)args.out; bf16* GS = (bf16*)((unsigned char*)args.out + 32 * MiB);
    bf16* Z = (bf16*)(ws + WS_Z);

    if (IN(PH_P0)) { p0_prologue(F, args); }
    SEAM(PH_P0);
    if (IN(PH_P1)) {
        { pg8::Gemm g{XN, (const bf16*)(ws + WS_W1Z), 1024, 1024, nullptr}; pg8::StaticOrder S; S.init(M, ZW, F.G, c);
          pg8::EpiStoreBf16 E{Z, ZW};
          pg8::gemm_phase<pg8::EpiStoreBf16, pg8::StaticOrder, true, false>(F.lds, g, S, E, F.wave); }
        { pg8::Gemm g{(const bf16*)(ws + WS_MEMN), (const bf16*)(ws + WS_WKV), 1024, 1024, nullptr}; pg8::StaticOrder S; S.init(MROWS, 1024, F.G, (c + 64) % F.G);
          pg8::EpiStoreBf16 E{(bf16*)(ws + WS_KVM), 1024};
          pg8::gemm_phase<pg8::EpiStoreBf16, pg8::StaticOrder, true, false>(F.lds, g, S, E, F.wave);
        }
        if (F.G == 256 && c >= 208) cv_range(args, CV_WGU, CV_WGU + CV_LATE, (c - 208) * NWAVES + F.wave, 48 * NWAVES, F_LANE);
    }
    SEAM(PH_P1);
    MEGA_TOKEN_MIXER_PHASES
    if (IN(PH_MIX)) {
        bf16* MIXED = (bf16*)(ws + WS_MIXED);
        const bf16* WGATE = (const bf16*)(ws + WS_WGATE); const bf16* WA = (const bf16*)(ws + WS_WA); const bf16* WB = (const bf16*)(ws + WS_WB); const bf16* WC = (const bf16*)(ws + WS_WC); const bf16* HA = Z + Z_MO;
        pg8::StaticOrder S; S.init(M, 1024, F.G, c);
        pg8::StaticOrder Sg0; Sg0.init(M, 1024, F.G, c, 0); pg8::StaticOrder Sg1; Sg1.init(M, 1024, F.G, c, 4); pg8::StaticOrder Sg2; Sg2.init(M, 1024, F.G, c, 8);
        pg8::Unit u0;
        if (S.next(0, u0)) {
            const size_t pm = (size_t)u0.pm * 256, pn = (size_t)u0.pn * 256;
            const pg8::Chain cA{HA + pm * ZW, WA + pn * 512, ZW, 512}, cG0{XN + pm * 1024, WGATE + pn * 1024, 1024, 1024}, cB{Z + Z_DQ + pm * ZW, WB + pn * 256, ZW, 256},
                             cG2{XN + pm * 1024, WGATE + (2048 + pn) * 1024, 1024, 1024}, cC{Z + Z_XQ + pm * ZW, WC + pn * 512, ZW, 512};
            { pg8::Gemm g{XN, WGATE, 1024, 1024, nullptr}; pg8::EpiGate E{GS, args.in[18] + 1024};
              pg8::gemm_phase<pg8::EpiGate, pg8::StaticOrder, true, false, 2>(F.lds, g, Sg1, E, F.wave, cB); }
            split_wait(bar, 2, F_TID);
            { pg8::Gemm g{Z + Z_DQ, WB, ZW, 256, nullptr}; pg8::EpiMix<0> E{GS, MIXED};
              pg8::gemm_phase<pg8::EpiMix<0>, pg8::StaticOrder, true, false, 3>(F.lds, g, S, E, F.wave, cG2); }
            { pg8::Gemm g{XN, WGATE, 1024, 1024, nullptr}; pg8::EpiGate E{GS, args.in[18] + 2048};
              pg8::gemm_phase<pg8::EpiGate, pg8::StaticOrder, true, false, 3>(F.lds, g, Sg2, E, F.wave, cC); }
            { pg8::Gemm g{Z + Z_XQ, WC, ZW, 512, nullptr}; pg8::EpiMix<1> E{GS, MIXED};
              pg8::gemm_phase<pg8::EpiMix<1>, pg8::StaticOrder, true, false, 3>(F.lds, g, S, E, F.wave, cG0); }
            { pg8::Gemm g{XN, WGATE, 1024, 1024, nullptr}; pg8::EpiGate E{GS, args.in[18]};
              pg8::gemm_phase<pg8::EpiGate, pg8::StaticOrder, true, false, 3>(F.lds, g, Sg0, E, F.wave, cA); }
            { pg8::Gemm g{HA, WA, ZW, 512, nullptr}; pg8::EpiMix<2> E{GS, MIXED};
              pg8::gemm_phase<pg8::EpiMix<2>, pg8::StaticOrder, true, false, 1>(F.lds, g, S, E, F.wave); }
        }
    }
    SEAM(PH_MIX);
    if (IN(PH_WOUT)) {
        pg8::StaticOrder S; S.init(M, 1024, F.G, c);
        pg8::Gemm g{GS, (const bf16*)(ws + WS_WOUT), 1024, 1024, nullptr}; pg8::EpiRes E{args.in[0], (float*)(ws + WS_H1)};
        pg8::gemm_phase<pg8::EpiRes, pg8::StaticOrder, false, false>(F.lds, g, S, E, F.wave);
    }
    split_arrive(bar, 3, F_TID);
    MEGA_MOE_PHASES
#undef IN
#undef SEAM
}

extern "C" void kernel_launch(void* const* d_in, const int* in_sizes, int n_in, void* d_out, int out_size, void* d_ws, size_t ws_size, hipStream_t stream) {
    static int grid = 0;
    if (grid == 0) {
        if (n_in != 28 || out_size != M * D || ws_size < WS_END) { fprintf(stderr, "kernel_launch: unexpected shapes n_in %d out %d ws %zu\n", n_in, out_size, ws_size); grid = -1; return; }
        int dev = 0, cus = 0;
        if (hipGetDevice(&dev) != hipSuccess || hipDeviceGetAttribute(&cus, hipDeviceAttributeMultiprocessorCount, dev) != hipSuccess) { grid = -1; return; }
        if (hipFuncSetAttribute((const void*)mega_fwd, hipFuncAttributeMaxDynamicSharedMemorySize, LDS_BYTES) != hipSuccess) { fprintf(stderr, "kernel_launch: hipFuncSetAttribute failed\n"); grid = -1; return; }
        grid = cus;
    }
    if (grid < 0) return;
    (void)hipMemsetAsync((unsigned char*)d_ws + WS_CTL, 0, 1 * MiB, stream);
    Args a{};
    for (int i = 0; i < 28; ++i) a.in[i] = (const float*)d_in[i];
    a.out = (float*)d_out; a.ws = (unsigned char*)d_ws; a.ph_lo = 0; a.ph_hi = PH_END; a.li = 0; a.pad = 0;
    hipLaunchKernelGGL(mega_fwd, dim3(grid), dim3(NWAVES * 64), LDS_BYTES, stream, a);
}
```

```cpp
#include <hip/hip_runtime.h>
#include <cstdio>
#include <cstdint>
#include <cmath>

constexpr int D = 1024, BATCH = 4, SEQ = 4096, M = BATCH * SEQ;
constexpr int MEM_LEN = 256, MROWS = BATCH * MEM_LEN;
constexpr float EPS = 1e-6f;
constexpr int IN_TOTAL = 4872;
constexpr int ZW = 4864;
constexpr int Z_MQ = 0, Z_MK = 512, Z_MV = 1024, Z_MO = 1536, Z_DQ = 2048, Z_DK = 2816, Z_DV = 3584, Z_XQ = 4352;
constexpr int NCHUNK = SEQ / 128;
typedef unsigned short bf16;

constexpr size_t MiB = 1u << 20;
constexpr size_t WS_CTL = 0;
constexpr size_t WS_IFG = 1 * MiB;
constexpr size_t WS_LSE = 2 * MiB;
constexpr size_t WS_MSC = 3 * MiB;
constexpr size_t WS_NL = 3 * MiB + 64 * 1024;
constexpr size_t WS_WGATE = 8 * MiB;
constexpr size_t WS_WA = 14 * MiB;
constexpr size_t WS_WB = 15 * MiB;
constexpr size_t WS_WC = 16 * MiB;
constexpr size_t WS_WOUT = 17 * MiB;
constexpr size_t WS_HA = 19 * MiB;
constexpr size_t WS_Z = 35 * MiB;
constexpr size_t WS_CL = 187 * MiB;
constexpr size_t WS_W1Z = 219 * MiB;
constexpr size_t WS_WKV = 229 * MiB;
constexpr size_t WS_MEMN = 231 * MiB;
constexpr size_t WS_KVM = 251 * MiB;
constexpr size_t WS_MIXED = 187 * MiB;
constexpr size_t WS_END = 253 * MiB;

__device__ __forceinline__ unsigned f2bf(float f) { unsigned u = __float_as_uint(f); return (u + 0x7fffu + ((u >> 16) & 1u)) >> 16; }
__device__ __forceinline__ float bf2f(bf16 h) { return __uint_as_float(((unsigned)h) << 16); }
#define DPP_F(v, ctrl, rmask) __builtin_bit_cast(float, __builtin_amdgcn_update_dpp(0, __builtin_bit_cast(int, (v)), (ctrl), (rmask), 0xf, false))
__device__ __forceinline__ float wave_sum(float v) {
    v += DPP_F(v, 0xB1, 0xf); v += DPP_F(v, 0x4E, 0xf); v += DPP_F(v, 0x141, 0xf); v += DPP_F(v, 0x140, 0xf);
    v += DPP_F(v, 0x142, 0xa); v += DPP_F(v, 0x143, 0xc);
    return __builtin_bit_cast(float, __builtin_amdgcn_readlane(__builtin_bit_cast(int, v), 63));
}
#define DPP_FM(v, ctrl, rmask) __builtin_bit_cast(float, __builtin_amdgcn_update_dpp(__builtin_bit_cast(int, (v)), __builtin_bit_cast(int, (v)), (ctrl), (rmask), 0xf, false))
__device__ __forceinline__ float wave_max(float v) {
    v = fmaxf(v, DPP_FM(v, 0xB1, 0xf)); v = fmaxf(v, DPP_FM(v, 0x4E, 0xf)); v = fmaxf(v, DPP_FM(v, 0x141, 0xf)); v = fmaxf(v, DPP_FM(v, 0x140, 0xf));
    v = fmaxf(v, DPP_FM(v, 0x142, 0xa)); v = fmaxf(v, DPP_FM(v, 0x143, 0xc));
    return __builtin_bit_cast(float, __builtin_amdgcn_readlane(__builtin_bit_cast(int, v), 63));
}
__device__ __forceinline__ float sigmoidf_(float x) { return 1.f / (1.f + __expf(-x)); }
__device__ __forceinline__ float siluf_(float x) { return x / (1.f + __expf(-x)); }
__device__ __forceinline__ float log_sigmoid_(float x) { return fminf(x, 0.f) - log1pf(__expf(-fabsf(x))); }

namespace pg8 {
#define PG8_LAS __attribute__((address_space(3)))
typedef unsigned short bf16_t;
typedef short bf16x8 __attribute__((ext_vector_type(8)));
typedef float f32x4 __attribute__((ext_vector_type(4)));
typedef unsigned u32x4 __attribute__((ext_vector_type(4)));
constexpr int BM = 256, BK = 64, HALF = 128, HTB = HALF * BK * 2  , STAGE_BYTES = 8 * HTB, NXCD = 8, WGM = 8;

__host__ __device__ __forceinline__ int lds_byte(int r, int c) { const int st = (r >> 4) * 2 + (c >> 5), rr = r & 15, cc = c & 31, ob = rr * 64 + cc * 2; return st * 1024 + (ob ^ (((ob >> 9) & 1) << 5)); }
__host__ __device__ __forceinline__ void stage_rc(int b, int& R, int& C) { const int st = b / 1024, sb = b % 1024, swz = sb ^ (((sb >> 9) & 1) << 5); R = (st >> 1) * 16 + swz / 64; C = (st & 1) * 32 + (swz % 64) / 2; }
__host__ __device__ __forceinline__ int perm32(int rho) { const int n = rho >> 4, i = rho & 15; return 8 * (i >> 2) + 4 * n + (i & 3); }

struct Unit { int pm, pn, bt, aux; };
struct Gemm { const bf16_t* A; const bf16_t* Bt; int lda, K; const int* rowidx; };

struct StaticOrder {
    int nM, nN, nwg, G, c, btoff;
    __host__ __device__ __forceinline__ void init(int M, int N, int G_, int c_, int btoff_ = 0) { nM = M / BM; nN = N / BM; nwg = nM * nN; G = G_; c = c_; btoff = btoff_; }
    __host__ __device__ __forceinline__ bool next(int i, Unit& u) const {
        const long L = (long)i * G + c; if (L >= nwg) return false;
        int wgid = (int)L; { const int q = nwg / NXCD, r = nwg % NXCD, xcd = wgid % NXCD, off = wgid / NXCD; wgid = (xcd < r ? xcd * (q + 1) : r * (q + 1) + (xcd - r) * q) + off; }
        const int nig = WGM * nN, gid = wgid / nig, fm = gid * WGM, gsz = (nM - fm) < WGM ? (nM - fm) : WGM;
        u.pm = fm + ((wgid % nig) % gsz); u.pn = (wgid % nig) / gsz; u.bt = u.pn + btoff; u.aux = 0; return true;
    }
};

typedef __bf16 bf16x2_t __attribute__((ext_vector_type(2)));
typedef float f32x2_t __attribute__((ext_vector_type(2)));
__device__ __forceinline__ unsigned cvt_pk_bf16(float lo, float hi) { const f32x2_t v = {lo, hi}; const bf16x2_t r = __builtin_convertvector(v, bf16x2_t); return __builtin_bit_cast(unsigned, r); }


struct Chain { const bf16_t* A; const bf16_t* Bt; int lda, K; };
template <class Epi, class Sched, bool ALIGN_EPI, bool GATHER, int CH = 0>
__device__ __forceinline__ void gemm_phase(PG8_LAS unsigned char* lds, const Gemm g, const Sched& S, const Epi& E, int wave_id, const Chain nx = Chain{nullptr, nullptr, 0, 0}) {
    int tid_; { int l; asm volatile("v_mbcnt_lo_u32_b32 %0, -1, 0\n\tv_mbcnt_hi_u32_b32 %0, -1, %0" : "=v"(l)); tid_ = wave_id * 64 + l; }
    const int tid = tid_, wid = wave_id, lane = tid & 63, wr = wid >> 2, wc = wid & 3, fr = lane & 15, fq = lane >> 4;
    const int K = g.K, nt = K / BK, lda = g.lda;
    unsigned voffA[2], voffB[2]; int RA[2], CA[2];
#pragma unroll
    for (int i = 0; i < 2; ++i) { int R, C; stage_rc(tid * 16 + i * 8192, R, C); const int Rb = Epi::PERM ? ((R & ~31) + perm32(R & 31)) : R;
        RA[i] = R; CA[i] = C; voffA[i] = (unsigned)(R * lda + C) * 2u; voffB[i] = (unsigned)(Rb * K + C) * 2u; }
    unsigned voffA_n[2], voffB_n[2]; size_t hstepA_n = 0, hstepB_n = 0;
    if constexpr ((CH & 2) != 0) {
#pragma unroll
        for (int i = 0; i < 2; ++i) { const int Rb = (RA[i] & ~31) + perm32(RA[i] & 31); voffA_n[i] = (unsigned)(RA[i] * nx.lda + CA[i]) * 2u; voffB_n[i] = (unsigned)(Rb * nx.K + CA[i]) * 2u; }
        hstepA_n = (size_t)HALF * nx.lda * 2; hstepB_n = (size_t)HALF * nx.K * 2;
    }
    const size_t kstep = (size_t)(BK * 2);
    const size_t hstepA = (size_t)HALF * lda * 2, tstepA = 2 * hstepA;
    const size_t hstepB = (size_t)HALF * K * 2, tstepB = 2 * hstepB;
    const unsigned ldsw = (unsigned)wid * 1024u;
    const int aoff = lds_byte(wr * 64 + fr, fq * 8), boff = lds_byte(wc * 32 + fr, fq * 8);
#define PG8_SA(b, h) (((b) * 2 + (h)) * HTB)
#define PG8_SB(b, h) ((4 + (b) * 2 + (h)) * HTB)
#define PG8_STAGE(bufoff, gbase, voff) do { _Pragma("unroll") for (int _i = 0; _i < 2; ++_i) \
        __builtin_amdgcn_global_load_lds((const unsigned*)((const char*)(gbase) + (voff)[_i]), (PG8_LAS unsigned*)(lds + (bufoff) + ldsw + _i * 8192), 16, 0, 0); } while (0)
#define PG8_LDA(dst, b, h) do { _Pragma("unroll") for (int m = 0; m < 4; ++m) _Pragma("unroll") for (int k = 0; k < 2; ++k) dst[m][k] = *(const PG8_LAS bf16x8*)(lds + PG8_SA(b, h) + aoff + m * 2048 + k * 1024); } while (0)
#define PG8_LDB(dst, b, h) do { _Pragma("unroll") for (int n = 0; n < 2; ++n) _Pragma("unroll") for (int k = 0; k < 2; ++k) dst[n][k] = *(const PG8_LAS bf16x8*)(lds + PG8_SB(b, h) + boff + n * 2048 + k * 1024); } while (0)
#define PG8_MMA(ai, bj, At, Bt) do { __builtin_amdgcn_s_setprio(1); _Pragma("unroll") for (int m = 0; m < 4; ++m) _Pragma("unroll") for (int n = 0; n < 2; ++n) _Pragma("unroll") for (int k = 0; k < 2; ++k) \
        acc[ai][bj][m][n] = __builtin_amdgcn_mfma_f32_16x16x32_bf16(Bt[n][k], At[m][k], acc[ai][bj][m][n], 0, 0, 0); __builtin_amdgcn_s_setprio(0); } while (0)
#define PG8_WAIT_V(n) asm volatile("s_waitcnt vmcnt(" #n ")" ::: "memory")
#define PG8_WAIT_L(n) asm volatile("s_waitcnt lgkmcnt(" #n ")" ::: "memory")
#define PG8_BAR __builtin_amdgcn_s_barrier()
#define PG8_SCHED __builtin_amdgcn_sched_barrier(0)
    Unit cur, nxt; int ui = 0;
    if (!S.next(0, cur)) return;
    f32x4 acc[2][2][4][2];
#pragma unroll
    for (int a = 0; a < 2; ++a)
#pragma unroll
        for (int b = 0; b < 2; ++b)
#pragma unroll
            for (int m = 0; m < 4; ++m)
#pragma unroll
                for (int n = 0; n < 2; ++n) acc[a][b][m][n] = (f32x4){0.f, 0.f, 0.f, 0.f};
    bf16x8 At[4][2], B0[2][2], B1[2][2];
    unsigned gAc[2][2], gAn[2][2];
    if constexpr (GATHER) {
#pragma unroll
        for (int h = 0; h < 2; ++h)
#pragma unroll
            for (int i = 0; i < 2; ++i) { unsigned _r = (unsigned)g.rowidx[cur.pm * BM + h * HALF + RA[i]]; _r = _r < 16384u ? _r : 0u; gAc[h][i] = (_r * (unsigned)lda + (unsigned)CA[i]) * 2u; }
    }
    const char* cA = GATHER ? (const char*)g.A : (const char*)g.A + (size_t)cur.pm * tstepA; const char* cB = (const char*)g.Bt + (size_t)cur.bt * tstepB;
#define PG8_STAGE_A(bufoff, p, h, useN) do { if constexpr (GATHER) { unsigned _v[2]; _v[0] = (useN) ? gAn[h][0] : gAc[h][0]; _v[1] = (useN) ? gAn[h][1] : gAc[h][1]; PG8_STAGE(bufoff, p, _v); } \
        else if constexpr ((CH & 2) != 0) { unsigned _v[2]; _v[0] = ((useN) && chain_now) ? voffA_n[0] : voffA[0]; _v[1] = ((useN) && chain_now) ? voffA_n[1] : voffA[1]; \
            PG8_STAGE(bufoff, (p) + (h) * (((useN) && chain_now) ? hstepA_n : hstepA), _v); } \
        else { PG8_STAGE(bufoff, (p) + (h) * hstepA, voffA); } } while (0)
#define PG8_STAGE_B(bufoff, p, h, useN) do { if constexpr ((CH & 2) != 0) { unsigned _v[2]; _v[0] = ((useN) && chain_now) ? voffB_n[0] : voffB[0]; _v[1] = ((useN) && chain_now) ? voffB_n[1] : voffB[1]; \
            PG8_STAGE(bufoff, (p) + (h) * (((useN) && chain_now) ? hstepB_n : hstepB), _v); } \
        else { PG8_STAGE(bufoff, (p) + (h) * hstepB, voffB); } } while (0)
    bool chain_now = false;
    if constexpr ((CH & 1) == 0) {
    PG8_STAGE(PG8_SB(0, 0), cB, voffB); PG8_STAGE(PG8_SB(0, 1), cB + hstepB, voffB); PG8_STAGE_A(PG8_SA(0, 0), cA, 0, false); PG8_STAGE_A(PG8_SA(0, 1), cA, 1, false);
    if (wr == 1) PG8_BAR;
    PG8_WAIT_V(2); PG8_BAR;
    PG8_STAGE(PG8_SB(1, 0), cB + kstep, voffB); PG8_STAGE_A(PG8_SA(1, 0), cA + kstep, 0, false); PG8_STAGE(PG8_SB(1, 1), cB + hstepB + kstep, voffB);
    PG8_WAIT_V(6); PG8_BAR;
    }
    for (;;) {
        const bool has_next = S.next(ui + 1, nxt);
        const char* nA = GATHER ? (const char*)g.A : (has_next ? (const char*)g.A + (size_t)nxt.pm * tstepA : (((CH & 2) != 0) ? (const char*)nx.A : cA)); const char* nB = has_next ? (const char*)g.Bt + (size_t)nxt.bt * tstepB : (((CH & 2) != 0) ? (const char*)nx.Bt : cB);
        if constexpr ((CH & 2) != 0) chain_now = !has_next;
        if constexpr (GATHER) {
#pragma unroll
            for (int h = 0; h < 2; ++h)
#pragma unroll
                for (int i = 0; i < 2; ++i) { unsigned _r = has_next ? (unsigned)g.rowidx[nxt.pm * BM + h * HALF + RA[i]] : 0u; _r = _r < 16384u ? _r : 0u; gAn[h][i] = has_next ? (_r * (unsigned)lda + (unsigned)CA[i]) * 2u : gAc[h][i]; }
        }
        for (int t = 0; t < nt; t += 2) {
            const bool last = (t == nt - 2);
            const char* a1 = cA + (size_t)(t + 1) * kstep;
            const char* a2 = last ? nA : cA + (size_t)(t + 2) * kstep; const char* b2 = last ? nB : cB + (size_t)(t + 2) * kstep;
            const char* a3 = a2 + kstep; const char* b3 = b2 + kstep;
            PG8_LDB(B0, 0, 0); PG8_LDB(B1, 0, 1); PG8_SCHED; PG8_LDA(At, 0, 0); PG8_STAGE_A(PG8_SA(1, 1), a1, 1, false);
            PG8_WAIT_V(8); PG8_WAIT_L(0); PG8_BAR; PG8_MMA(0, 0, At, B0); PG8_MMA(0, 1, At, B1); PG8_BAR; PG8_SCHED;
            PG8_LDA(At, 0, 1); PG8_STAGE_B(PG8_SB(0, 0), b2, 0, last); PG8_STAGE_B(PG8_SB(0, 1), b2, 1, last); PG8_STAGE_A(PG8_SA(0, 0), a2, 0, last);
            PG8_WAIT_V(8); PG8_WAIT_L(0); PG8_BAR; PG8_MMA(1, 0, At, B0); PG8_MMA(1, 1, At, B1); PG8_BAR; PG8_SCHED;
            PG8_LDB(B0, 1, 0); PG8_LDB(B1, 1, 1); PG8_SCHED; PG8_LDA(At, 1, 0); PG8_STAGE_A(PG8_SA(0, 1), a2, 1, last);
            PG8_WAIT_V(8); PG8_WAIT_L(0); PG8_BAR; PG8_MMA(0, 0, At, B0); PG8_MMA(0, 1, At, B1); PG8_BAR; PG8_SCHED;
            PG8_LDA(At, 1, 1); PG8_STAGE_B(PG8_SB(1, 0), b3, 0, last); PG8_STAGE_B(PG8_SB(1, 1), b3, 1, last); PG8_STAGE_A(PG8_SA(1, 0), a3, 0, last);
            PG8_WAIT_V(8); PG8_WAIT_L(0); PG8_BAR; PG8_MMA(1, 0, At, B0); PG8_MMA(1, 1, At, B1); PG8_BAR; PG8_SCHED;
        }
        if constexpr (ALIGN_EPI) { if (wr == 0) PG8_BAR; }
        E(acc, cur, wr, wc, fr, fq);
        if (!has_next) { if constexpr ((CH & 2) != 0) { if constexpr (ALIGN_EPI) { if (wr == 1) PG8_BAR; } return; } break; }
#pragma unroll
        for (int a = 0; a < 2; ++a)
#pragma unroll
            for (int b = 0; b < 2; ++b)
#pragma unroll
                for (int m = 0; m < 4; ++m)
#pragma unroll
                    for (int n = 0; n < 2; ++n) acc[a][b][m][n] = (f32x4){0.f, 0.f, 0.f, 0.f};
        cur = nxt; cA = nA; cB = nB; ++ui;
        if constexpr (GATHER) {
#pragma unroll
            for (int h = 0; h < 2; ++h)
#pragma unroll
                for (int i = 0; i < 2; ++i) gAc[h][i] = gAn[h][i];
        }
        if constexpr (ALIGN_EPI) { if (wr == 1) PG8_BAR; }
    }
    PG8_WAIT_V(0);
    if constexpr (!ALIGN_EPI) { if (wr == 0) PG8_BAR; }
    PG8_BAR;
#undef PG8_SA
#undef PG8_SB
#undef PG8_STAGE
#undef PG8_STAGE_A
#undef PG8_STAGE_B
#undef PG8_LDA
#undef PG8_LDB
#undef PG8_MMA
#undef PG8_WAIT_V
#undef PG8_WAIT_L
#undef PG8_BAR
#undef PG8_SCHED
}
}
namespace pg8 {
struct EpiStoreBf16 {
    static constexpr bool PERM = true; static constexpr int SID = 1;
    bf16_t* O; int ldc;
    __device__ __forceinline__ void operator()(const f32x4 (&acc)[2][2][4][2], const Unit& u, int wr, int wc, int fr, int fq) const {
        const int row0 = u.pm * BM + wr * 64 + fr, col0 = u.pn * BM + wc * 32 + 8 * fq;
#pragma unroll
        for (int ai = 0; ai < 2; ++ai)
#pragma unroll
            for (int m = 0; m < 4; ++m) { bf16_t* rowp = O + (size_t)(row0 + ai * HALF + m * 16) * ldc + col0;
#pragma unroll
                for (int bj = 0; bj < 2; ++bj) { const f32x4 v0 = acc[ai][bj][m][0], v1 = acc[ai][bj][m][1];
                    u32x4 w; w.x = cvt_pk_bf16(v0[0], v0[1]); w.y = cvt_pk_bf16(v0[2], v0[3]); w.z = cvt_pk_bf16(v1[0], v1[1]); w.w = cvt_pk_bf16(v1[2], v1[3]);
                    *(u32x4*)(rowp + bj * HALF) = w; } }
    }
};
__device__ __forceinline__ float fast_sigmoid(float x) { return __builtin_amdgcn_rcpf(1.f + __builtin_amdgcn_exp2f(-1.4426950408889634f * x)); }
struct EpiGate {
    static constexpr bool PERM = true; static constexpr int SID = 2;
    bf16_t* O; const float* bias;
    __device__ __forceinline__ void operator()(const f32x4 (&acc)[2][2][4][2], const Unit& u, int wr, int wc, int fr, int fq) const {
        const int row0 = u.pm * BM + wr * 64 + fr, col0 = u.pn * BM + wc * 32 + 8 * fq;
        f32x4 bv[2][2];
#pragma unroll
        for (int bj = 0; bj < 2; ++bj)
#pragma unroll
            for (int n = 0; n < 2; ++n) bv[bj][n] = *(const f32x4*)(bias + col0 + bj * HALF + 4 * n);
#pragma unroll
        for (int ai = 0; ai < 2; ++ai)
#pragma unroll
            for (int m = 0; m < 4; ++m) { bf16_t* rowp = O + (size_t)(row0 + ai * HALF + m * 16) * 1024 + col0;
#pragma unroll
                for (int bj = 0; bj < 2; ++bj) { f32x4 v0 = acc[ai][bj][m][0] + bv[bj][0], v1 = acc[ai][bj][m][1] + bv[bj][1];
#pragma unroll
                    for (int j = 0; j < 4; ++j) { v0[j] = fast_sigmoid(v0[j]); v1[j] = fast_sigmoid(v1[j]); }
                    u32x4 w; w.x = cvt_pk_bf16(v0[0], v0[1]); w.y = cvt_pk_bf16(v0[2], v0[3]); w.z = cvt_pk_bf16(v1[0], v1[1]); w.w = cvt_pk_bf16(v1[2], v1[3]);
                    *(u32x4*)(rowp + bj * HALF) = w; } }
    }
};
__device__ __forceinline__ float bflo(unsigned w) { return __uint_as_float(w << 16); }
__device__ __forceinline__ float bfhi(unsigned w) { return __uint_as_float(w & 0xffff0000u); }
template <int MODE>
struct EpiMix {
    static constexpr bool PERM = true; static constexpr int SID = 30 + MODE;
    bf16_t* GS; bf16_t* MIXED;
    __device__ __forceinline__ void operator()(const f32x4 (&acc)[2][2][4][2], const Unit& u, int wr, int wc, int fr, int fq) const {
        const int row0 = u.pm * BM + wr * 64 + fr, col0 = u.pn * BM + wc * 32 + 8 * fq;
        u32x4 gw[4][2], pw[4][2];
#pragma unroll
        for (int m = 0; m < 4; ++m)
#pragma unroll
            for (int bj = 0; bj < 2; ++bj) { const size_t o = (size_t)(row0 + m * 16) * 1024 + col0 + bj * HALF;
                gw[m][bj] = *(const u32x4*)(GS + o); if (MODE != 0) pw[m][bj] = *(const u32x4*)(MIXED + o); }
#pragma unroll
        for (int ai = 0; ai < 2; ++ai) {
#pragma unroll
            for (int m = 0; m < 4; ++m)
#pragma unroll
                for (int bj = 0; bj < 2; ++bj) { const u32x4 g = gw[m][bj]; const size_t o = (size_t)(row0 + ai * HALF + m * 16) * 1024 + col0 + bj * HALF;
                    f32x4 t0, t1;
                    t0[0] = bflo(g.x) * acc[ai][bj][m][0][0]; t0[1] = bfhi(g.x) * acc[ai][bj][m][0][1]; t0[2] = bflo(g.y) * acc[ai][bj][m][0][2]; t0[3] = bfhi(g.y) * acc[ai][bj][m][0][3];
                    t1[0] = bflo(g.z) * acc[ai][bj][m][1][0]; t1[1] = bfhi(g.z) * acc[ai][bj][m][1][1]; t1[2] = bflo(g.w) * acc[ai][bj][m][1][2]; t1[3] = bfhi(g.w) * acc[ai][bj][m][1][3];
                    if (MODE != 0) { const u32x4 p = pw[m][bj];
                        t0[0] += bflo(p.x); t0[1] += bfhi(p.x); t0[2] += bflo(p.y); t0[3] += bfhi(p.y); t1[0] += bflo(p.z); t1[1] += bfhi(p.z); t1[2] += bflo(p.w); t1[3] += bfhi(p.w); }
                    u32x4 w; w.x = cvt_pk_bf16(t0[0], t0[1]); w.y = cvt_pk_bf16(t0[2], t0[3]); w.z = cvt_pk_bf16(t1[0], t1[1]); w.w = cvt_pk_bf16(t1[2], t1[3]);
                    if (MODE != 2) *(u32x4*)(MIXED + o) = w; else *(u32x4*)(GS + o) = w;
                    if (ai == 0) { gw[m][bj] = *(const u32x4*)(GS + o + (size_t)HALF * 1024); if (MODE != 0) pw[m][bj] = *(const u32x4*)(MIXED + o + (size_t)HALF * 1024); }
                    asm volatile("" ::: "memory"); }
        }
    }
};
struct EpiRes {
    static constexpr bool PERM = false; static constexpr int SID = 4;
    const float* x; float* out;
    __device__ __forceinline__ void operator()(const f32x4 (&acc)[2][2][4][2], const Unit& u, int wr, int wc, int fr, int fq) const {
        const int row0 = u.pm * BM + wr * 64 + fr, col0 = u.pn * BM + wc * 32 + 4 * fq;
        f32x4 xa[2][2][2], xb[2][2][2];
#define EPIRES_LOAD(dst, ai, mp) do { _Pragma("unroll") for (int mm = 0; mm < 2; ++mm) _Pragma("unroll") for (int bj = 0; bj < 2; ++bj) _Pragma("unroll") for (int n = 0; n < 2; ++n) \
            dst[mm][bj][n] = *(const f32x4*)(x + (size_t)(row0 + (ai) * HALF + (2 * (mp) + mm) * 16) * 1024 + col0 + bj * HALF + n * 16); } while (0)
#define EPIRES_STORE(src, ai, mp) do { _Pragma("unroll") for (int mm = 0; mm < 2; ++mm) _Pragma("unroll") for (int bj = 0; bj < 2; ++bj) _Pragma("unroll") for (int n = 0; n < 2; ++n) \
            *(f32x4*)(out + (size_t)(row0 + (ai) * HALF + (2 * (mp) + mm) * 16) * 1024 + col0 + bj * HALF + n * 16) = src[mm][bj][n] + acc[ai][bj][2 * (mp) + mm][n]; } while (0)
        EPIRES_LOAD(xa, 0, 0); EPIRES_LOAD(xb, 0, 1); asm volatile("" ::: "memory");
        EPIRES_STORE(xa, 0, 0); asm volatile("" ::: "memory"); EPIRES_LOAD(xa, 1, 0); asm volatile("" ::: "memory");
        EPIRES_STORE(xb, 0, 1); asm volatile("" ::: "memory"); EPIRES_LOAD(xb, 1, 1); asm volatile("" ::: "memory");
        EPIRES_STORE(xa, 1, 0); asm volatile("" ::: "memory");
        EPIRES_STORE(xb, 1, 1); asm volatile("" ::: "memory");
#undef EPIRES_LOAD
#undef EPIRES_STORE
    }
};
}
constexpr int NWAVES = 8;
constexpr int SCR_BYTES = 146432;
constexpr int LDSCTL_OFF = SCR_BYTES, MISC_OFF = LDSCTL_OFF + 320;
constexpr int LDS_BYTES = 147456;
#define GAS __attribute__((address_space(1)))
#define LAS __attribute__((address_space(3)))
typedef unsigned v4u __attribute__((ext_vector_type(4)));
typedef float f32x4 __attribute__((ext_vector_type(4)));
typedef short bf16x8 __attribute__((ext_vector_type(8)));
typedef short s16x4 __attribute__((ext_vector_type(4)));
typedef GAS unsigned gu32;
#define RLX_AGENT __ATOMIC_RELAXED, __HIP_MEMORY_SCOPE_AGENT
#define LDS_WAIT() asm volatile("s_waitcnt lgkmcnt(0)" ::: "memory")
#define VM_WAIT() asm volatile("s_waitcnt vmcnt(0)" ::: "memory")
__device__ __forceinline__ int lane_id() { int l; asm volatile("v_mbcnt_lo_u32_b32 %0, -1, 0\n\tv_mbcnt_hi_u32_b32 %0, -1, %0" : "=v"(l)); return l; }
__device__ __forceinline__ unsigned pk2(float lo, float hi) { return pg8::cvt_pk_bf16(lo, hi); }

constexpr int CW_BAR = 4096;
constexpr int CW_ECNT = 32768;

#define XB_TMO      128
#define XB_XCNT(j)  (256  + 64 * (j))
#define XB_XSUB(j)  (1280 + 64 * (j))
#define XB_XGEN(j)  (2304 + 64 * (j))
#define XB_TOP      3328
#define XB_TOPGEN   3392
#define XCD_BAR_WORDS 3456
#define XB_SPIN_CAP (1u << 18)
__device__ __forceinline__ unsigned xb_ld(unsigned* p)              { return __hip_atomic_load(p, __ATOMIC_RELAXED, __HIP_MEMORY_SCOPE_AGENT); }
__device__ __forceinline__ unsigned xb_add(unsigned* p, unsigned v) { return __hip_atomic_fetch_add(p, v, __ATOMIC_RELAXED, __HIP_MEMORY_SCOPE_AGENT); }
__device__ __forceinline__ unsigned xb_xcc_id() { return (unsigned)__builtin_amdgcn_s_getreg((3 << 11) | 20) & 0xFu; }
#define XB_SPIN(cond, bar) do { unsigned _sp = 0; while (cond) { __builtin_amdgcn_s_sleep(1); \
    if ((++_sp & 255u) == 0u) { if (xb_ld(&(bar)[XB_TMO])) break; if (_sp > XB_SPIN_CAP) { atomicAdd(&(bar)[XB_TMO], 1u); break; } } } } while (0)
struct XcdBarrier { unsigned* bar; unsigned x; volatile LAS unsigned* st; };
__device__ __forceinline__ XcdBarrier xcd_barrier_post(unsigned* bar, volatile LAS unsigned* st, int tid) {
    XcdBarrier b; b.bar = bar; b.x = xb_xcc_id(); b.st = st;
    if (tid == 0) (void)xb_add(&bar[XB_XCNT(b.x)], 1u);
    return b;
}
__device__ __forceinline__ void xcd_barrier_complete(unsigned* bar, unsigned x, unsigned& nloc, unsigned& nx) {
    const unsigned G = gridDim.x * gridDim.y * gridDim.z;
    unsigned sum, cnt, mine, sp = 0u;
    for (;;) {
        sum = 0u; cnt = 0u; mine = 0u;
#pragma unroll
        for (unsigned j = 0; j < 16; ++j) { const unsigned c = xb_ld(&bar[XB_XCNT(j)]); sum += c; cnt += (c > 0u) ? 1u : 0u; mine = (j == x) ? c : mine; }
        if (sum == G) break;
        __builtin_amdgcn_s_sleep(1);
        if ((++sp & 255u) == 0u) { if (xb_ld(&bar[XB_TMO])) break; if (sp > XB_SPIN_CAP) { atomicAdd(&bar[XB_TMO], 1u); break; } }
    }
    nloc = mine > 0u ? mine : 1u; nx = cnt > 0u ? cnt : 1u;
}
__device__ __forceinline__ void xcd_barrier(const XcdBarrier& b, int tid) {
    asm volatile("s_waitcnt vmcnt(0)" ::: "memory");
    __syncthreads();
    if (tid == 0) {
        unsigned* bar = b.bar;
        __builtin_amdgcn_s_waitcnt(0);
        unsigned nloc = b.st[0], nx = b.st[1];
        if (nloc == 0u) { xcd_barrier_complete(bar, b.x, nloc, nx); b.st[0] = nloc; b.st[1] = nx; }
        const unsigned old = xb_add(&bar[XB_XSUB(b.x)], 1u);
        const unsigned gen = old / nloc;
        if (old + 1u == (gen + 1u) * nloc) {
            __builtin_amdgcn_fence(__ATOMIC_RELEASE, "agent");
            asm volatile("s_waitcnt vmcnt(0)" ::: "memory");
            const unsigned og = xb_add(&bar[XB_TOP], 1u);
            const unsigned tg = og / nx;
            if (og + 1u == (tg + 1u) * nx) xb_add(&bar[XB_TOPGEN], 1u);
            else XB_SPIN(xb_ld(&bar[XB_TOPGEN]) == tg, bar);
            __builtin_amdgcn_fence(__ATOMIC_ACQUIRE, "agent");
            xb_add(&bar[XB_XGEN(b.x)], 1u);
            asm volatile("s_waitcnt vmcnt(0)" ::: "memory");
        } else {
            XB_SPIN(xb_ld(&bar[XB_XGEN(b.x)]) == gen, bar);
            __builtin_amdgcn_fence(__ATOMIC_ACQUIRE, "agent");
            asm volatile("s_waitcnt vmcnt(0)" ::: "memory");
        }
    }
    __syncthreads();
}

constexpr int CW_SPLIT_REL = 65536 - CW_BAR;
__device__ __forceinline__ void split_arrive(const XcdBarrier& b, int inst, int tid) {
    asm volatile("s_waitcnt vmcnt(0)" ::: "memory");
    __syncthreads();
    if (tid == 0) {
        unsigned* w = b.bar + CW_SPLIT_REL + inst * 2048;
        const unsigned nloc = b.st[0];
        const unsigned old = xb_add(&w[64 * b.x], 1u);
        if (old + 1u == nloc) { __builtin_amdgcn_fence(__ATOMIC_RELEASE, "agent"); asm volatile("s_waitcnt vmcnt(0)" ::: "memory"); (void)xb_add(&w[1024], 1u); }
    }
}
__device__ __forceinline__ void split_wait(const XcdBarrier& b, int inst, int tid) {
    if (tid == 0) {
        unsigned* w = b.bar + CW_SPLIT_REL + inst * 2048;
        const unsigned nx = b.st[1];
        XB_SPIN(xb_ld(&w[1024]) < nx, b.bar);
        __builtin_amdgcn_fence(__ATOMIC_ACQUIRE, "agent");
        asm volatile("s_waitcnt vmcnt(0)" ::: "memory");
    }
    __syncthreads();
}

struct Args { const float* in[28]; float* out; unsigned char* ws; int ph_lo, ph_hi, li, pad; };

struct Frame {
    LAS unsigned char* lds;
    int wave, G, gw, NGW;
#define F_LANE (lane_id())
#define F_TID (F.wave * 64 + lane_id())
};

__device__ __forceinline__ void tr_load(const float* W, int ldw, int kb, int nb, int lane, f32x4 (&v)[8]) {
    const float* src = W + (size_t)(64 * kb + 8 * (lane >> 3)) * ldw + 32 * nb + 4 * (lane & 7);
#pragma unroll
    for (int j = 0; j < 8; ++j) v[j] = *(const f32x4*)(src + (size_t)j * ldw);
}
__device__ __forceinline__ void tr_store(bf16* WT, int K, int kb, int nb, int lane, const f32x4 (&v)[8]) {
    bf16* dst = WT + (size_t)(32 * nb + 4 * (lane & 7)) * K + 64 * kb + 8 * (lane >> 3);
#pragma unroll
    for (int i = 0; i < 4; ++i) { v4u o; o.x = pk2(v[0][i], v[1][i]); o.y = pk2(v[2][i], v[3][i]); o.z = pk2(v[4][i], v[5][i]); o.w = pk2(v[6][i], v[7][i]);
        *(GAS v4u*)(dst + (size_t)i * K) = o; }
}
__device__ __forceinline__ void p0_transpose_item(const float* W, int ldw, int K, bf16* WT, int kb, int nb, int lane) { f32x4 v[8]; tr_load(W, ldw, kb, nb, lane, v); tr_store(WT, K, kb, nb, lane, v); }
__device__ __forceinline__ void row_load(const float* xrow, int lane, f32x4 (&v)[4]) {
    const GAS f32x4* xr = (const GAS f32x4*)xrow + lane;
#pragma unroll
    for (int j = 0; j < 4; ++j) v[j] = xr[64 * j];
}
__device__ __forceinline__ void gain_load(const float* g, int lane, f32x4 (&gg)[4]) {
    const GAS f32x4* gr = (const GAS f32x4*)g + lane;
#pragma unroll
    for (int j = 0; j < 4; ++j) gg[j] = gr[64 * j];
}
__device__ __forceinline__ void rms_row_finish(const f32x4 (&gg)[4], bf16* orow, int lane, f32x4 (&v)[4]) {
    float s = 0.f;
#pragma unroll
    for (int j = 0; j < 4; ++j) s += (v[j].x * v[j].x + v[j].y * v[j].y) + (v[j].z * v[j].z + v[j].w * v[j].w);
    const float rstd = rsqrtf(wave_sum(s) * (1.f / D) + EPS);
    GAS unsigned long long* o8 = (GAS unsigned long long*)orow + lane;
#pragma unroll
    for (int j = 0; j < 4; ++j) { v[j] = v[j] * rstd * gg[j];
        o8[64 * j] = (unsigned long long)pk2(v[j].x, v[j].y) | ((unsigned long long)pk2(v[j].z, v[j].w) << 32); }
}

constexpr int PH_P0 = 0, PH_P1 = 1, PH_P2 = 2, PH_SCAN = 3, PH_MLOUT = 4, PH_MIX = 5, PH_WOUT = 6, PH_ROUTE = 7, PH_G1 = 8, PH_G2S = 9, PH_G2P = 10, PH_END = 11;
constexpr size_t WS_G8 = 219 * MiB;
constexpr size_t WS_H1 = 35 * MiB;
constexpr size_t WS_HN = 99 * MiB;
constexpr size_t WS_WGU = 219 * MiB;
constexpr size_t WS_WD = 19 * MiB;
constexpr size_t WS_HH = 187 * MiB;
constexpr size_t WS_Y1 = 139 * MiB;


constexpr int CV_WGU = 32 * 256, CV_LATE = 1536 + 256 + 128 + 256 + 512, CV_ITEMS = CV_WGU + CV_LATE + 32 * 128;
__device__ __forceinline__ void cv_item(const Args& a, int it, const float*& W, int& ldw, int& K, bf16*& WT, int& kb, int& nb) {
    unsigned char* ws = a.ws;
    if (it < CV_WGU) { const int e = it >> 8, q = it & 255, sub = q >> 6, r = q & 63;
        W = ((sub & 1) ? a.in[26] : a.in[25]) + (size_t)e * 1024 * 256 + (sub >> 1) * 128; ldw = 256; K = 1024; WT = (bf16*)(ws + WS_WGU) + ((size_t)e * 512 + sub * 128) * 1024; kb = r >> 2; nb = r & 3; return; }
    int r = it - CV_WGU;
    if (r < 1536) { W = a.in[17]; ldw = 3072; K = 1024; WT = (bf16*)(ws + WS_WGATE); kb = r / 96; nb = r % 96; return; } r -= 1536;
    if (r < 256) { W = a.in[14]; ldw = 1024; K = 512; WT = (bf16*)(ws + WS_WA); kb = r >> 5; nb = r & 31; return; } r -= 256;
    if (r < 128) { W = a.in[15]; ldw = 1024; K = 256; WT = (bf16*)(ws + WS_WB); kb = r >> 5; nb = r & 31; return; } r -= 128;
    if (r < 256) { W = a.in[16]; ldw = 1024; K = 512; WT = (bf16*)(ws + WS_WC); kb = r >> 5; nb = r & 31; return; } r -= 256;
    if (r < 512) { W = a.in[19]; ldw = 1024; K = 1024; WT = (bf16*)(ws + WS_WOUT); kb = r >> 5; nb = r & 31; return; } r -= 512;
    { const int e = r >> 7, q = r & 127; W = a.in[27] + (size_t)e * 256 * 1024; ldw = 1024; K = 256; WT = (bf16*)(ws + WS_WD) + (size_t)e * 1024 * 256; kb = q >> 5; nb = q & 31; }
}
__device__ __forceinline__ void bg_load(const Args& a, int it, int lane, f32x4 (&v)[8]) { const float* W; int ldw, K, kb, nb; bf16* WT; cv_item(a, it, W, ldw, K, WT, kb, nb); tr_load(W, ldw, kb, nb, lane, v); }
__device__ __forceinline__ void bg_store(const Args& a, int it, int lane, const f32x4 (&v)[8]) { const float* W; int ldw, K, kb, nb; bf16* WT; cv_item(a, it, W, ldw, K, WT, kb, nb); tr_store(WT, K, kb, nb, lane, v); }
__device__ __forceinline__ void cv_range(const Args& a, int lo, int hi, int wi, int nw, int lane) {
    for (int it = lo + wi; it < hi; it += 3 * nw) { f32x4 v0[8], v1[8], v2[8]; const int it1 = it + nw, it2 = it + 2 * nw; const bool h1 = it1 < hi, h2 = it2 < hi;
        bg_load(a, it, lane, v0); bg_load(a, h1 ? it1 : it, lane, v1); bg_load(a, h2 ? it2 : it, lane, v2);
        bg_store(a, it, lane, v0); if (h1) bg_store(a, it1, lane, v1); if (h2) bg_store(a, it2, lane, v2); }
}
constexpr size_t WS_ENT = 131 * MiB;
constexpr size_t WS_ENTW = 135 * MiB;
constexpr int TOFF_LDS = 136192;

namespace pg8 {
template <int i0, int i1, int npn_shift, int gather>
struct MoeOrder {
    const PG8_LAS int* toff; int G, c, tbeg, tend, c2;
    __device__ __forceinline__ bool next(int i, Unit& u) const {
        if (c < 0) return false;
        const int L = (i == 0) ? c : i * G + c2; const int tau = tbeg + (L >> npn_shift), pn = L & ((1 << npn_shift) - 1);
        if (tau >= tend) return false;
        int li = i0;
        while (toff[li + 1] <= tau) ++li;
        const int t = tau - toff[li], v = (li + 32) & 63, e = v & 31;
        u.pm = gather ? (v * 64 + t) : tau; u.pn = pn; u.bt = (e << npn_shift) + pn; u.aux = (tau << 16) | (v << 8) | t;
        return true;
    }
};
struct EpiGLU {
    static constexpr bool PERM = true; static constexpr int SID = 5;
    bf16_t* H; const float* entw;
    __device__ __forceinline__ void operator()(const f32x4 (&acc)[2][2][4][2], const Unit& u, int wr, int wc, int fr, int fq) const {
        const int tau = u.aux >> 16, v = (u.aux >> 8) & 255, t = u.aux & 255;
        const int col0 = u.pn * 128 + wc * 32 + 8 * fq;
        int rb = wr * 64 + fr; asm volatile("" : "+v"(rb));
        const float* wrow = entw + (size_t)v * 16384 + t * 256 + rb; bf16_t* hrow = H + ((size_t)tau * 256 + rb) * 256 + col0;
        float wv8[2][4];
#pragma unroll
        for (int ai = 0; ai < 2; ++ai)
#pragma unroll
            for (int m = 0; m < 4; ++m) wv8[ai][m] = wrow[ai * HALF + m * 16];
#pragma unroll
        for (int ai = 0; ai < 2; ++ai)
#pragma unroll
            for (int m = 0; m < 4; ++m) { const float w = wv8[ai][m];
                f32x4 h0, h1;
#pragma unroll
                for (int j = 0; j < 4; ++j) { const float g0 = acc[ai][0][m][0][j], g1 = acc[ai][0][m][1][j];
                    h0[j] = g0 * fast_sigmoid(g0) * acc[ai][1][m][0][j] * w; h1[j] = g1 * fast_sigmoid(g1) * acc[ai][1][m][1][j] * w; }
                u32x4 o; o.x = cvt_pk_bf16(h0[0], h0[1]); o.y = cvt_pk_bf16(h0[2], h0[3]); o.z = cvt_pk_bf16(h1[0], h1[1]); o.w = cvt_pk_bf16(h1[2], h1[3]);
                { unsigned long long* hp = (unsigned long long*)(hrow + (size_t)(ai * HALF + m * 16) * 256);
                  __hip_atomic_store(hp, (unsigned long long)o.x | ((unsigned long long)o.y << 32), __ATOMIC_RELAXED, __HIP_MEMORY_SCOPE_AGENT);
                  __hip_atomic_store(hp + 1, (unsigned long long)o.z | ((unsigned long long)o.w << 32), __ATOMIC_RELAXED, __HIP_MEMORY_SCOPE_AGENT); } }
    }
};
template <bool PRIMARY>
struct EpiScatter {
    static constexpr bool PERM = true; static constexpr int SID = 6;
    const int* ent; const PG8_LAS int* cnt; bf16_t* Y1; const float* H1; float* OUT;
    __device__ __forceinline__ void operator()(const f32x4 (&acc)[2][2][4][2], const Unit& u, int wr, int wc, int fr, int fq) const {
        const int v = (u.aux >> 8) & 255, t = u.aux & 255;
        int tq; asm volatile("v_mbcnt_lo_u32_b32 %0, -1, 0\n\tv_mbcnt_hi_u32_b32 %0, -1, %0" : "=v"(tq));
        const unsigned col0 = (unsigned)(u.pn * BM + wc * 32 + 8 * (tq >> 4));
        const int rb = wr * 64 + (tq & 15);
        const char* eb = (const char*)(ent + (size_t)v * 16384 + t * 256); const unsigned rb4 = (unsigned)rb * 4u; const int nv = cnt[v] - t * 256 - rb;
        unsigned tok[2][4];
#pragma unroll
        for (int ai = 0; ai < 2; ++ai)
#pragma unroll
            for (int m = 0; m < 4; ++m) tok[ai][m] = (ai * HALF + m * 16 < nv) ? *(const unsigned*)(eb + rb4 + (unsigned)(ai * HALF + m * 16) * 4u) : 0u;
#pragma unroll
        for (int ai = 0; ai < 2; ++ai)
#pragma unroll
            for (int mp = 0; mp < 2; ++mp) {
                u32x4 yv[2][2]; f32x4 hv[2][2][2];
                if (PRIMARY) {
#pragma unroll
                    for (int mm = 0; mm < 2; ++mm)
#pragma unroll
                        for (int bj = 0; bj < 2; ++bj) { const unsigned o = tok[ai][2 * mp + mm] * 1024u + col0 + bj * HALF;
                            yv[mm][bj] = *(const u32x4*)((const char*)Y1 + o * 2u); hv[mm][bj][0] = *(const f32x4*)((const char*)H1 + o * 4u); hv[mm][bj][1] = *(const f32x4*)((const char*)H1 + o * 4u + 16u); }
                }
#pragma unroll
                for (int mm = 0; mm < 2; ++mm) { const int m = 2 * mp + mm;
                    if (ai * HALF + m * 16 < nv) {
#pragma unroll
                        for (int bj = 0; bj < 2; ++bj) { const unsigned o = tok[ai][m] * 1024u + col0 + bj * HALF; const f32x4 a0 = acc[ai][bj][m][0], a1 = acc[ai][bj][m][1];
                            if (PRIMARY) { const u32x4 y = yv[mm][bj]; f32x4 t0 = hv[mm][bj][0], t1 = hv[mm][bj][1];
                                t0[0] += a0[0] + bflo(y.x); t0[1] += a0[1] + bfhi(y.x); t0[2] += a0[2] + bflo(y.y); t0[3] += a0[3] + bfhi(y.y);
                                t1[0] += a1[0] + bflo(y.z); t1[1] += a1[1] + bfhi(y.z); t1[2] += a1[2] + bflo(y.w); t1[3] += a1[3] + bfhi(y.w);
                                *(f32x4*)((char*)OUT + o * 4u) = t0; *(f32x4*)((char*)OUT + o * 4u + 16u) = t1; }
                            else { u32x4 w; w.x = cvt_pk_bf16(a0[0], a0[1]); w.y = cvt_pk_bf16(a0[2], a0[3]); w.z = cvt_pk_bf16(a1[0], a1[1]); w.w = cvt_pk_bf16(a1[2], a1[3]); *(u32x4*)((char*)Y1 + o * 2u) = w; } } } }
                asm volatile("" ::: "memory"); }
    }
};
}

__device__ __forceinline__ void route_phase(const Frame& F, const Args& a, gu32* ctl, const XcdBarrier& bar) {
    const float* ln2_g = a.in[20]; const float* w_grp = a.in[21]; const float* b_grp = a.in[22]; const float* w_er = a.in[23]; const float* b_er = a.in[24];
    const float* w_eg = a.in[25]; const float* w_eu = a.in[26]; const float* w_ed = a.in[27];
    unsigned char* ws = a.ws;
    const float* H1 = (const float*)(ws + WS_H1); bf16* HN = (bf16*)(ws + WS_HN);
    int* ENT = (int*)(ws + WS_ENT); float* ENTW = (float*)(ws + WS_ENTW);
    __syncthreads();
    cv_range(a, 0, CV_WGU, F.gw, F.NGW, F_LANE); cv_range(a, CV_WGU + CV_LATE, CV_ITEMS, F.gw, F.NGW, F_LANE);
    split_wait(bar, 3, F_TID);
    LAS float* wer = (LAS float*)F.lds;
    { const int t0 = F_TID; f32x4 wa[8], wb[8];
#pragma unroll
      for (int i = 0; i < 8; ++i) { const int r = t0 + 512 * i; wa[i] = *(const f32x4*)(w_er + (size_t)r * 8); wb[i] = *(const f32x4*)(w_er + (size_t)r * 8 + 4); }
#pragma unroll
      for (int i = 0; i < 8; ++i) { const int r = t0 + 512 * i, g = r >> 10, k = r & 1023; LAS float* d = wer + (size_t)(g * 8) * 1024 + k;
        d[0] = wa[i].x; d[1024] = wa[i].y; d[2048] = wa[i].z; d[3072] = wa[i].w; d[4096] = wb[i].x; d[5120] = wb[i].y; d[6144] = wb[i].z; d[7168] = wb[i].w; } }
    __syncthreads();
    const int lane = F_LANE;
    f32x4 wgq[4][4];
#pragma unroll
    for (int jj = 0; jj < 4; ++jj)
#pragma unroll
        for (int cc = 0; cc < 4; ++cc) wgq[jj][cc] = *(const f32x4*)(w_grp + (size_t)(4 * lane + 256 * jj + cc) * 4);
    f32x4 g2v[4]; gain_load(ln2_g, lane, g2v);
    const float bg0 = b_grp[0], bg1 = b_grp[1], bg2 = b_grp[2], bg3 = b_grp[3];
    const float berv = b_er[lane & 31];
    constexpr int TP = 2;
    f32x4 vn[TP][4];
#pragma unroll
    for (int q = 0; q < TP; ++q) { const int m = F.gw + q * F.NGW; row_load(H1 + (size_t)(m < M ? m : 0) * D, lane, vn[q]); }
    for (int mb = F.gw; mb < M; mb += TP * F.NGW) {
        f32x4 vv[TP][4];
#pragma unroll
        for (int q = 0; q < TP; ++q)
#pragma unroll
            for (int j = 0; j < 4; ++j) vv[q][j] = vn[q][j];
#pragma unroll
        for (int q = 0; q < TP; ++q) { const int m = mb + (TP + q) * F.NGW; row_load(H1 + (size_t)(m < M ? m : 0) * D, lane, vn[q]); }
        asm volatile("" ::: "memory");
        int lv[TP][2]; float lw[TP][2];
#pragma unroll
        for (int q = 0; q < TP; ++q) { const int m = mb + q * F.NGW; lv[q][0] = lv[q][1] = 0; lw[q][0] = lw[q][1] = 0.f; if (m >= M) continue;
            f32x4 (&v)[4] = vv[q];
            rms_row_finish(g2v, HN + (size_t)m * D, lane, v);
            float gl[4] = {0.f, 0.f, 0.f, 0.f};
#pragma unroll
            for (int jj = 0; jj < 4; ++jj)
#pragma unroll
                for (int cc = 0; cc < 4; ++cc) { const float y = v[jj][cc]; const f32x4 w4 = wgq[jj][cc]; gl[0] += y * w4.x; gl[1] += y * w4.y; gl[2] += y * w4.z; gl[3] += y * w4.w; }
            gl[0] = wave_sum(gl[0]) + bg0; gl[1] = wave_sum(gl[1]) + bg1; gl[2] = wave_sum(gl[2]) + bg2; gl[3] = wave_sum(gl[3]) + bg3;
            int gi = 0; float gmax = gl[0];
#pragma unroll
            for (int j = 1; j < 4; ++j) if (gl[j] > gmax) { gmax = gl[j]; gi = j; }
            float gden = 0.f;
#pragma unroll
            for (int j = 0; j < 4; ++j) gden += __expf(gl[j] - gmax);
            const float gw = 1.f / gden;
            gi = __builtin_amdgcn_readfirstlane(gi);
            const LAS float* we = wer + (size_t)(gi * 8) * 1024 + 4 * lane;
            float el[8];
#pragma unroll
            for (int j = 0; j < 8; ++j) { float s = 0.f;
#pragma unroll
                for (int jj = 0; jj < 4; ++jj) { const f32x4 w4 = *(const LAS f32x4*)(we + j * 1024 + 256 * jj); s += (v[jj].x * w4.x + v[jj].y * w4.y) + (v[jj].z * w4.z + v[jj].w * w4.w); }
                el[j] = wave_sum(s) + __uint_as_float(__builtin_amdgcn_readlane(__float_as_uint(berv), gi * 8 + j)); }
            int i0 = 0; float m0 = el[0];
#pragma unroll
            for (int j = 1; j < 8; ++j) if (el[j] > m0) { m0 = el[j]; i0 = j; }
            int i1 = -1; float m1 = -INFINITY;
#pragma unroll
            for (int j = 0; j < 8; ++j) if (j != i0 && el[j] > m1) { m1 = el[j]; i1 = j; }
            const float e1 = __expf(m1 - m0);
            lv[q][0] = gi * 8 + i0; lv[q][1] = 32 + gi * 8 + i1; lw[q][0] = gw / (1.f + e1); lw[q][1] = gw * e1 / (1.f + e1);
        }
        if (lane < 2 * TP) { const int q = lane >> 1, s = lane & 1, m = mb + q * F.NGW;
            const int vl = q ? (s ? lv[1][1] : lv[1][0]) : (s ? lv[0][1] : lv[0][0]); const float wl = q ? (s ? lw[1][1] : lw[1][0]) : (s ? lw[0][1] : lw[0][0]);
            if (m < M) { const unsigned r = __hip_atomic_fetch_add(ctl + CW_ECNT + 64 * vl, 1u, RLX_AGENT);
                ENT[(size_t)vl * 16384 + r] = m; ENTW[(size_t)vl * 16384 + r] = wl; } }
    }
}
__device__ __forceinline__ void moe_tile_offsets(const Frame& F, gu32* ctl) {
    LAS int* toff = (LAS int*)(F.lds + TOFF_LDS);
    __syncthreads();
    if (F_TID < 64) toff[80 + F_TID] = (int)__hip_atomic_load(ctl + CW_ECNT + 64 * F_TID, RLX_AGENT);
    __syncthreads();
    if (F_TID == 0) { int acc = 0; for (int i = 0; i < 64; ++i) { toff[i] = acc; acc += (toff[80 + ((i + 32) & 63)] + 255) >> 8; } toff[64] = acc; }
    __syncthreads();
}
constexpr int CW_SDONE = CW_ECNT + 64 * 64;
#define TOFFP ((const LAS int*)(F.lds + TOFF_LDS))
constexpr int G2LS = 528;
template <bool PRIMARY>
__device__ __forceinline__ void g2e_phase(const Frame& F, unsigned char* ws, float* OUT, int c, int G, const XcdBarrier& bar, int wait_inst) {
    LAS unsigned char* Bs = F.lds;
    const LAS int* toff = TOFFP; const LAS int* cnt = TOFFP + 80;
    const bf16* HH = (const bf16*)(ws + WS_HH); const bf16* WD = (const bf16*)(ws + WS_WD); const int* ENT = (const int*)(ws + WS_ENT);
    bf16* Y1 = (bf16*)(ws + WS_Y1); const float* H1 = (const float*)(ws + WS_H1);
    const int tid = F_TID, lane = tid & 63, i16 = lane & 15, quad = lane >> 4, w = F.wave;
    for (int u = (c >= 0 ? c : 256); u < 256; u += G) {
        const int e = u >> 3, pn = (u >> 1) & 3, hh = u & 1, v = (PRIMARY ? 0 : 32) + e, li = (v + 32) & 63;
        const int n = __builtin_amdgcn_readfirstlane(cnt[v]), hbase = __builtin_amdgcn_readfirstlane(toff[li]) * 256;
        const int half = ((((n + 1) >> 1) + 15) & ~15), rbeg = hh ? half : 0, rend = hh ? n : (half < n ? half : n);
        const int nstrip = (rend > rbeg) ? ((rend - rbeg + 15) >> 4) : 0;
        __syncthreads();
        bf16x8 af[8]; unsigned tok = 0u; int row = rbeg + 16 * w + i16;
        if (nstrip > 0) {
            const v4u* gb = (const v4u*)(WD + ((size_t)e * 1024 + pn * 256) * 256);
            v4u rb[16];
#pragma unroll
            for (int i = 0; i < 16; ++i) rb[i] = gb[tid + 512 * i];
            if (wait_inst >= 0) { split_wait(bar, wait_inst, tid); wait_inst = -1; }
            if (w < nstrip) { if (row < rend) tok = (unsigned)ENT[(size_t)v * 16384 + row];
                const bf16* hrow = HH + ((size_t)hbase + row) * 256 + 8 * quad;
#pragma unroll
                for (int ks = 0; ks < 8; ++ks) af[ks] = *(const bf16x8*)(hrow + 32 * ks); }
            const int c0 = tid >> 5, ch = tid & 31, L0 = 16 * ((c0 >> 2) & 1) + 4 * ((c0 >> 3) & 1) + (c0 & 3);
            LAS unsigned char* sb = Bs + L0 * G2LS + ch * 16;
#pragma unroll
            for (int i = 0; i < 16; ++i) *(LAS v4u*)(sb + (32 * (i >> 1) + 8 * (i & 1)) * G2LS) = rb[i];
        }
        __syncthreads();
        for (int s = w; s < nstrip; s += NWAVES) {
            const bool valid = row < rend;
            const unsigned ob = tok * 1024u + (unsigned)(pn * 256 + 8 * quad);
            v4u yv[8]; f32x4 hv[8][2];
            if (PRIMARY) {
#pragma unroll
                for (int p = 0; p < 8; ++p) { const unsigned o = ob + 32u * p; yv[p] = *(const v4u*)((const char*)Y1 + o * 2u); hv[p][0] = *(const f32x4*)((const char*)H1 + o * 4u); hv[p][1] = *(const f32x4*)((const char*)H1 + o * 4u + 16u); }
            }
            bf16x8 afn[8]; unsigned tokn = 0u; const int rown = row + 16 * NWAVES; const bool more = s + NWAVES < nstrip;
            if (!PRIMARY && more) { if (rown < rend) tokn = (unsigned)ENT[(size_t)v * 16384 + rown];
                const bf16* hrow = HH + ((size_t)hbase + rown) * 256 + 8 * quad;
#pragma unroll
                for (int ks = 0; ks < 8; ++ks) afn[ks] = *(const bf16x8*)(hrow + 32 * ks); }
            f32x4 acc[16];
#pragma unroll
            for (int nt = 0; nt < 16; ++nt) { acc[nt] = (f32x4){0.f, 0.f, 0.f, 0.f};
#pragma unroll
                for (int ks = 0; ks < 8; ++ks) acc[nt] = __builtin_amdgcn_mfma_f32_16x16x32_bf16(*(const LAS bf16x8*)(Bs + (16 * nt + i16) * G2LS + (32 * ks + 8 * quad) * 2), af[ks], acc[nt], 0, 0, 0);
                if (nt & 1) asm volatile("" ::: "memory"); }
            if (PRIMARY && more) { if (rown < rend) tokn = (unsigned)ENT[(size_t)v * 16384 + rown];
                const bf16* hrow = HH + ((size_t)hbase + rown) * 256 + 8 * quad;
#pragma unroll
                for (int ks = 0; ks < 8; ++ks) af[ks] = *(const bf16x8*)(hrow + 32 * ks); }
            if (valid) {
#pragma unroll
                for (int p = 0; p < 8; ++p) { const unsigned o = ob + 32u * p; const f32x4 a0 = acc[2 * p], a1 = acc[2 * p + 1];
                    if (PRIMARY) { const v4u y = yv[p]; f32x4 t0 = hv[p][0], t1 = hv[p][1];
                        t0[0] += a0[0] + pg8::bflo(y.x); t0[1] += a0[1] + pg8::bfhi(y.x); t0[2] += a0[2] + pg8::bflo(y.y); t0[3] += a0[3] + pg8::bfhi(y.y);
                        t1[0] += a1[0] + pg8::bflo(y.z); t1[1] += a1[1] + pg8::bfhi(y.z); t1[2] += a1[2] + pg8::bflo(y.w); t1[3] += a1[3] + pg8::bfhi(y.w);
                        *(f32x4*)((char*)OUT + o * 4u) = t0; *(f32x4*)((char*)OUT + o * 4u + 16u) = t1; }
                    else { v4u wv; wv.x = pg8::cvt_pk_bf16(a0[0], a0[1]); wv.y = pg8::cvt_pk_bf16(a0[2], a0[3]); wv.z = pg8::cvt_pk_bf16(a1[0], a1[1]); wv.w = pg8::cvt_pk_bf16(a1[2], a1[3]); *(v4u*)((char*)Y1 + o * 2u) = wv; } }
            }
            if (more) {
                if (!PRIMARY) {
#pragma unroll
                    for (int ks = 0; ks < 8; ++ks) af[ks] = afn[ks]; }
                tok = tokn; row = rown; }
        }
    }
    if (wait_inst >= 0) split_wait(bar, wait_inst, tid);
    __syncthreads();
}
#define MEGA_MOE_PHASES \
    if (IN(PH_ROUTE)) { route_phase(F, args, ctl, bar); } \
    SEAM(PH_ROUTE); \
    if (IN(PH_G1)) { moe_tile_offsets(F, ctl); \
        const int tS = __builtin_amdgcn_readfirstlane(TOFFP[32]), tA = __builtin_amdgcn_readfirstlane(TOFFP[64]);     \
        const int c2 = (c - 2 * tS + F.G) % F.G;     \
        {     \
            pg8::MoeOrder<0, 64, 1, 1> S{TOFFP, F.G, c, 0, tA, c2}; \
            pg8::Gemm g{(const bf16*)(ws + WS_HN), (const bf16*)(ws + WS_WGU), 1024, 1024, (const int*)(ws + WS_ENT)}; \
            pg8::EpiGLU E{(bf16*)(ws + WS_HH), (const float*)(ws + WS_ENTW)}; \
            pg8::gemm_phase<pg8::EpiGLU, pg8::MoeOrder<0, 64, 1, 1>, true, true>(F.lds, g, S, E, F.wave); } \
        {     \
            int nsec = 0; for (int i = 0;; ++i) { const int L = (i == 0) ? c : i * F.G + c2; if (L >= 2 * tA) break; if (L < 2 * tS) ++nsec; } \
            VM_WAIT(); __syncthreads(); \
            if (F_TID == 0 && nsec > 0) { __hip_atomic_fetch_add(ctl + CW_SDONE, (unsigned)nsec, RLX_AGENT); }     \
            const int nbusy = (F.G == 256 && 2 * tA > F.G) ? (2 * tA - F.G) : 0;     \
            const int nfree = F.G - nbusy, cf = (c2 >= nbusy) ? (c2 - nbusy) : -1; \
            if (cf >= 0) { \
                if (F_TID == 0) { unsigned sp = 0; while (__hip_atomic_load(ctl + CW_SDONE, RLX_AGENT) < (unsigned)(2 * tS)) { __builtin_amdgcn_s_sleep(2); if (++sp > (1u << 22)) break; } \
                    __builtin_amdgcn_fence(__ATOMIC_ACQUIRE, "agent"); VM_WAIT(); } \
                __syncthreads(); \
            } \
            g2e_phase<false>(F, ws, args.out, cf, nfree, bar, -1); } \
        split_arrive(bar, 4, F_TID);     \
    } \
    if (IN(PH_G2P)) { moe_tile_offsets(F, ctl); g2e_phase<true>(F, ws, args.out, c, F.G, bar, 4); }
__device__ __forceinline__ void ml_scan_phase(const Frame& F, float* CL, float* NL, float* SC) {
    const int gt = F.gw * 64 + F_LANE, NT = F.NGW * 64;
    for (int e = gt; e < 16 * 16512; e += NT) {
        const int bh = e / 16512, r = e % 16512; const bool isn = r >= 16384;
        float* p0 = isn ? (NL + (size_t)bh * NCHUNK * 128 + (r - 16384)) : (CL + (size_t)bh * NCHUNK * 16384 + r);
        const size_t stride = isn ? 128 : 16384;
        float loc[NCHUNK];
#pragma unroll
        for (int c = 0; c < NCHUNK; ++c) loc[c] = p0[c * stride];
        float st = 0.f, mcur = 0.f;
#pragma unroll
        for (int c = 0; c < NCHUNK; ++c) {
            const int u = bh * NCHUNK + c;
            const float bl = SC[u * 4 + 0], ml = SC[u * 4 + 1];
            const float mnew = fmaxf(bl + mcur, ml), dec = __expf(bl + mcur - mnew), sl = __expf(ml - mnew);
            p0[c * stride] = st; st = dec * st + sl * loc[c];
            if (r == 0) SC[u * 4 + 2] = mcur;
            mcur = mnew;
        }
    }
}
#define MFMA16(a, b, c) __builtin_amdgcn_mfma_f32_16x16x32_bf16((a), (b), (c), 0, 0, 0)
__device__ __forceinline__ bf16x8 lds_frag(const LAS unsigned char* p) { return *(const LAS bf16x8*)p; }
__device__ __forceinline__ bf16x8 lds_frag_tr2(const LAS unsigned char* p0, const LAS unsigned char* p1) {
    const s16x4 a = __builtin_amdgcn_ds_read_tr16_b64_v4i16((LAS s16x4*)p0), b = __builtin_amdgcn_ds_read_tr16_b64_v4i16((LAS s16x4*)p1);
    bf16x8 r; r[0] = a[0]; r[1] = a[1]; r[2] = a[2]; r[3] = a[3]; r[4] = b[0]; r[5] = b[1]; r[6] = b[2]; r[7] = b[3]; return r;
}
__device__ __forceinline__ bf16x8 pack8(f32x4 a, f32x4 b) {
    v4u w; w.x = pg8::cvt_pk_bf16(a[0], a[1]); w.y = pg8::cvt_pk_bf16(a[2], a[3]); w.z = pg8::cvt_pk_bf16(b[0], b[1]); w.w = pg8::cvt_pk_bf16(b[2], b[3]);
    return __builtin_bit_cast(bf16x8, w);
}
__device__ __forceinline__ float bfs(short s) { return __uint_as_float(((unsigned)(unsigned short)s) << 16); }
__device__ __forceinline__ float quad_sum(float v) { v += __shfl_xor(v, 16); v += __shfl_xor(v, 32); return v; }
__device__ __forceinline__ float quad_max(float v) { v = fmaxf(v, __shfl_xor(v, 16)); v = fmaxf(v, __shfl_xor(v, 32)); return v; }

constexpr int XS = 272;
__device__ __forceinline__ void cross_job(const Frame& F, bf16* Z, const bf16* kvm, const float* qg, const float* kg, int job) {
    const int b = job >> 6, h = (job >> 4) & 3, qblk = job & 15;
    LAS unsigned char* Ks = F.lds; LAS unsigned char* Vs = F.lds + 256 * XS;
    const int tid = F_TID, lane = tid & 63, i16 = lane & 15, quad = lane >> 4;
    __syncthreads();
    { const int ch = tid & 15, r0 = tid >> 4;
        const v4u* src = (const v4u*)(kvm + (size_t)(b * MEM_LEN + r0) * 1024 + h * 128 + ch * 8);
        v4u kw[8], vw[8];
#pragma unroll
        for (int it = 0; it < 8; ++it) { kw[it] = src[(size_t)it * 32 * 128]; vw[it] = src[(size_t)it * 32 * 128 + 64]; }
        const f32x4 g0 = *(const f32x4*)(kg + ch * 8), g1 = *(const f32x4*)(kg + ch * 8 + 4);
#pragma unroll
        for (int it = 0; it < 8; ++it) { const int row = r0 + 32 * it;
            const bf16x8 kr = __builtin_bit_cast(bf16x8, kw[it]); float kv[8]; float ss = 0.f;
#pragma unroll
            for (int e = 0; e < 8; ++e) { kv[e] = bfs(kr[e]); ss += kv[e] * kv[e]; }
            ss += DPP_F(ss, 0xB1, 0xf); ss += DPP_F(ss, 0x4E, 0xf); ss += DPP_F(ss, 0x141, 0xf); ss += DPP_F(ss, 0x140, 0xf);
            const float rstd = rsqrtf(ss * (1.f / 128) + EPS);
            f32x4 a, c2; a[0] = kv[0] * rstd * g0[0]; a[1] = kv[1] * rstd * g0[1]; a[2] = kv[2] * rstd * g0[2]; a[3] = kv[3] * rstd * g0[3];
            c2[0] = kv[4] * rstd * g1[0]; c2[1] = kv[5] * rstd * g1[1]; c2[2] = kv[6] * rstd * g1[2]; c2[3] = kv[7] * rstd * g1[3];
            *(LAS bf16x8*)(Ks + row * XS + ch * 16) = pack8(a, c2); *(LAS v4u*)(Vs + row * XS + ch * 16) = vw[it]; } }
    __syncthreads();
    for (int pass = 0; pass < 2; ++pass) {
        const int t0 = qblk * 256 + pass * 128 + F.wave * 16;
        bf16* qrow = Z + (size_t)(b * SEQ + t0 + i16) * ZW + Z_XQ + h * 128;
        bf16x8 qf[4]; float ss = 0.f; float qv[4][8];
#pragma unroll
        for (int ks = 0; ks < 4; ++ks) { const bf16x8 raw = *(const bf16x8*)(qrow + 32 * ks + 8 * quad);
#pragma unroll
            for (int e = 0; e < 8; ++e) { qv[ks][e] = bfs(raw[e]); ss += qv[ks][e] * qv[ks][e]; } }
        const float rstd = rsqrtf(quad_sum(ss) * (1.f / 128) + EPS) * 0.08838834764831845f;
#pragma unroll
        for (int ks = 0; ks < 4; ++ks) { const f32x4 g0 = *(const f32x4*)(qg + 32 * ks + 8 * quad), g1 = *(const f32x4*)(qg + 32 * ks + 8 * quad + 4);
            f32x4 a, c2; a[0] = qv[ks][0] * rstd * g0[0]; a[1] = qv[ks][1] * rstd * g0[1]; a[2] = qv[ks][2] * rstd * g0[2]; a[3] = qv[ks][3] * rstd * g0[3];
            c2[0] = qv[ks][4] * rstd * g1[0]; c2[1] = qv[ks][5] * rstd * g1[1]; c2[2] = qv[ks][6] * rstd * g1[2]; c2[3] = qv[ks][7] * rstd * g1[3];
            qf[ks] = pack8(a, c2); }
        f32x4 s[16];
#pragma unroll
        for (int jt = 0; jt < 16; ++jt) { s[jt] = (f32x4){0.f, 0.f, 0.f, 0.f};
#pragma unroll
            for (int ks = 0; ks < 4; ++ks) s[jt] = MFMA16(lds_frag(Ks + (16 * jt + i16) * XS + (32 * ks + 8 * quad) * 2), qf[ks], s[jt]);
            if (jt & 1) asm volatile("" ::: "memory"); }
        float mx = -INFINITY;
#pragma unroll
        for (int jt = 0; jt < 16; ++jt) mx = fmaxf(mx, fmaxf(fmaxf(s[jt][0], s[jt][1]), fmaxf(s[jt][2], s[jt][3])));
        mx = quad_max(mx);
        float l = 0.f;
#pragma unroll
        for (int jt = 0; jt < 16; ++jt) {
#pragma unroll
            for (int r = 0; r < 4; ++r) { s[jt][r] = __expf(s[jt][r] - mx); l += s[jt][r]; } }
        l = quad_sum(l);
        f32x4 o[8];
#pragma unroll
        for (int dt = 0; dt < 8; ++dt) o[dt] = (f32x4){0.f, 0.f, 0.f, 0.f};
#pragma unroll
        for (int kk = 0; kk < 8; ++kk) { const bf16x8 pf = pack8(s[2 * kk], s[2 * kk + 1]);
            const LAS unsigned char* vb = Vs + (32 * kk + 4 * quad + (i16 >> 2)) * XS + (4 * (i16 & 3)) * 2;
#pragma unroll
            for (int dt = 0; dt < 8; ++dt) o[dt] = MFMA16(lds_frag_tr2(vb + dt * 32, vb + 16 * XS + dt * 32), pf, o[dt]);
            asm volatile("" ::: "memory"); }
        const float inv = 1.f / l;
#pragma unroll
        for (int dt = 0; dt < 8; ++dt) { uint2 w; w.x = pg8::cvt_pk_bf16(o[dt][0] * inv, o[dt][1] * inv); w.y = pg8::cvt_pk_bf16(o[dt][2] * inv, o[dt][3] * inv);
            *(uint2*)(qrow + 16 * dt + 4 * quad) = w; }
    }
}

constexpr int DS = 144;
struct DilUnit { int b, g, h, r, res, blk, k; };
__device__ __forceinline__ DilUnit dil_decode(int vc, int i) {
    DilUnit d; d.g = i >> 1; d.k = i & 1; const int bh = vc >> 4; d.b = bh >> 2; d.h = bh & 3;
    if (d.g == 0) { d.r = 1; d.res = 0; d.blk = 2 * (vc & 15) + d.k; }
    else if (d.g == 1) { d.r = 4; d.res = (vc >> 2) & 3; d.blk = 2 * (vc & 3) + d.k; }
    else { d.r = 16; d.res = vc & 15; d.blk = d.k; }
    return d;
}
struct DilPre { v4u kw[4], vw[4]; bf16x8 qraw[2]; f32x4 kg0, kg1; };
__device__ __forceinline__ void dil_load(const bf16* Z, const float* kg, const DilUnit& d, int tid, int wave, DilPre& p) {
    const int colk = Z_DK + d.g * 256 + d.h * 64, colv = Z_DV + d.g * 256 + d.h * 64, colq = Z_DQ + d.g * 256 + d.h * 64;
#pragma unroll
    for (int it = 0; it < 4; ++it) { const int c = tid + 512 * it, j = c >> 3, ch = c & 7, ak0 = 128 * (d.blk - 1) + j, ak = ak0 < 0 ? 0 : ak0;
        if (it < 2 && d.k) continue;
        const bf16* rowp = Z + (size_t)(d.b * SEQ + ak * d.r + d.res) * ZW; p.kw[it] = *(const v4u*)(rowp + colk + ch * 8); p.vw[it] = *(const v4u*)(rowp + colv + ch * 8); }
    const int lane = tid & 63, i16 = lane & 15, quad = lane >> 4, aq = 128 * d.blk + 16 * wave + i16;
    const bf16* qrow = Z + (size_t)(d.b * SEQ + aq * d.r + d.res) * ZW + colq;
#pragma unroll
    for (int ks = 0; ks < 2; ++ks) p.qraw[ks] = *(const bf16x8*)(qrow + 32 * ks + 8 * quad);
    p.kg0 = *(const f32x4*)(kg + d.g * 64 + (tid & 7) * 8); p.kg1 = *(const f32x4*)(kg + d.g * 64 + (tid & 7) * 8 + 4);
}
__device__ __forceinline__ void dil_stage(LAS unsigned char* Ks, LAS unsigned char* Vs, const DilUnit& d, int tid, const DilPre& p) {
    const f32x4 g0 = p.kg0, g1 = p.kg1;
#pragma unroll
    for (int it = 0; it < 4; ++it) { const int c = tid + 512 * it, j0 = c >> 3, ch = c & 7; const bool ok = d.blk > 0 || j0 >= 128;
        if (it < 2 && d.k) continue;
        const int j = d.k ? j0 - 128 : j0;
        const v4u kwv = ok ? p.kw[it] : (v4u){0u, 0u, 0u, 0u}, vwv = ok ? p.vw[it] : (v4u){0u, 0u, 0u, 0u};
        const bf16x8 kr = __builtin_bit_cast(bf16x8, kwv); float kv[8]; float ss = 0.f;
#pragma unroll
        for (int e = 0; e < 8; ++e) { kv[e] = bfs(kr[e]); ss += kv[e] * kv[e]; }
        ss += DPP_F(ss, 0xB1, 0xf); ss += DPP_F(ss, 0x4E, 0xf); ss += DPP_F(ss, 0x141, 0xf);
        const float rstd = rsqrtf(ss * (1.f / 64) + EPS);
        f32x4 a, c2; a[0] = kv[0] * rstd * g0[0]; a[1] = kv[1] * rstd * g0[1]; a[2] = kv[2] * rstd * g0[2]; a[3] = kv[3] * rstd * g0[3];
        c2[0] = kv[4] * rstd * g1[0]; c2[1] = kv[5] * rstd * g1[1]; c2[2] = kv[6] * rstd * g1[2]; c2[3] = kv[7] * rstd * g1[3];
        *(LAS bf16x8*)(Ks + j * DS + ch * 16) = pack8(a, c2); *(LAS v4u*)(Vs + j * DS + ch * 16) = vwv; }
}
__device__ __forceinline__ void dil_compute(const LAS unsigned char* Ks, const LAS unsigned char* Vs, bf16* Z, const f32x4 (&qgv)[2][2], float* LSE, const DilUnit& d, int tid, int w, const bf16x8 (&qraw)[2]) {
    const int lane = tid & 63, i16 = lane & 15, quad = lane >> 4, g = d.g, blk = d.blk;
    const int aq = 128 * blk + 16 * w + i16;
    const int mrow = d.b * SEQ + aq * d.r + d.res;
    bf16* qrow = Z + (size_t)mrow * ZW + Z_DQ + g * 256 + d.h * 64;
    bf16x8 qf[2]; { float qv[2][8]; float ss = 0.f;
#pragma unroll
        for (int ks = 0; ks < 2; ++ks) {
#pragma unroll
            for (int e = 0; e < 8; ++e) { qv[ks][e] = bfs(qraw[ks][e]); ss += qv[ks][e] * qv[ks][e]; } }
        const float rstd = rsqrtf(quad_sum(ss) * (1.f / 64) + EPS) * 0.125f;
#pragma unroll
        for (int ks = 0; ks < 2; ++ks) { const f32x4 g0 = qgv[ks][0], g1 = qgv[ks][1];
            f32x4 a, c2; a[0] = qv[ks][0] * rstd * g0[0]; a[1] = qv[ks][1] * rstd * g0[1]; a[2] = qv[ks][2] * rstd * g0[2]; a[3] = qv[ks][3] * rstd * g0[3];
            c2[0] = qv[ks][4] * rstd * g1[0]; c2[1] = qv[ks][5] * rstd * g1[1]; c2[2] = qv[ks][6] * rstd * g1[2]; c2[3] = qv[ks][7] * rstd * g1[3];
            qf[ks] = pack8(a, c2); } }
    f32x4 s[10]; float mx = -INFINITY;
#pragma unroll
    for (int dj = 0; dj < 9; ++dj) { s[dj] = (f32x4){0.f, 0.f, 0.f, 0.f};
#pragma unroll
        for (int ks = 0; ks < 2; ++ks) s[dj] = MFMA16(lds_frag(Ks + (16 * ((w + dj + 8 * d.k) & 15) + i16) * DS + (32 * ks + 8 * quad) * 2), qf[ks], s[dj]);
#pragma unroll
        for (int rg = 0; rg < 4; ++rg) { const int jj = 16 * dj + 4 * quad + rg; const bool ok = (jj >= i16) && (jj <= i16 + 128) && (blk > 0 || 16 * w + jj >= 128);
            s[dj][rg] = ok ? s[dj][rg] : -INFINITY; mx = fmaxf(mx, s[dj][rg]); } }
    mx = quad_max(mx);
    float l = 0.f;
#pragma unroll
    for (int dj = 0; dj < 9; ++dj)
#pragma unroll
        for (int rg = 0; rg < 4; ++rg) { s[dj][rg] = __expf(s[dj][rg] - mx); l += s[dj][rg]; }
    l = quad_sum(l);
    s[9] = (f32x4){0.f, 0.f, 0.f, 0.f};
    f32x4 o[4];
#pragma unroll
    for (int dt = 0; dt < 4; ++dt) o[dt] = (f32x4){0.f, 0.f, 0.f, 0.f};
#pragma unroll
    for (int kk = 0; kk < 5; ++kk) { const bf16x8 pf = pack8(s[2 * kk], s[2 * kk + 1]);
        const int t0 = w + 2 * kk, t1 = t0 + 1, p0 = (t0 + 8 * d.k) & 15, p1 = t1 < 16 ? ((t1 + 8 * d.k) & 15) : 16;
        const LAS unsigned char* vb0 = Vs + (16 * p0 + 4 * quad + (i16 >> 2)) * DS + (4 * (i16 & 3)) * 2; const LAS unsigned char* vb1 = Vs + (16 * p1 + 4 * quad + (i16 >> 2)) * DS + (4 * (i16 & 3)) * 2;
#pragma unroll
        for (int dt = 0; dt < 4; ++dt) o[dt] = MFMA16(lds_frag_tr2(vb0 + dt * 32, vb1 + dt * 32), pf, o[dt]); }
    const float inv = 1.f / l;
#pragma unroll
    for (int dt = 0; dt < 4; ++dt) { uint2 wv; wv.x = pg8::cvt_pk_bf16(o[dt][0] * inv, o[dt][1] * inv); wv.y = pg8::cvt_pk_bf16(o[dt][2] * inv, o[dt][3] * inv);
        *(uint2*)(qrow + 16 * dt + 4 * quad) = wv; }
    LSE[((size_t)g * M + mrow) * 4 + d.h] = mx + __logf(l);
}
__device__ __forceinline__ void dil_phase(const Frame& F, bf16* Z, const float* qg, const float* kg, float* LSE, int c) {
    LAS unsigned char* Ks = F.lds; LAS unsigned char* Vs = F.lds + 256 * DS;
    const int tid = F_TID;
    __syncthreads();
    if (tid < 128) *(LAS v4u*)(Vs + (256 + (tid >> 3)) * DS + (tid & 7) * 16) = (v4u){0u, 0u, 0u, 0u};
    if (c >= 256) return;
    DilUnit cur = dil_decode(c, 0); DilPre pre; dil_load(Z, kg, cur, tid, F.wave, pre);
    for (int vc = c; vc < 256; vc += F.G)
    for (int i = 0; i < 6; ++i) {
        __syncthreads();
        dil_stage(Ks, Vs, cur, tid, pre);
        bf16x8 qr[2] = {pre.qraw[0], pre.qraw[1]};
        __syncthreads();
        const DilUnit now = cur;
        f32x4 qgv[2][2];
#pragma unroll
        for (int ks = 0; ks < 2; ++ks) { qgv[ks][0] = *(const f32x4*)(qg + now.g * 64 + 32 * ks + 8 * ((tid & 63) >> 4)); qgv[ks][1] = *(const f32x4*)(qg + now.g * 64 + 32 * ks + 8 * ((tid & 63) >> 4) + 4); }
        { const int ni = i < 5 ? i + 1 : 0, nvc = i < 5 ? vc : vc + F.G;
          cur = dil_decode(nvc < 256 ? nvc : c, nvc < 256 ? ni : 0); dil_load(Z, kg, cur, tid, F.wave, pre); }
        asm volatile("" ::: "memory");
        dil_compute(Ks, Vs, Z, qgv, LSE, now, tid, F.wave, qr);
    }
}
__device__ __forceinline__ void dil_merge_phase(const Frame& F, bf16* Z, const float* LSE) {
    const int gt = F.gw * 64 + F_LANE, NT = F.NGW * 64;
    for (int it0 = gt; it0 < M * 32; it0 += 2 * NT) {
        float l[2][3]; bf16x8 av[2][3]; bf16* pp[2];
#pragma unroll
        for (int q = 0; q < 2; ++q) { const int it = it0 + q * NT; const int m = (it < M * 32) ? (it >> 5) : 0, h = (it >> 3) & 3, ch = it & 7;
            l[q][0] = LSE[((size_t)0 * M + m) * 4 + h]; l[q][1] = LSE[((size_t)1 * M + m) * 4 + h]; l[q][2] = LSE[((size_t)2 * M + m) * 4 + h];
            pp[q] = Z + (size_t)m * ZW + Z_DQ + h * 64 + ch * 8;
            av[q][0] = *(const bf16x8*)pp[q]; av[q][1] = *(const bf16x8*)(pp[q] + 256); av[q][2] = *(const bf16x8*)(pp[q] + 512); }
#pragma unroll
        for (int q = 0; q < 2; ++q) { if (it0 + q * NT >= M * 32) break;
            const float mxl = fmaxf(l[q][0], fmaxf(l[q][1], l[q][2])), e0 = __expf(l[q][0] - mxl), e1 = __expf(l[q][1] - mxl), e2 = __expf(l[q][2] - mxl), inv = 1.f / (e0 + e1 + e2);
            f32x4 x, y;
#pragma unroll
            for (int e = 0; e < 4; ++e) { x[e] = (e0 * bfs(av[q][0][e]) + e1 * bfs(av[q][1][e]) + e2 * bfs(av[q][2][e])) * inv; y[e] = (e0 * bfs(av[q][0][e + 4]) + e1 * bfs(av[q][1][e + 4]) + e2 * bfs(av[q][2][e + 4])) * inv; }
            *(bf16x8*)pp[q] = pack8(x, y); }
    }
}

constexpr int MS = 272;
__device__ __forceinline__ void conv_silu8(const bf16* Z, const float* cw, int m, int c0, float (&y)[8]) {
    const int t = m % SEQ;
#pragma unroll
    for (int e = 0; e < 8; ++e) y[e] = 0.f;
#pragma unroll
    for (int j = 0; j < 4; ++j) { if (t - 3 + j >= 0) { const bf16x8 z = *(const bf16x8*)(Z + (size_t)(m - 3 + j) * ZW + c0);
            const f32x4 w0 = *(const f32x4*)(cw + j * 1024 + c0), w1 = *(const f32x4*)(cw + j * 1024 + c0 + 4);
            y[0] += w0[0] * bfs(z[0]); y[1] += w0[1] * bfs(z[1]); y[2] += w0[2] * bfs(z[2]); y[3] += w0[3] * bfs(z[3]);
            y[4] += w1[0] * bfs(z[4]); y[5] += w1[1] * bfs(z[5]); y[6] += w1[2] * bfs(z[6]); y[7] += w1[3] * bfs(z[7]); } }
#pragma unroll
    for (int e = 0; e < 8; ++e) y[e] = y[e] * pg8::fast_sigmoid(y[e]);
}
struct ConvRows { f32x4 w[4][2]; bf16x8 z[7]; };
__device__ __forceinline__ void conv_load(const bf16* Z, const float* cw, int m, int c0, ConvRows& R) {
    const int t = m % SEQ;
#pragma unroll
    for (int j = 0; j < 4; ++j) { R.w[j][0] = *(const f32x4*)(cw + j * 1024 + c0); R.w[j][1] = *(const f32x4*)(cw + j * 1024 + c0 + 4); }
#pragma unroll
    for (int i = 0; i < 7; ++i) { const int back = (t - 3 + i >= 0) ? (3 - i) : -i; R.z[i] = *(const bf16x8*)(Z + (size_t)(m - back) * ZW + c0); }
}
__device__ __forceinline__ void conv_finish(const ConvRows& R, int m, float (&y)[4][8]) {
    const int t = m % SEQ;
    bf16x8 z[7];
#pragma unroll
    for (int i = 0; i < 7; ++i) z[i] = (t - 3 + i >= 0) ? R.z[i] : (bf16x8){0, 0, 0, 0, 0, 0, 0, 0};
#pragma unroll
    for (int r = 0; r < 4; ++r) {
#pragma unroll
        for (int e = 0; e < 8; ++e) { float acc = 0.f;
#pragma unroll
            for (int j = 0; j < 4; ++j) acc += R.w[j][e >> 2][e & 3] * bfs(z[r + j][e]);
            y[r][e] = acc * pg8::fast_sigmoid(acc); } }
}
__device__ __forceinline__ void conv_silu8x4(const bf16* Z, const float* cw, int m, int c0, float (&y)[4][8]) { ConvRows R; conv_load(Z, cw, m, c0, R); conv_finish(R, m, y); }
__device__ __forceinline__ void wave_scan_sum2(float v0, float v1, int lane, float& p0, float& p1) {
    float p = v0 + v1;
#pragma unroll
    for (int off = 1; off < 64; off <<= 1) { const float t = __shfl_up(p, off); if (lane >= off) p += t; }
    p1 = p; p0 = p - v1;
}
__device__ __forceinline__ void wave_scan_max2(float v0, float v1, int lane, float& p0, float& p1) {
    float p = fmaxf(v0, v1);
#pragma unroll
    for (int off = 1; off < 64; off <<= 1) { const float t = __shfl_up(p, off); if (lane >= off) p = fmaxf(p, t); }
    const float prev = __shfl_up(p, 1);
    p1 = p; p0 = (lane > 0) ? fmaxf(prev, v0) : v0;
}
__device__ __forceinline__ void ml_local_fast(const Frame& F, const bf16* Z, const float* cw, const float* ifg, float* CL, float* NL, float* SC, int u) {
    LAS unsigned char* Ks = F.lds; LAS unsigned char* Vs = F.lds + 128 * MS; LAS float* av = (LAS float*)(F.lds + 256 * MS); LAS float* npart = av + 128;
    const int c = u % NCHUNK, h = (u / NCHUNK) % 4, b = u / (NCHUNK * 4), tid = F_TID, lane = tid & 63, i16 = lane & 15, quad = lane >> 4;
    const int m0 = b * SEQ + c * 128;
    const int sg = tid >> 4, ch = tid & 15;
    ConvRows rk; conv_load(Z, cw, m0 + 4 * sg, 512 + h * 128 + ch * 8, rk);
    v4u vr[4];
#pragma unroll
    for (int r = 0; r < 4; ++r) vr[r] = *(const v4u*)(Z + (size_t)(m0 + 4 * sg + r) * ZW + Z_MV + h * 128 + ch * 8);
    __syncthreads();
    if (F.wave == 0) {
        const float f0 = log_sigmoid_(ifg[(size_t)(m0 + 2 * lane) * 8 + 4 + h]), f1 = log_sigmoid_(ifg[(size_t)(m0 + 2 * lane + 1) * 8 + 4 + h]);
        float b0, b1; wave_scan_sum2(f0, f1, lane, b0, b1);
        const float bl = __shfl(b1, 63);
        const float le0 = bl - b0 + ifg[(size_t)(m0 + 2 * lane) * 8 + h], le1 = bl - b1 + ifg[(size_t)(m0 + 2 * lane + 1) * 8 + h];
        const float ml = wave_max(fmaxf(le0, le1));
        av[2 * lane] = __expf(le0 - ml); av[2 * lane + 1] = __expf(le1 - ml);
        if (lane == 0) { SC[u * 4 + 0] = bl; SC[u * 4 + 1] = ml; }
    }
    __syncthreads();
    { float y[4][8];
      conv_finish(rk, m0 + 4 * sg, y);
#pragma unroll
      for (int r = 0; r < 4; ++r) { const int s = 4 * sg + r; const float sc = 0.08838834764831845f * av[s];
          f32x4 a, c2; a[0] = y[r][0] * sc; a[1] = y[r][1] * sc; a[2] = y[r][2] * sc; a[3] = y[r][3] * sc; c2[0] = y[r][4] * sc; c2[1] = y[r][5] * sc; c2[2] = y[r][6] * sc; c2[3] = y[r][7] * sc;
          *(LAS bf16x8*)(Ks + s * MS + ch * 16) = pack8(a, c2);
          *(LAS v4u*)(Vs + s * MS + ch * 16) = vr[r]; } }
    __syncthreads();
    { const int d = tid & 127, sq = tid >> 7; float acc = 0.f;
      for (int s = sq * 32; s < sq * 32 + 32; ++s) acc += bfs(*(const LAS short*)(Ks + s * MS + d * 2));
      npart[sq * 128 + d] = acc; }
    const int w = F.wave;
    f32x4 acc[8];
#pragma unroll
    for (int dt = 0; dt < 8; ++dt) acc[dt] = (f32x4){0.f, 0.f, 0.f, 0.f};
#pragma unroll
    for (int ks = 0; ks < 4; ++ks) {
        const int rbase = 32 * ks + 8 * quad + (i16 >> 2), cb = 4 * (i16 & 3) * 2;
        const bf16x8 af = lds_frag_tr2(Vs + rbase * MS + 16 * w * 2 + cb, Vs + (rbase + 4) * MS + 16 * w * 2 + cb);
#pragma unroll
        for (int dt = 0; dt < 8; ++dt) acc[dt] = MFMA16(af, lds_frag_tr2(Ks + rbase * MS + dt * 32 + cb, Ks + (rbase + 4) * MS + dt * 32 + cb), acc[dt]); }
    float* ct = CL + (size_t)u * 16384;
#pragma unroll
    for (int dt = 0; dt < 8; ++dt)
#pragma unroll
        for (int rg = 0; rg < 4; ++rg) ct[(16 * w + 4 * quad + rg) * 128 + 16 * dt + i16] = acc[dt][rg];
    __syncthreads();
    if (tid < 128) NL[(size_t)u * 128 + tid] = (npart[tid] + npart[128 + tid]) + (npart[256 + tid] + npart[384 + tid]);
}
__device__ __forceinline__ void ml_out_fast(const Frame& F, const bf16* Z, const float* cw, const float* ifg, const float* CP, const float* NP, const float* SC, const float* ng, bf16* HA, int u, const XcdBarrier& bar, int wait_inst) {
    LAS unsigned char* Qs = F.lds; LAS unsigned char* Ks = Qs + 128 * MS; LAS unsigned char* Vs = Ks + 128 * MS; LAS unsigned char* Cs = Vs + 128 * MS;
    LAS float* gv = (LAS float*)(Cs + 144 * MS); LAS float* cmx = gv + 128; LAS float* bv = cmx + 128;
    const int c = u % NCHUNK, h = (u / NCHUNK) % 4, b = u / (NCHUNK * 4), tid = F_TID, lane = tid & 63, i16 = lane & 15, quad = lane >> 4;
    const int m0 = b * SEQ + c * 128;
    float mprev = 0.f;
    const int sg = tid >> 4, ch = tid & 15;
    ConvRows rq, rk; conv_load(Z, cw, m0 + 4 * sg, h * 128 + ch * 8, rq); conv_load(Z, cw, m0 + 4 * sg, 512 + h * 128 + ch * 8, rk);
    v4u vr[4]; f32x4 cp[4][2];
#pragma unroll
    for (int r = 0; r < 4; ++r) vr[r] = *(const v4u*)(Z + (size_t)(m0 + 4 * sg + r) * ZW + Z_MV + h * 128 + ch * 8);
    if (wait_inst < 0) {
#pragma unroll
        for (int r = 0; r < 4; ++r) { const int s = 4 * sg + r; cp[r][0] = *(const f32x4*)(CP + (size_t)u * 16384 + s * 128 + ch * 8); cp[r][1] = *(const f32x4*)(CP + (size_t)u * 16384 + s * 128 + ch * 8 + 4); } }
    __syncthreads();
#define ML_OUT_GATES() do { mprev = SC[u * 4 + 2]; if (F.wave == 0) { \
        const float f0 = log_sigmoid_(ifg[(size_t)(m0 + 2 * lane) * 8 + 4 + h]), f1 = log_sigmoid_(ifg[(size_t)(m0 + 2 * lane + 1) * 8 + 4 + h]); \
        float b0, b1; wave_scan_sum2(f0, f1, lane, b0, b1); \
        const float g0 = ifg[(size_t)(m0 + 2 * lane) * 8 + h] - b0, g1 = ifg[(size_t)(m0 + 2 * lane + 1) * 8 + h] - b1; \
        float c0, c1; wave_scan_max2(g0, g1, lane, c0, c1); \
        gv[2 * lane] = g0; gv[2 * lane + 1] = g1; cmx[2 * lane] = fmaxf(c0, mprev); cmx[2 * lane + 1] = fmaxf(c1, mprev); bv[2 * lane] = b0; bv[2 * lane + 1] = b1; } } while (0)
    if (wait_inst < 0) ML_OUT_GATES();
    { float y[4][8];
      conv_finish(rq, m0 + 4 * sg, y);
#pragma unroll
      for (int r = 0; r < 4; ++r) { f32x4 a, c2; a[0] = y[r][0]; a[1] = y[r][1]; a[2] = y[r][2]; a[3] = y[r][3]; c2[0] = y[r][4]; c2[1] = y[r][5]; c2[2] = y[r][6]; c2[3] = y[r][7];
          *(LAS bf16x8*)(Qs + (4 * sg + r) * MS + ch * 16) = pack8(a, c2); }
      conv_finish(rk, m0 + 4 * sg, y);
#pragma unroll
      for (int r = 0; r < 4; ++r) { const float sc = 0.08838834764831845f; f32x4 a, c2; a[0] = y[r][0] * sc; a[1] = y[r][1] * sc; a[2] = y[r][2] * sc; a[3] = y[r][3] * sc; c2[0] = y[r][4] * sc; c2[1] = y[r][5] * sc; c2[2] = y[r][6] * sc; c2[3] = y[r][7] * sc;
          *(LAS bf16x8*)(Ks + (4 * sg + r) * MS + ch * 16) = pack8(a, c2); }
#pragma unroll
      for (int r = 0; r < 4; ++r) *(LAS v4u*)(Vs + (4 * sg + r) * MS + ch * 16) = vr[r];
      if (wait_inst >= 0) { split_wait(bar, wait_inst, tid); ML_OUT_GATES();
#pragma unroll
          for (int r = 0; r < 4; ++r) { const int s = 4 * sg + r; cp[r][0] = *(const f32x4*)(CP + (size_t)u * 16384 + s * 128 + ch * 8); cp[r][1] = *(const f32x4*)(CP + (size_t)u * 16384 + s * 128 + ch * 8 + 4); } }
#pragma unroll
      for (int r = 0; r < 4; ++r) *(LAS bf16x8*)(Cs + (4 * sg + r) * MS + ch * 16) = pack8(cp[r][0], cp[r][1]); }
#undef ML_OUT_GATES
    for (int it = tid; it < 16 * 16; it += 512) { const int rr = it >> 4, ch = it & 15;
        f32x4 p0 = (f32x4){0.f, 0.f, 0.f, 0.f}, p1 = p0;
        if (rr == 0) { p0 = *(const f32x4*)(NP + (size_t)u * 128 + ch * 8); p1 = *(const f32x4*)(NP + (size_t)u * 128 + ch * 8 + 4); }
        *(LAS bf16x8*)(Cs + (128 + rr) * MS + ch * 16) = pack8(p0, p1); }
    __syncthreads();
    const int w = F.wave, t = 16 * w + i16;
    const bf16* mo = Z + (size_t)(m0 + t) * ZW + Z_MO + h * 128; bf16* op = (bf16*)mo;
    uint2 mwv[8]; f32x4 ggv[8];
#pragma unroll
    for (int et = 0; et < 8; ++et) { const int e0 = 16 * et + 4 * quad; mwv[et] = *(const uint2*)(mo + e0); ggv[et] = *(const f32x4*)(ng + h * 128 + e0); }
    asm volatile("" ::: "memory");
    bf16x8 qf[4];
#pragma unroll
    for (int ks = 0; ks < 4; ++ks) qf[ks] = lds_frag(Qs + t * MS + (32 * ks + 8 * quad) * 2);
    f32x4 acc[9];
#pragma unroll
    for (int et = 0; et < 9; ++et) { acc[et] = (f32x4){0.f, 0.f, 0.f, 0.f};
#pragma unroll
        for (int ks = 0; ks < 4; ++ks) acc[et] = MFMA16(lds_frag(Cs + (16 * et + i16) * MS + (32 * ks + 8 * quad) * 2), qf[ks], acc[et]); }
    const float cm = cmx[t], winter = __expf(mprev - cm);
    const float qn = __shfl(acc[8][0], i16);
#pragma unroll
    for (int et = 0; et < 8; ++et) acc[et] = acc[et] * winter;
    float den = winter * qn;
    f32x4 sv[8]; float dsum = 0.f;
#pragma unroll
    for (int js = 0; js < 8; ++js) { sv[js] = (f32x4){0.f, 0.f, 0.f, 0.f};
        if (js <= w) {
#pragma unroll
            for (int ks = 0; ks < 4; ++ks) sv[js] = MFMA16(lds_frag(Ks + (16 * js + i16) * MS + (32 * ks + 8 * quad) * 2), qf[ks], sv[js]);
#pragma unroll
            for (int rg = 0; rg < 4; ++rg) { const int s = 16 * js + 4 * quad + rg; const float wgt = (s <= t) ? __expf(gv[s] - cm) : 0.f; sv[js][rg] *= wgt; dsum += sv[js][rg]; } } }
    den += quad_sum(dsum);
#pragma unroll
    for (int kk = 0; kk < 4; ++kk) { if (2 * kk <= w) { const bf16x8 pf = pack8(sv[2 * kk], sv[2 * kk + 1]);
            const LAS unsigned char* vb = Vs + (32 * kk + 4 * quad + (i16 >> 2)) * MS + (4 * (i16 & 3)) * 2;
#pragma unroll
            for (int et = 0; et < 8; ++et) acc[et] = MFMA16(lds_frag_tr2(vb + et * 32, vb + 16 * MS + et * 32), pf, acc[et]); } }
    const float dn = fmaxf(fabsf(den), __expf(-bv[t] - cm)), inv = 1.f / dn;
    float ss = 0.f;
#pragma unroll
    for (int et = 0; et < 8; ++et) { acc[et] = acc[et] * inv; ss += (acc[et][0] * acc[et][0] + acc[et][1] * acc[et][1]) + (acc[et][2] * acc[et][2] + acc[et][3] * acc[et][3]); }
    const float rstd = rsqrtf(quad_sum(ss) * (1.f / 128) + EPS);
#pragma unroll
    for (int et = 0; et < 8; ++et) { const int e0 = 16 * et + 4 * quad; const uint2 mw = mwv[et]; const f32x4 gg = ggv[et];
        const float o0 = acc[et][0] * rstd * gg[0] * pg8::fast_sigmoid(pg8::bflo(mw.x)), o1 = acc[et][1] * rstd * gg[1] * pg8::fast_sigmoid(pg8::bfhi(mw.x));
        const float o2 = acc[et][2] * rstd * gg[2] * pg8::fast_sigmoid(pg8::bflo(mw.y)), o3 = acc[et][3] * rstd * gg[3] * pg8::fast_sigmoid(pg8::bfhi(mw.y));
        uint2 wv; wv.x = pg8::cvt_pk_bf16(o0, o1); wv.y = pg8::cvt_pk_bf16(o2, o3); *(uint2*)(op + e0) = wv; }
}
#define MEGA_TOKEN_MIXER_PHASES \
    if (IN(PH_P2)) { \
        for (int u = c; u < 512; u += F.G) ml_local_fast(F, Z, args.in[4], (const float*)(ws + WS_IFG), (float*)(ws + WS_CL), (float*)(ws + WS_NL), (float*)(ws + WS_MSC), u); \
        split_arrive(bar, 0, F_TID);                              \
        for (int job = c; job < 256; job += F.G) cross_job(F, Z, (const bf16*)(ws + WS_KVM), args.in[12], args.in[13], job); \
        dil_phase(F, Z, args.in[8], args.in[9], (float*)(ws + WS_LSE), c); \
        split_arrive(bar, 1, F_TID);                              \
    } \
    if (IN(PH_SCAN)) { split_wait(bar, 0, F_TID); ml_scan_phase(F, (float*)(ws + WS_CL), (float*)(ws + WS_NL), (float*)(ws + WS_MSC)); \
        split_wait(bar, 1, F_TID); dil_merge_phase(F, Z, (const float*)(ws + WS_LSE)); \
        split_arrive(bar, 5, F_TID);                              } \
    if (IN(PH_MLOUT)) { int wi_ = 5; \
        for (int u = c; u < 512; u += F.G) { ml_out_fast(F, Z, args.in[4], (const float*)(ws + WS_IFG), (const float*)(ws + WS_CL), (const float*)(ws + WS_NL), (const float*)(ws + WS_MSC), args.in[7], (bf16*)(ws + WS_HA), u, bar, wi_); wi_ = -1; } \
        if (wi_ >= 0) split_wait(bar, 5, F_TID); \
        split_arrive(bar, 2, F_TID);                              \
    }
__device__ __forceinline__ void p0_prologue(const Frame& F, const Args& a) {
    const float* x = a.in[0]; const float* mem = a.in[1]; const float* ln1_g = a.in[2]; const float* w_in = a.in[3];
    const float* m_i_b = a.in[5]; const float* m_f_b = a.in[6]; const float* mem_norm_g = a.in[10]; const float* w_mem_kv = a.in[11];
    unsigned char* ws = a.ws;
    bf16* XN = (bf16*)a.out; float* IFG = (float*)(ws + WS_IFG);
    LAS float* wif = (LAS float*)(F.lds + 8 * 8448);
    { const int t0 = F_TID; f32x4 wa[2], wb[2];
#pragma unroll
      for (int i = 0; i < 2; ++i) { const int k = t0 + 512 * i; wa[i] = *(const f32x4*)(w_in + (size_t)k * IN_TOTAL + 2048); wb[i] = *(const f32x4*)(w_in + (size_t)k * IN_TOTAL + 2052); }
#pragma unroll
      for (int i = 0; i < 2; ++i) { const int k = t0 + 512 * i;
        wif[k] = wa[i].x; wif[1024 + k] = wa[i].y; wif[2048 + k] = wa[i].z; wif[3072 + k] = wa[i].w; wif[4096 + k] = wb[i].x; wif[5120 + k] = wb[i].y; wif[6144 + k] = wb[i].z; wif[7168 + k] = wb[i].w; } }
    __syncthreads();
    constexpr int I0 = 16 * 64, I1 = 16 * 88, I3 = 16 * 32;
    constexpr int NITEMS = I0 + I1 + I3;
    for (int it = F.gw; it < NITEMS; it += F.NGW) {
        int r = it;
        if (r < I0) { p0_transpose_item(w_in, IN_TOTAL, 1024, (bf16*)(ws + WS_W1Z), r / 64, r % 64, F_LANE); continue; } r -= I0;
        if (r < I1) { p0_transpose_item(w_in + 2056, IN_TOTAL, 1024, (bf16*)(ws + WS_W1Z) + (size_t)2048 * 1024, r / 88, r % 88, F_LANE); continue; } r -= I1;
        p0_transpose_item(w_mem_kv, 1024, 1024, (bf16*)(ws + WS_WKV), r / 32, r % 32, F_LANE);
    }
    if (F.G != 256) cv_range(a, CV_WGU, CV_WGU + CV_LATE, F.gw, F.NGW, F_LANE);
    f32x4 g1v[4]; gain_load(ln1_g, F_LANE, g1v);
    for (int mb = F.gw; mb < M; mb += 4 * F.NGW) {
        f32x4 vv[4][4];
#pragma unroll
        for (int q = 0; q < 4; ++q) { const int m = mb + q * F.NGW; if (m < M) row_load(x + (size_t)m * D, F_LANE, vv[q]); }
#pragma unroll
        for (int q = 0; q < 4; ++q) { const int m = mb + q * F.NGW; if (m >= M) break;
            f32x4 (&v)[4] = vv[q];
            rms_row_finish(g1v, XN + (size_t)m * D, F_LANE, v);
            float acc[8];
#pragma unroll
            for (int j = 0; j < 8; ++j) { float s = 0.f;
#pragma unroll
                for (int jj = 0; jj < 4; ++jj) { const f32x4 w4 = *(const LAS f32x4*)(wif + j * 1024 + 4 * F_LANE + 256 * jj); s += (v[jj].x * w4.x + v[jj].y * w4.y) + (v[jj].z * w4.z + v[jj].w * w4.w); }
                acc[j] = wave_sum(s); }
            if (F_LANE == 0) {
                f32x4 o0, o1;
                o0.x = acc[0] + m_i_b[0]; o0.y = acc[1] + m_i_b[1]; o0.z = acc[2] + m_i_b[2]; o0.w = acc[3] + m_i_b[3];
                o1.x = acc[4] + m_f_b[0]; o1.y = acc[5] + m_f_b[1]; o1.z = acc[6] + m_f_b[2]; o1.w = acc[7] + m_f_b[3];
                *(f32x4*)(IFG + (size_t)m * 8) = o0; *(f32x4*)(IFG + (size_t)m * 8 + 4) = o1;
            }
        }
    }
    { f32x4 gmv[4]; gain_load(mem_norm_g, F_LANE, gmv);
      for (int m = F.gw; m < MROWS; m += F.NGW) { f32x4 v[4]; row_load(mem + (size_t)m * D, F_LANE, v); rms_row_finish(gmv, (bf16*)(ws + WS_MEMN) + (size_t)m * D, F_LANE, v); } }
}

__device__ __forceinline__ void kv_norm_tile(const Frame& F, bf16* KVM, const float* kg, int pm, int pn) {
    VM_WAIT(); __syncthreads();
    const float g0 = kg[2 * F_LANE], g1 = kg[2 * F_LANE + 1];
    for (int it = F.wave; it < 512; it += NWAVES) {
        const int row = pm * 256 + (it >> 1), h = pn * 2 + (it & 1);
        unsigned* p = (unsigned*)(KVM + (size_t)row * 1024 + h * 128) + F_LANE;
        const unsigned w = __hip_atomic_load(p, RLX_AGENT);
        const float a = pg8::bflo(w), b = pg8::bfhi(w);
        const float rstd = rsqrtf(wave_sum(a * a + b * b) * (1.f / 128) + EPS);
        *p = pk2(a * rstd * g0, b * rstd * g1);
    }
}

__global__ void __launch_bounds__(NWAVES * 64, 2) mega_fwd(Args args) {
    extern __shared__ __attribute__((aligned(16))) unsigned char lds_raw[];
    Frame F;
    F.lds = (LAS unsigned char*)lds_raw;
    F.wave = __builtin_amdgcn_readfirstlane((int)threadIdx.x >> 6);
    F.G = gridDim.x;
    { const int bx = blockIdx.x; const int vcu = (F.G % 8 == 0) ? (bx % 8) * (F.G / 8) + bx / 8 : bx; F.gw = vcu * NWAVES + F.wave; F.NGW = F.G * NWAVES; }
    unsigned char* ws = args.ws;
    gu32* ctl = (gu32*)(ws + WS_CTL);
    volatile LAS unsigned* MISC = (volatile LAS unsigned*)(F.lds + MISC_OFF);
    for (int u = F_TID; u < (LDS_BYTES - LDSCTL_OFF) / 4; u += NWAVES * 64) ((LAS unsigned*)(F.lds + LDSCTL_OFF))[u] = 0u;
    __syncthreads();
    const int lo = args.ph_lo, hi = args.ph_hi;
    XcdBarrier bar = xcd_barrier_post((unsigned*)(ctl + CW_BAR) + args.li * XCD_BAR_WORDS, MISC + 8, F_TID);
#ifndef PHASE_MASK
#define PHASE_MASK 0xFFFF
#endif
#define IN(k) (((PHASE_MASK >> (k)) & 1) && lo <= (k) && (k) < hi)
#define SEAM(k) do { if (IN(k) && IN((k) + 1)) xcd_barrier(bar, F_TID); } while (0)
    const int c = (int)blockIdx.x;
    bf16* XN = (bf16*)args.out; bf16* GS = (bf16*)((unsigned char*)args.out + 32 * MiB);
    bf16* Z = (bf16*)(ws + WS_Z);

    if (IN(PH_P0)) { p0_prologue(F, args); }
    SEAM(PH_P0);
    if (IN(PH_P1)) {
        { pg8::Gemm g{XN, (const bf16*)(ws + WS_W1Z), 1024, 1024, nullptr}; pg8::StaticOrder S; S.init(M, ZW, F.G, c);
          pg8::EpiStoreBf16 E{Z, ZW};
          pg8::gemm_phase<pg8::EpiStoreBf16, pg8::StaticOrder, true, false>(F.lds, g, S, E, F.wave); }
        { pg8::Gemm g{(const bf16*)(ws + WS_MEMN), (const bf16*)(ws + WS_WKV), 1024, 1024, nullptr}; pg8::StaticOrder S; S.init(MROWS, 1024, F.G, (c + 64) % F.G);
          pg8::EpiStoreBf16 E{(bf16*)(ws + WS_KVM), 1024};
          pg8::gemm_phase<pg8::EpiStoreBf16, pg8::StaticOrder, true, false>(F.lds, g, S, E, F.wave);
        }
        if (F.G == 256 && c >= 208) cv_range(args, CV_WGU, CV_WGU + CV_LATE, (c - 208) * NWAVES + F.wave, 48 * NWAVES, F_LANE);
    }
    SEAM(PH_P1);
    MEGA_TOKEN_MIXER_PHASES
    if (IN(PH_MIX)) {
        bf16* MIXED = (bf16*)(ws + WS_MIXED);
        const bf16* WGATE = (const bf16*)(ws + WS_WGATE); const bf16* WA = (const bf16*)(ws + WS_WA); const bf16* WB = (const bf16*)(ws + WS_WB); const bf16* WC = (const bf16*)(ws + WS_WC); const bf16* HA = Z + Z_MO;
        pg8::StaticOrder S; S.init(M, 1024, F.G, c);
        pg8::StaticOrder Sg0; Sg0.init(M, 1024, F.G, c, 0); pg8::StaticOrder Sg1; Sg1.init(M, 1024, F.G, c, 4); pg8::StaticOrder Sg2; Sg2.init(M, 1024, F.G, c, 8);
        pg8::Unit u0;
        if (S.next(0, u0)) {
            const size_t pm = (size_t)u0.pm * 256, pn = (size_t)u0.pn * 256;
            const pg8::Chain cA{HA + pm * ZW, WA + pn * 512, ZW, 512}, cG0{XN + pm * 1024, WGATE + pn * 1024, 1024, 1024}, cB{Z + Z_DQ + pm * ZW, WB + pn * 256, ZW, 256},
                             cG2{XN + pm * 1024, WGATE + (2048 + pn) * 1024, 1024, 1024}, cC{Z + Z_XQ + pm * ZW, WC + pn * 512, ZW, 512};
            { pg8::Gemm g{XN, WGATE, 1024, 1024, nullptr}; pg8::EpiGate E{GS, args.in[18] + 1024};
              pg8::gemm_phase<pg8::EpiGate, pg8::StaticOrder, true, false, 2>(F.lds, g, Sg1, E, F.wave, cB); }
            split_wait(bar, 2, F_TID);
            { pg8::Gemm g{Z + Z_DQ, WB, ZW, 256, nullptr}; pg8::EpiMix<0> E{GS, MIXED};
              pg8::gemm_phase<pg8::EpiMix<0>, pg8::StaticOrder, true, false, 3>(F.lds, g, S, E, F.wave, cG2); }
            { pg8::Gemm g{XN, WGATE, 1024, 1024, nullptr}; pg8::EpiGate E{GS, args.in[18] + 2048};
              pg8::gemm_phase<pg8::EpiGate, pg8::StaticOrder, true, false, 3>(F.lds, g, Sg2, E, F.wave, cC); }
            { pg8::Gemm g{Z + Z_XQ, WC, ZW, 512, nullptr}; pg8::EpiMix<1> E{GS, MIXED};
              pg8::gemm_phase<pg8::EpiMix<1>, pg8::StaticOrder, true, false, 3>(F.lds, g, S, E, F.wave, cG0); }
            { pg8::Gemm g{XN, WGATE, 1024, 1024, nullptr}; pg8::EpiGate E{GS, args.in[18]};
              pg8::gemm_phase<pg8::EpiGate, pg8::StaticOrder, true, false, 3>(F.lds, g, Sg0, E, F.wave, cA); }
            { pg8::Gemm g{HA, WA, ZW, 512, nullptr}; pg8::EpiMix<2> E{GS, MIXED};
              pg8::gemm_phase<pg8::EpiMix<2>, pg8::StaticOrder, true, false, 1>(F.lds, g, S, E, F.wave); }
        }
    }
    SEAM(PH_MIX);
    if (IN(PH_WOUT)) {
        pg8::StaticOrder S; S.init(M, 1024, F.G, c);
        pg8::Gemm g{GS, (const bf16*)(ws + WS_WOUT), 1024, 1024, nullptr}; pg8::EpiRes E{args.in[0], (float*)(ws + WS_H1)};
        pg8::gemm_phase<pg8::EpiRes, pg8::StaticOrder, false, false>(F.lds, g, S, E, F.wave);
    }
    split_arrive(bar, 3, F_TID);
    MEGA_MOE_PHASES
#undef IN
#undef SEAM
}

extern "C" void kernel_launch(void* const* d_in, const int* in_sizes, int n_in, void* d_out, int out_size, void* d_ws, size_t ws_size, hipStream_t stream) {
    static int grid = 0;
    if (grid == 0) {
        if (n_in != 28 || out_size != M * D || ws_size < WS_END) { fprintf(stderr, "kernel_launch: unexpected shapes n_in %d out %d ws %zu\n", n_in, out_size, ws_size); grid = -1; return; }
        int dev = 0, cus = 0;
        if (hipGetDevice(&dev) != hipSuccess || hipDeviceGetAttribute(&cus, hipDeviceAttributeMultiprocessorCount, dev) != hipSuccess) { grid = -1; return; }
        if (hipFuncSetAttribute((const void*)mega_fwd, hipFuncAttributeMaxDynamicSharedMemorySize, LDS_BYTES) != hipSuccess) { fprintf(stderr, "kernel_launch: hipFuncSetAttribute failed\n"); grid = -1; return; }
        grid = cus;
    }
    if (grid < 0) return;
    (void)hipMemsetAsync((unsigned char*)d_ws + WS_CTL, 0, 1 * MiB, stream);
    Args a{};
    for (int i = 0; i < 28; ++i) a.in[i] = (const float*)d_in[i];
    a.out = (float*)d_out; a.ws = (unsigned char*)d_ws; a.ph_lo = 0; a.ph_hi = PH_END; a.li = 0; a.pad = 0;
    hipLaunchKernelGGL(mega_fwd, dim3(grid), dim3(NWAVES * 64), LDS_BYTES, stream, a);
}
```
